# Optimizing an MI355X kernel written in HIP

```python
import math, functools
import jax, jax.numpy as jnp
from jax import lax
import numpy as np

D_MODEL = 1024
BATCH = 16
SEQ = 2048
DEPTH = 1

CTX_LEN = 256
GRID_W = 64
ROPE_THETA = 10000.0
NORM_EPS = 1e-6
Q_BLOCK = 128

A_HEADS = 4
A_HEAD_DIM = 64
A_WIDTH = A_HEADS * 2 * A_HEAD_DIM
B_HEADS = 8
B_NOPE = 64
B_ROPE = 32
B_VDIM = 64
B_Q_RANK = 256
B_KV_RANK = 128
B_WIDTH = B_HEADS * B_VDIM
MIX_WIDTH = A_WIDTH + B_WIDTH
IN_WIDTH = 3 * A_WIDTH + B_Q_RANK + B_KV_RANK + B_ROPE
SPLIT_POINTS = (A_WIDTH, 2 * A_WIDTH, 3 * A_WIDTH, 3 * A_WIDTH + B_Q_RANK,
                3 * A_WIDTH + B_Q_RANK + B_KV_RANK)
FFN_HIDDEN = -(-8 * D_MODEL // (3 * 256)) * 256

kernel_name = "hybrid_diffattn_mla_dit_layer"


def _rmsnorm(x, gain=None):
    x32 = x.astype(jnp.float32)
    y = x32 * lax.rsqrt(jnp.mean(x32 * x32, axis=-1, keepdims=True) + NORM_EPS)
    if gain is not None:
        y = y * gain.astype(jnp.float32)
    return y.astype(x.dtype)


def _modulate(h, shift, scale):
    return h * (1 + scale) + shift


def _axial_rope(x, row, col):
    half = x.shape[-1] // 2
    quarter = half // 2
    inv = ROPE_THETA ** (-jnp.arange(quarter, dtype=jnp.float32) / quarter)

    def rot(xa, pos):
        ang = pos.astype(jnp.float32)[:, None] * inv[None, :]
        cos = jnp.concatenate([jnp.cos(ang)] * 2, -1)[None, :, None, :]
        sin = jnp.concatenate([jnp.sin(ang)] * 2, -1)[None, :, None, :]
        xa32 = xa.astype(jnp.float32)
        rotated = jnp.concatenate([-xa32[..., quarter:], xa32[..., :quarter]], -1)
        return (xa32 * cos + rotated * sin).astype(x.dtype)

    return jnp.concatenate([rot(x[..., :half], row), rot(x[..., half:], col)], -1)


def _project(h, w_in, q_a_norm, kv_a_norm, w_q_up, w_kv_up, pos):
    nb, s, _ = h.shape
    qa, ka, va, cq, ckv, krope = jnp.split(h @ w_in, SPLIT_POINTS, axis=-1)
    qa = qa.reshape(nb, s, A_HEADS, 2, A_HEAD_DIM)
    ka = ka.reshape(nb, s, A_HEADS, 2, A_HEAD_DIM)
    q1, q2 = qa[..., 0, :], qa[..., 1, :]
    k1, k2 = ka[..., 0, :], ka[..., 1, :]
    va = va.reshape(nb, s, A_HEADS, 2 * A_HEAD_DIM)
    qb = (_rmsnorm(cq, q_a_norm) @ w_q_up).reshape(nb, s, B_HEADS, B_NOPE + B_ROPE)
    kvb = (_rmsnorm(ckv, kv_a_norm) @ w_kv_up).reshape(nb, s, B_HEADS, B_NOPE + B_VDIM)
    q_nope, q_rope = qb[..., :B_NOPE], qb[..., B_NOPE:]
    k_nope, vb = kvb[..., :B_NOPE], kvb[..., B_NOPE:]
    krope = krope[:, :, None, :]
    if pos is not None:
        row, col = pos
        q1, q2, k1, k2 = (_axial_rope(t, row, col) for t in (q1, q2, k1, k2))
        q_rope = _axial_rope(q_rope, row, col)
        krope = _axial_rope(krope, row, col)
    qb = jnp.concatenate([q_nope, q_rope], -1)
    kb = jnp.concatenate([k_nope, jnp.broadcast_to(krope, (nb, s, B_HEADS, B_ROPE))], -1)
    return q1, q2, k1, k2, va, qb, kb, vb


def _diff_attend(q1, q2, k1, k2, v, lam):
    scale = A_HEAD_DIM ** -0.5
    s1 = jnp.einsum('bqhd,bkhd->bhqk', q1, k1).astype(jnp.float32) * scale
    s2 = jnp.einsum('bqhd,bkhd->bhqk', q2, k2).astype(jnp.float32) * scale
    a = jax.nn.softmax(s1, axis=-1) - lam * jax.nn.softmax(s2, axis=-1)
    return jnp.einsum('bhqk,bkhe->bqhe', a.astype(v.dtype), v)


def _softmax_attend(q, k, v):
    scale = (B_NOPE + B_ROPE) ** -0.5
    s = jnp.einsum('bqhd,bkhd->bhqk', q, k).astype(jnp.float32) * scale
    a = jax.nn.softmax(s, axis=-1)
    return jnp.einsum('bhqk,bkhe->bqhe', a.astype(v.dtype), v)


def _map_query_blocks(fn, *qs):
    nb, s = qs[0].shape[:2]
    n_blk = s // Q_BLOCK
    blocks = tuple(jnp.moveaxis(q.reshape(nb, n_blk, Q_BLOCK, *q.shape[2:]), 1, 0) for q in qs)
    out = lax.map(lambda blk: fn(*blk), blocks)
    out = jnp.moveaxis(out, 0, 1)
    return out.reshape(nb, s, *out.shape[3:])


def _merge_heads(oa, ob, lam_init, diff_subln, w_out):
    nb, s = oa.shape[:2]
    oa = _rmsnorm(oa, diff_subln) * (1 - lam_init)
    cat = jnp.concatenate([oa.reshape(nb, s, A_WIDTH), ob.reshape(nb, s, B_WIDTH)], -1)
    return cat @ w_out


def _swiglu(h, w_ffn_in, w_ffn_out):
    gate, up = jnp.split(h @ w_ffn_in, 2, axis=-1)
    return (jax.nn.silu(gate) * up) @ w_ffn_out


def _layer(x_lat, x_ctx, row, col, c, c_ctx, w_ada, b_ada, w_in, q_a_norm, kv_a_norm,
           w_q_up, w_kv_up, diff_lambda, diff_subln, w_out, w_ffn_in, w_ffn_out,
           layer_idx, update_ctx):
    lam_init = 0.8 - 0.6 * math.exp(-0.3 * layer_idx)
    lp = diff_lambda.astype(jnp.float32)
    lam = jnp.exp(jnp.sum(lp[0] * lp[1])) - jnp.exp(jnp.sum(lp[2] * lp[3])) + lam_init

    sh_a, sc_a, g_a, sh_f, sc_f, g_f = jnp.split((jax.nn.silu(c) @ w_ada + b_ada)[:, None, :], 6, axis=-1)
    csh_a, csc_a, cg_a, csh_f, csc_f, cg_f = jnp.split(jax.nn.silu(c_ctx) @ w_ada + b_ada, 6, axis=-1)

    proj = functools.partial(_project, w_in=w_in, q_a_norm=q_a_norm, kv_a_norm=kv_a_norm,
                             w_q_up=w_q_up, w_kv_up=w_kv_up)
    h_lat = _modulate(_rmsnorm(x_lat), sh_a, sc_a)
    h_ctx = _modulate(_rmsnorm(x_ctx), csh_a, csc_a)
    lq1, lq2, lk1, lk2, lva, lqb, lkb, lvb = proj(h_lat, pos=(row, col))
    cq1, cq2, ck1, ck2, cva, cqb, ckb, cvb = proj(h_ctx, pos=None)

    k1 = jnp.concatenate([ck1, lk1], axis=1)
    k2 = jnp.concatenate([ck2, lk2], axis=1)
    va = jnp.concatenate([cva, lva], axis=1)
    kb = jnp.concatenate([ckb, lkb], axis=1)
    vb = jnp.concatenate([cvb, lvb], axis=1)
    oa = _map_query_blocks(lambda q1, q2: _diff_attend(q1, q2, k1, k2, va, lam), lq1, lq2)
    ob = _map_query_blocks(lambda q: _softmax_attend(q, kb, vb), lqb)
    new_lat = x_lat + g_a * _merge_heads(oa, ob, lam_init, diff_subln, w_out)
    h = _modulate(_rmsnorm(new_lat), sh_f, sc_f)
    new_lat = new_lat + g_f * _swiglu(h, w_ffn_in, w_ffn_out)

    if update_ctx:
        oac = _diff_attend(cq1, cq2, ck1, ck2, cva, lam)
        obc = _softmax_attend(cqb, ckb, cvb)
        new_ctx = x_ctx + cg_a * _merge_heads(oac, obc, lam_init, diff_subln, w_out)
        hc = _modulate(_rmsnorm(new_ctx), csh_f, csc_f)
        new_ctx = new_ctx + cg_f * _swiglu(hc, w_ffn_in, w_ffn_out)
    else:
        new_ctx = x_ctx
    return new_lat, new_ctx


def setup_inputs(seed: int = 0) -> dict:
    key = jax.random.key(seed)
    ks = jax.random.split(key, 17)
    f32 = jnp.float32

    def nrm(k, shape, scale):
        return jax.random.normal(k, shape, f32) * scale

    return {
        "x": nrm(ks[0], (BATCH, SEQ, D_MODEL), 1.0),
        "c": nrm(ks[1], (BATCH, D_MODEL), 1.0),
        "ctx": nrm(ks[2], (BATCH, CTX_LEN, D_MODEL), 1.0),
        "c_ctx": nrm(ks[3], (D_MODEL,), 1.0),
        "w_ada": nrm(ks[4], (DEPTH, D_MODEL, 6 * D_MODEL), 0.5 * D_MODEL ** -0.5),
        "b_ada": nrm(ks[5], (DEPTH, 6 * D_MODEL), 0.01),
        "w_in": nrm(ks[6], (DEPTH, D_MODEL, IN_WIDTH), D_MODEL ** -0.5),
        "q_a_norm": 1.0 + nrm(ks[7], (DEPTH, B_Q_RANK), 0.05),
        "kv_a_norm": 1.0 + nrm(ks[8], (DEPTH, B_KV_RANK), 0.05),
        "w_q_up": nrm(ks[9], (DEPTH, B_Q_RANK, B_HEADS * (B_NOPE + B_ROPE)), B_Q_RANK ** -0.5),
        "w_kv_up": nrm(ks[10], (DEPTH, B_KV_RANK, B_HEADS * (B_NOPE + B_VDIM)), B_KV_RANK ** -0.5),
        "diff_lambda": nrm(ks[11], (DEPTH, 4, A_HEAD_DIM), 0.1),
        "diff_subln": 1.0 + nrm(ks[12], (DEPTH, 2 * A_HEAD_DIM), 0.05),
        "w_out": nrm(ks[13], (DEPTH, MIX_WIDTH, D_MODEL), MIX_WIDTH ** -0.5),
        "w_ffn_in": nrm(ks[14], (DEPTH, D_MODEL, 2 * FFN_HIDDEN), D_MODEL ** -0.5),
        "w_ffn_out": nrm(ks[15], (DEPTH, FFN_HIDDEN, D_MODEL), FFN_HIDDEN ** -0.5),
        "final_norm": 1.0 + nrm(ks[16], (D_MODEL,), 0.05),
    }


def reference(x, c, ctx, c_ctx, w_ada, b_ada, w_in, q_a_norm, kv_a_norm, w_q_up, w_kv_up,
              diff_lambda, diff_subln, w_out, w_ffn_in, w_ffn_out, final_norm):
    seq = x.shape[1]
    rows = seq // GRID_W
    row = jnp.repeat(jnp.arange(rows, dtype=jnp.int32), GRID_W)
    col = jnp.tile(jnp.arange(GRID_W, dtype=jnp.int32), rows)
    x_lat, x_ctx = x, ctx
    for layer in range(DEPTH):
        x_lat, x_ctx = _layer(
            x_lat, x_ctx, row, col, c, c_ctx,
            w_ada[layer], b_ada[layer], w_in[layer], q_a_norm[layer], kv_a_norm[layer],
            w_q_up[layer], w_kv_up[layer], diff_lambda[layer], diff_subln[layer],
            w_out[layer], w_ffn_in[layer], w_ffn_out[layer],
            layer_idx=layer, update_ctx=(layer < DEPTH - 1))
    return _rmsnorm(x_lat, final_norm)
```

```cpp
#include <hip/hip_runtime.h>
#include <hip/hip_cooperative_groups.h>
#include <cstdint>
#include <cstdio>
namespace cg = cooperative_groups;

#define LAS __attribute__((address_space(3)))
typedef unsigned short bf16_t;
typedef short bf16x8 __attribute__((ext_vector_type(8)));
typedef short s16x4 __attribute__((ext_vector_type(4)));
typedef float f32x2 __attribute__((ext_vector_type(2)));
typedef float f32x4 __attribute__((ext_vector_type(4)));
typedef float f32x16 __attribute__((ext_vector_type(16)));
typedef unsigned u32x2 __attribute__((ext_vector_type(2)));
typedef unsigned u32x4 __attribute__((ext_vector_type(4)));
typedef __bf16 bf16x2_t __attribute__((ext_vector_type(2)));

constexpr int DM = 1024, NB = 16, SEQ = 2048, CTXL = 256, TPB = SEQ + CTXL;
constexpr int MROWS = NB * TPB, MLAT = NB * SEQ;
constexpr int FFH = 2816, NIN = 2048, NADA = 6 * DM;
constexpr float EPS = 1e-6f;
constexpr int NWAVES = 8, NTHREADS = 512;

constexpr size_t KiB = 1024, MiB = 1024 * 1024;
constexpr size_t WS_MOD = 0, WS_BIASF = 512 * KiB, WS_SSQQ = 1024 * KiB, WS_SSQKV = 1184 * KiB, WS_SSQ2 = 1344 * KiB, WS_LAM = 1536 * KiB, WS_BAR = 1792 * KiB;
constexpr size_t CTL_BYTES = 2 * MiB;
constexpr size_t WS_TAB = 2 * MiB;
constexpr size_t WS_WIN = 3 * MiB, WS_WQUP = 7 * MiB, WS_WKVUP = 7 * MiB + 512 * KiB, WS_WOUT = 8 * MiB, WS_WFFI = 10 * MiB, WS_WFFO = 21 * MiB;
constexpr size_t WS_A2 = 27 * MiB, WS_CAT = 91 * MiB;
constexpr size_t WS_H = 155 * MiB, WS_QB = 155 * MiB, WS_QA = 227 * MiB, WS_KA = 263 * MiB, WS_VA = 299 * MiB, WS_CQ = 335 * MiB, WS_CKV = 353 * MiB;
constexpr size_t WS_KB = 362 * MiB, WS_VB = 416 * MiB, WS_SCR = 452 * MiB, WS_G = 155 * MiB, WS_END = 484 * MiB;
static_assert(WS_G + (size_t)MLAT * FFH * 2 <= WS_CQ, "G overlay");
static_assert(WS_WFFO + (size_t)DM * FFH * 2 <= WS_A2, "wffo");

struct Params {
    const float *x, *c, *ctx, *c_ctx, *w_ada, *b_ada, *w_in, *q_a_norm, *kv_a_norm, *w_q_up, *w_kv_up, *diff_lambda, *diff_subln, *w_out, *w_ffn_in, *w_ffn_out, *final_norm;
    float* out; unsigned char* ws;
};

__device__ __forceinline__ unsigned cvtpk(float lo, float hi) { f32x2 v = {lo, hi}; bf16x2_t b = __builtin_convertvector(v, bf16x2_t); return __builtin_bit_cast(unsigned, b); }
__device__ __forceinline__ float wave_sum(float v) {
#pragma unroll
    for (int o = 1; o < 64; o <<= 1) v += __shfl_xor(v, o);
    return v;
}
__device__ __forceinline__ float silu_f(float v) { return v / (1.f + __expf(-v)); }
__device__ __forceinline__ u32x4 pack8(f32x4 a, f32x4 b) { u32x4 w; w.x = cvtpk(a[0], a[1]); w.y = cvtpk(a[2], a[3]); w.z = cvtpk(b[0], b[1]); w.w = cvtpk(b[2], b[3]); return w; }
__device__ __forceinline__ int ropeA_L(int q) { return 4 * ((q >> 3) & 3) + (q & 3) + 16 * ((q >> 2) & 1); }
__device__ __forceinline__ int ropeB_L(int q) { const int a = q >> 3, n = (q >> 2) & 1, j = q & 3; return (a >> 1) * 16 + (a & 1) * 4 + j + 8 * n; }

struct Frame { int tid, lane, wave, G, bid, gwi, ngw; LAS unsigned char* lds; };

__device__ __forceinline__ void p0_ada_task(const Params& P, float* MOD, int t, int lane) {
    const int cgp = t % 24, kc = t / 24, k0 = kc * 32, n = cgp * 256 + lane * 4, k = k0 + (lane & 31);
    float sv[17];
#pragma unroll
    for (int b = 0; b < 16; ++b) sv[b] = silu_f(P.c[b * DM + k]);
    sv[16] = silu_f(P.c_ctx[k]);
    f32x4 acc[17];
    const f32x4 binit = (kc == 0) ? *(const f32x4*)(P.b_ada + n) : (f32x4){0.f, 0.f, 0.f, 0.f};
#pragma unroll
    for (int b = 0; b < 17; ++b) acc[b] = binit;
#pragma unroll 2
    for (int kk = 0; kk < 32; ++kk) {
        const f32x4 w = *(const f32x4*)(P.w_ada + (size_t)(k0 + kk) * NADA + n);
#pragma unroll
        for (int b = 0; b < 17; ++b) { const float s = __shfl(sv[b], kk); acc[b] += w * s; }
    }
#pragma unroll
    for (int b = 0; b < 17; ++b)
#pragma unroll
        for (int j = 0; j < 4; ++j) atomicAdd(&MOD[b * NADA + n + j], acc[b][j]);
}
__device__ __forceinline__ int src_col(int mat, int p) {
    switch (mat) {
    case 0: if (p < 1024) return (p & ~31) + ropeA_L(p & 31); if (p < 1920) return p; if (p < 1952) return 1920 + ropeB_L(p - 1920); return -1;
    case 1: if (p < 512) return (p >> 6) * 96 + (p & 63); { const int q = p - 512; return (q >> 5) * 96 + 64 + ropeB_L(q & 31); }
    case 2: if (p < 512) return (p >> 6) * 128 + (p & 63); { const int q = p - 512; return (q >> 6) * 128 + 64 + (q & 63); }
    case 4: { const int t = p >> 8, q = p & 255; return q < 128 ? 128 * t + q : FFH + 128 * t + (q - 128); }
    default: return p;
    }
}
__device__ __forceinline__ void p0_transpose_item(const float* W, int K, int N, const float* gain, bf16_t* WT, int mat, int npb, LAS float* scr, int item, int lane) {
    const int kb = item / npb, pb = item % npb, k0 = 64 * kb, p0 = 32 * pb;
    const int sc = src_col(mat, p0 + (lane & 31));
#pragma unroll 8
    for (int i = 0; i < 32; ++i) { const int kk = 2 * i + (lane >> 5);
        float v = 0.f; if (sc >= 0) { v = W[(size_t)(k0 + kk) * N + sc]; if (gain) v *= gain[k0 + kk]; }
        scr[kk * 33 + (lane & 31)] = v; }
    asm volatile("s_waitcnt lgkmcnt(0)" ::: "memory");
    const int c = lane & 7;
#pragma unroll
    for (int j = 0; j < 4; ++j) { const int n = (lane >> 3) + 8 * j; const LAS float* s = scr + (8 * c) * 33 + n;
        u32x4 o; o.x = cvtpk(s[0 * 33], s[1 * 33]); o.y = cvtpk(s[2 * 33], s[3 * 33]); o.z = cvtpk(s[4 * 33], s[5 * 33]); o.w = cvtpk(s[6 * 33], s[7 * 33]);
        *(u32x4*)(WT + (size_t)(p0 + n) * K + k0 + 8 * c) = o; }
    asm volatile("s_waitcnt lgkmcnt(0)" ::: "memory");
}
__device__ __forceinline__ void sincos_d(double a, float& s, float& c) {
    const double k = __builtin_rint(a * 0.15915494309189535);
    double r = __builtin_fma(-k, 6.283185307179586, a); r = __builtin_fma(-k, 2.4492935982947064e-16, r);
    const double r2 = r * r; double ts = r, tc = 1.0, ss = r, cc = 1.0;
    for (int n = 0; n < 14; ++n) { tc = -tc * r2 / (double)((2 * n + 1) * (2 * n + 2)); cc += tc; ts = -ts * r2 / (double)((2 * n + 2) * (2 * n + 3)); ss += ts; }
    s = (float)ss; c = (float)cc;
}
__device__ __forceinline__ void p0_phase(const Params& P, const Frame& F) {
    float* MOD = (float*)(P.ws + WS_MOD);
    LAS float* scr = (LAS float*)(F.lds + F.wave * 8448);
    constexpr int NADA_T = 24 * 32;
    constexpr int I0 = 16 * 64, I1 = 4 * 24, I2 = 2 * 32, I3 = 16 * 32, I4 = 16 * 176, I5 = 44 * 32;
    constexpr int NT = NADA_T + I0 + I1 + I2 + I3 + I4 + I5;
    for (int t = F.gwi; t < NT; t += F.ngw) {
        int r = t;
        if (r < NADA_T) { p0_ada_task(P, MOD, r, F.lane); continue; } r -= NADA_T;
        if (r < I0) { p0_transpose_item(P.w_in, 1024, 1952, nullptr, (bf16_t*)(P.ws + WS_WIN), 0, 64, scr, r, F.lane); continue; } r -= I0;
        if (r < I1) { p0_transpose_item(P.w_q_up, 256, 768, P.q_a_norm, (bf16_t*)(P.ws + WS_WQUP), 1, 24, scr, r, F.lane); continue; } r -= I1;
        if (r < I2) { p0_transpose_item(P.w_kv_up, 128, 1024, P.kv_a_norm, (bf16_t*)(P.ws + WS_WKVUP), 2, 32, scr, r, F.lane); continue; } r -= I2;
        if (r < I3) { p0_transpose_item(P.w_out, 1024, 1024, nullptr, (bf16_t*)(P.ws + WS_WOUT), 3, 32, scr, r, F.lane); continue; } r -= I3;
        if (r < I4) { p0_transpose_item(P.w_ffn_in, 1024, 2 * FFH, nullptr, (bf16_t*)(P.ws + WS_WFFI), 4, 176, scr, r, F.lane); continue; } r -= I4;
        p0_transpose_item(P.w_ffn_out, FFH, 1024, nullptr, (bf16_t*)(P.ws + WS_WFFO), 5, 32, scr, r, F.lane);
    }
    if (F.bid == F.G - 1) {
        float* TAB = (float*)(P.ws + WS_TAB);
        for (int i = F.tid; i < 1536; i += NTHREADS) {
            float s, c;
            if (i < 1024) { const int pos = i >> 4, f = i & 15; double inv = 1.0; for (int q = 0; q < f; ++q) inv *= 0.5623413251903491; sincos_d((double)pos * inv, s, c); TAB[i] = c; TAB[1024 + i] = s; }
            else { const int e = i - 1024, pos = e >> 3, f = e & 7; double inv = 1.0; for (int q = 0; q < f; ++q) inv *= 0.31622776601683794; sincos_d((double)pos * inv, s, c); TAB[2048 + e] = c; TAB[2560 + e] = s; }
        }
        if (F.wave == 0) {
            const float* lp = P.diff_lambda; const float a = wave_sum(lp[F.lane] * lp[64 + F.lane]), b = wave_sum(lp[128 + F.lane] * lp[192 + F.lane]);
            if (F.lane == 0) *(float*)(P.ws + WS_LAM) = __expf(a) - __expf(b) + 0.2f;
        }
    }
}

__device__ __forceinline__ void p1_phase(const Params& P, const Frame& F) {
    const float* MOD = (const float*)(P.ws + WS_MOD);
    bf16_t* H = (bf16_t*)(P.ws + WS_H);
    for (int r = F.gwi; r < MROWS; r += F.ngw) {
        const int b = r / TPB, t = r - b * TPB;
        const float* src = (t < CTXL) ? P.ctx + ((size_t)b * CTXL + t) * DM : P.x + ((size_t)b * SEQ + (t - CTXL)) * DM;
        const float* mp = MOD + (size_t)((t < CTXL) ? 16 : b) * NADA;
        f32x4 v[4]; float s = 0.f;
#pragma unroll
        for (int j = 0; j < 4; ++j) { v[j] = *(const f32x4*)(src + 4 * F.lane + 256 * j); s += (v[j].x * v[j].x + v[j].y * v[j].y) + (v[j].z * v[j].z + v[j].w * v[j].w); }
        const float rstd = rsqrtf(wave_sum(s) * (1.f / DM) + EPS);
#pragma unroll
        for (int j = 0; j < 4; ++j) { const int col = 4 * F.lane + 256 * j; const f32x4 sh = *(const f32x4*)(mp + col), sc = *(const f32x4*)(mp + DM + col);
            const f32x4 h = v[j] * rstd * (sc + 1.f) + sh; u32x2 w; w.x = cvtpk(h[0], h[1]); w.y = cvtpk(h[2], h[3]);
            *(u32x2*)(H + (size_t)r * DM + col) = w; }
    }
    if (F.gwi < 22 * 16) {
        float* BIASF = (float*)(P.ws + WS_BIASF);
        const int cgp = F.gwi % 22, kc = F.gwi / 22, k0 = kc * 64, n = cgp * 256 + F.lane * 4;
        float sv[16];
#pragma unroll
        for (int b = 0; b < 16; ++b) sv[b] = MOD[(size_t)b * NADA + 3 * DM + k0 + F.lane];
        f32x4 acc[16];
#pragma unroll
        for (int b = 0; b < 16; ++b) acc[b] = (f32x4){0.f, 0.f, 0.f, 0.f};
#pragma unroll 2
        for (int kk = 0; kk < 64; ++kk) {
            const f32x4 w = *(const f32x4*)(P.w_ffn_in + (size_t)(k0 + kk) * (2 * FFH) + n);
#pragma unroll
            for (int b = 0; b < 16; ++b) { const float s = __shfl(sv[b], kk); acc[b] += w * s; }
        }
#pragma unroll
        for (int b = 0; b < 16; ++b)
#pragma unroll
            for (int j = 0; j < 4; ++j) atomicAdd(&BIASF[b * (2 * FFH) + n + j], acc[b][j]);
    }
}

struct Unit { int pm, pn; };
__device__ __forceinline__ int perm32(int rho) { const int n = rho >> 4, i = rho & 15; return 8 * (i >> 2) + 4 * n + (i & 3); }
struct TileOrder {
    int nM, nN, nwg, G, c;
    __device__ __forceinline__ void init(int nM_, int nN_, int G_, int c_) { nM = nM_; nN = nN_; nwg = nM * nN; G = G_; c = c_; }
    __device__ __forceinline__ bool next(int i, Unit& u) const {
        const long L = (long)i * G + c; if (L >= nwg) return false;
        int wgid = (int)L; { const int q = nwg / 8, r = nwg % 8, xcd = wgid % 8, off = wgid / 8; wgid = (xcd < r ? xcd * (q + 1) : r * (q + 1) + (xcd - r) * q) + off; }
        const int nig = 8 * nN, gid = wgid / nig, fm = gid * 8, gsz = (nM - fm) < 8 ? (nM - fm) : 8;
        u.pm = fm + ((wgid % nig) % gsz); u.pn = (wgid % nig) / gsz; return true;
    }
};
typedef f32x4 Acc[2][2][4][2];
constexpr int SG_STRIDE = 144;
template <class Epi>
__device__ __forceinline__ void gemm_unit_simple(const Frame& F, const bf16_t* A, const bf16_t* Bt, int K, const Unit u, const Epi& E) {
    const int wr = F.wave >> 2, wc = F.wave & 3, fr = F.lane & 15, fq = F.lane >> 4;
    LAS unsigned char* As = F.lds; LAS unsigned char* Bs = F.lds + 256 * SG_STRIDE;
    Acc acc;
#pragma unroll
    for (int a = 0; a < 2; ++a)
#pragma unroll
        for (int b = 0; b < 2; ++b)
#pragma unroll
            for (int m = 0; m < 4; ++m)
#pragma unroll
                for (int n = 0; n < 2; ++n) acc[a][b][m][n] = (f32x4){0.f, 0.f, 0.f, 0.f};
    const bf16_t* Ag = A + (size_t)u.pm * 256 * K; const bf16_t* Bg = Bt + (size_t)u.pn * 256 * K;
#pragma unroll 1
    for (int kt = 0; kt < K; kt += 64) {
        __syncthreads();
#pragma unroll
        for (int i = 0; i < 4; ++i) { const int p = F.tid + 512 * i, row = p >> 3, ch = p & 7;
            const u32x4 va = *(const u32x4*)(Ag + (size_t)row * K + kt + ch * 8), vb = *(const u32x4*)(Bg + (size_t)row * K + kt + ch * 8);
            *(LAS u32x4*)(As + row * SG_STRIDE + ch * 16) = va; *(LAS u32x4*)(Bs + row * SG_STRIDE + ch * 16) = vb; if (i & 1) asm volatile("" ::: "memory"); }
        __syncthreads();
#pragma unroll
        for (int k2 = 0; k2 < 2; ++k2) {
#pragma unroll
            for (int ai = 0; ai < 2; ++ai) {
                bf16x8 At[4];
#pragma unroll
                for (int m = 0; m < 4; ++m) At[m] = *(const LAS bf16x8*)(As + (128 * ai + 64 * wr + 16 * m + fr) * SG_STRIDE + (32 * k2 + 8 * fq) * 2);
#pragma unroll
                for (int bj = 0; bj < 2; ++bj) {
                    bf16x8 Bf[2];
#pragma unroll
                    for (int n = 0; n < 2; ++n) Bf[n] = *(const LAS bf16x8*)(Bs + (128 * bj + 32 * wc + perm32(16 * n + fr)) * SG_STRIDE + (32 * k2 + 8 * fq) * 2);
#pragma unroll
                    for (int m = 0; m < 4; ++m)
#pragma unroll
                        for (int n = 0; n < 2; ++n) acc[ai][bj][m][n] = __builtin_amdgcn_mfma_f32_16x16x32_bf16(Bf[n], At[m], acc[ai][bj][m][n], 0, 0, 0);
                }
            }
        }
    }
    E(acc, u, wr, wc, fr, fq);
}

struct RopeTab { const float *Ac, *As, *Bc, *Bs; };
__device__ __forceinline__ RopeTab rope_tab(const Params& P) { const float* T = (const float*)(P.ws + WS_TAB); return RopeTab{T, T + 1024, T + 2048, T + 2560}; }
__device__ __forceinline__ void rope_pair(f32x4& v0, f32x4& v1, const f32x4 cs, const f32x4 sn) { const f32x4 a = v0 * cs - v1 * sn, b = v1 * cs + v0 * sn; v0 = a; v1 = b; }

struct EpiQKV {
    bf16_t *QA, *KA, *VA, *CQ, *CKV, *KB; float *SSQQ, *SSQKV; RopeTab T;
    __device__ __forceinline__ void operator()(const Acc& acc, const Unit& u, int wr, int wc, int fr, int fq) const {
        const int jb = u.pm % 9; const bool lat = jb != 0; const int pn = u.pn;
        if (!lat && (pn < 2 || pn == 6)) return;
#pragma unroll
        for (int ai = 0; ai < 2; ++ai) {
            const int prow = (jb - 1) * 4 + 2 * ai + wr;
#pragma unroll
            for (int m = 0; m < 4; ++m) {
                const int pcol = 16 * m + fr; const size_t grow = (size_t)u.pm * 256 + 128 * ai + 64 * wr + 16 * m + fr;
                if (pn < 4) {
                    bf16_t* dst = (pn < 2 ? QA : KA) + grow * 512 + (pn & 1) * 256 + 32 * wc + 8 * fq;
                    const int pos = (wc & 1) ? pcol : prow;
                    f32x4 cs = {1.f, 1.f, 1.f, 1.f}, sn = {0.f, 0.f, 0.f, 0.f};
                    if (lat) { cs = *(const f32x4*)(T.Ac + pos * 16 + 4 * fq); sn = *(const f32x4*)(T.As + pos * 16 + 4 * fq); }
#pragma unroll
                    for (int bj = 0; bj < 2; ++bj) { f32x4 v0 = acc[ai][bj][m][0], v1 = acc[ai][bj][m][1]; rope_pair(v0, v1, cs, sn); *(u32x4*)(dst + 128 * bj) = pack8(v0, v1); }
                } else if (pn < 6) {
#pragma unroll
                    for (int bj = 0; bj < 2; ++bj) *(u32x4*)(VA + grow * 512 + (pn - 4) * 256 + 128 * bj + 32 * wc + 8 * fq) = pack8(acc[ai][bj][m][0], acc[ai][bj][m][1]);
                } else if (pn == 6) {
                    float s = 0.f;
#pragma unroll
                    for (int bj = 0; bj < 2; ++bj) { const f32x4 v0 = acc[ai][bj][m][0], v1 = acc[ai][bj][m][1];
                        s += (v0[0] * v0[0] + v0[1] * v0[1]) + (v0[2] * v0[2] + v0[3] * v0[3]) + (v1[0] * v1[0] + v1[1] * v1[1]) + (v1[2] * v1[2] + v1[3] * v1[3]);
                        *(u32x4*)(CQ + grow * 256 + 128 * bj + 32 * wc + 8 * fq) = pack8(v0, v1); }
                    s += __shfl_xor(s, 16); s += __shfl_xor(s, 32);
                    if (fq == 0) atomicAdd(SSQQ + grow, s);
                } else {
                    { const f32x4 v0 = acc[ai][0][m][0], v1 = acc[ai][0][m][1];
                      float s = (v0[0] * v0[0] + v0[1] * v0[1]) + (v0[2] * v0[2] + v0[3] * v0[3]) + (v1[0] * v1[0] + v1[1] * v1[1]) + (v1[2] * v1[2] + v1[3] * v1[3]);
                      *(u32x4*)(CKV + grow * 128 + 32 * wc + 8 * fq) = pack8(v0, v1);
                      s += __shfl_xor(s, 16); s += __shfl_xor(s, 32);
                      if (fq == 0) atomicAdd(SSQKV + grow, s); }
                    if (wc == 0) {
                        f32x4 v0 = acc[ai][1][m][0], v1 = acc[ai][1][m][1];
                        if (lat) { const int pos = (fq < 2) ? prow : pcol; const f32x4 cs = *(const f32x4*)(T.Bc + pos * 8 + 4 * (fq & 1)), sn = *(const f32x4*)(T.Bs + pos * 8 + 4 * (fq & 1)); rope_pair(v0, v1, cs, sn); }
                        const u32x4 w = pack8(v0, v1);
#pragma unroll
                        for (int h = 0; h < 8; ++h) *(u32x4*)(KB + grow * 768 + h * 96 + 64 + 8 * fq) = w;
                    }
                }
            }
        }
    }
};
struct EpiQup {
    bf16_t* QB; const float* SSQQ; RopeTab T;
    __device__ __forceinline__ void operator()(const Acc& acc, const Unit& u, int wr, int wc, int fr, int fq) const {
        const int jb = u.pm % 9, pn = u.pn;
#pragma unroll
        for (int ai = 0; ai < 2; ++ai) {
            const int prow = (jb - 1) * 4 + 2 * ai + wr;
#pragma unroll
            for (int m = 0; m < 4; ++m) {
                const int pcol = 16 * m + fr; const size_t grow = (size_t)u.pm * 256 + 128 * ai + 64 * wr + 16 * m + fr;
                const float rstd = rsqrtf(SSQQ[grow] * (1.f / 256.f) + EPS);
#pragma unroll
                for (int bj = 0; bj < 2; ++bj) {
                    f32x4 v0 = acc[ai][bj][m][0] * rstd, v1 = acc[ai][bj][m][1] * rstd;
                    if (pn < 2) { const int c = pn * 256 + 128 * bj + 32 * wc + 8 * fq; *(u32x4*)(QB + grow * 768 + (c >> 6) * 96 + (c & 63)) = pack8(v0, v1); }
                    else { const int h = 4 * bj + wc, pos = (fq < 2) ? prow : pcol;
                        const f32x4 cs = *(const f32x4*)(T.Bc + pos * 8 + 4 * (fq & 1)), sn = *(const f32x4*)(T.Bs + pos * 8 + 4 * (fq & 1)); rope_pair(v0, v1, cs, sn);
                        *(u32x4*)(QB + grow * 768 + h * 96 + 64 + 8 * fq) = pack8(v0, v1); }
                }
                asm volatile("" ::: "memory");
            }
        }
    }
};
struct EpiKVup {
    bf16_t *KB, *VB; const float* SSQKV;
    __device__ __forceinline__ void operator()(const Acc& acc, const Unit& u, int wr, int wc, int fr, int fq) const {
        const int pn = u.pn;
#pragma unroll
        for (int ai = 0; ai < 2; ++ai)
#pragma unroll
            for (int m = 0; m < 4; ++m) {
                const size_t grow = (size_t)u.pm * 256 + 128 * ai + 64 * wr + 16 * m + fr;
                const float rstd = rsqrtf(SSQKV[grow] * (1.f / 128.f) + EPS);
#pragma unroll
                for (int bj = 0; bj < 2; ++bj) {
                    const f32x4 v0 = acc[ai][bj][m][0] * rstd, v1 = acc[ai][bj][m][1] * rstd;
                    if (pn < 2) { const int c = pn * 256 + 128 * bj + 32 * wc + 8 * fq; *(u32x4*)(KB + grow * 768 + (c >> 6) * 96 + (c & 63)) = pack8(v0, v1); }
                    else *(u32x4*)(VB + grow * 512 + (pn - 2) * 256 + 128 * bj + 32 * wc + 8 * fq) = pack8(v0, v1);
                }
                asm volatile("" ::: "memory");
            }
    }
};
struct EpiOut {
    const float* x; float* out; bf16_t* A2; const float* MOD; float* SSQ2;
    __device__ __forceinline__ void operator()(const Acc& acc, const Unit& u, int wr, int wc, int fr, int fq) const {
        const float* mp = MOD + (size_t)(u.pm >> 3) * NADA;
#pragma unroll
        for (int ai = 0; ai < 2; ++ai)
#pragma unroll
            for (int m = 0; m < 4; ++m) {
                const size_t row = (size_t)u.pm * 256 + 128 * ai + 64 * wr + 16 * m + fr; float s = 0.f;
#pragma unroll
                for (int bj = 0; bj < 2; ++bj) {
                    const int col = u.pn * 256 + 128 * bj + 32 * wc + 8 * fq; const size_t off = row * DM + col;
                    f32x4 nv[2];
#pragma unroll
                    for (int n = 0; n < 2; ++n) { const f32x4 ga = *(const f32x4*)(mp + 2 * DM + col + 4 * n), xv = *(const f32x4*)(x + off + 4 * n);
                        nv[n] = xv + ga * acc[ai][bj][m][n]; *(f32x4*)(out + off + 4 * n) = nv[n];
                        s += (nv[n][0] * nv[n][0] + nv[n][1] * nv[n][1]) + (nv[n][2] * nv[n][2] + nv[n][3] * nv[n][3]); }
                    const f32x4 s0 = *(const f32x4*)(mp + 4 * DM + col), s1 = *(const f32x4*)(mp + 4 * DM + col + 4);
                    *(u32x4*)(A2 + off) = pack8(nv[0] * (s0 + 1.f), nv[1] * (s1 + 1.f));
                }
                s += __shfl_xor(s, 16); s += __shfl_xor(s, 32);
                if (fq == 0) atomicAdd(SSQ2 + row, s);
            }
    }
};
struct EpiFfnIn {
    bf16_t* G; const float* SSQ2; const float* BIASF;
    __device__ __forceinline__ void operator()(const Acc& acc, const Unit& u, int wr, int wc, int fr, int fq) const {
        const float* bp = BIASF + (size_t)(u.pm >> 3) * (2 * FFH); const int hc = u.pn * 128 + 32 * wc + 8 * fq;
        f32x4 bg[2], bu[2];
#pragma unroll
        for (int n = 0; n < 2; ++n) { bg[n] = *(const f32x4*)(bp + hc + 4 * n); bu[n] = *(const f32x4*)(bp + FFH + hc + 4 * n); }
#pragma unroll
        for (int ai = 0; ai < 2; ++ai)
#pragma unroll
            for (int m = 0; m < 4; ++m) {
                const size_t row = (size_t)u.pm * 256 + 128 * ai + 64 * wr + 16 * m + fr;
                const float rstd = rsqrtf(SSQ2[row] * (1.f / DM) + EPS);
                f32x4 o[2];
#pragma unroll
                for (int n = 0; n < 2; ++n) { const f32x4 g = acc[ai][0][m][n] * rstd + bg[n], up = acc[ai][1][m][n] * rstd + bu[n];
#pragma unroll
                    for (int j = 0; j < 4; ++j) o[n][j] = silu_f(g[j]) * up[j]; }
                *(u32x4*)(G + row * FFH + hc) = pack8(o[0], o[1]);
            }
    }
};
struct EpiFfnOut {
    float* out; const float* MOD;
    __device__ __forceinline__ void operator()(const Acc& acc, const Unit& u, int wr, int wc, int fr, int fq) const {
        const float* mp = MOD + (size_t)(u.pm >> 3) * NADA + 5 * DM;
#pragma unroll
        for (int ai = 0; ai < 2; ++ai)
#pragma unroll
            for (int m = 0; m < 4; ++m) {
                const size_t row = (size_t)u.pm * 256 + 128 * ai + 64 * wr + 16 * m + fr;
#pragma unroll
                for (int bj = 0; bj < 2; ++bj)
#pragma unroll
                    for (int n = 0; n < 2; ++n) { const int col = u.pn * 256 + 128 * bj + 32 * wc + 8 * fq + 4 * n; const size_t off = row * DM + col;
                        const f32x4 gf = *(const f32x4*)(mp + col), nl = *(const f32x4*)(out + off); *(f32x4*)(out + off) = nl + gf * acc[ai][bj][m][n]; }
            }
    }
};

#define SBAR() __builtin_amdgcn_sched_barrier(0)
__device__ __forceinline__ int crow(int r, int hi) { return (r & 3) + 8 * (r >> 2) + 4 * hi; }
constexpr float ATT_THR = 8.f;
template <int DQK> struct AttC { static constexpr float SCALE = (DQK == 64) ? 0.125f : 0.10206207261596575f; static constexpr float C = SCALE * 1.4426950408889634f; };
template <int DQK>
__device__ __forceinline__ void partialSM(f32x16& p0, f32x16& p1, float& m_reg, float& mn, float& alpha) {
    constexpr float C = AttC<DQK>::C, SC = AttC<DQK>::SCALE;
    float pmax = p0[0];
#pragma unroll
    for (int r = 1; r < 16; ++r) pmax = fmaxf(pmax, p0[r]);
#pragma unroll
    for (int r = 0; r < 16; ++r) pmax = fmaxf(pmax, p1[r]);
    { auto rr = __builtin_amdgcn_permlane32_swap(__float_as_uint(pmax), __float_as_uint(pmax), false, false);
      pmax = fmaxf(__uint_as_float(rr[0]), __uint_as_float(rr[1])); }
    if (__builtin_expect(__all(pmax - m_reg <= ATT_THR / SC), 1)) { mn = m_reg; alpha = 1.f; }
    else { mn = fmaxf(m_reg, pmax); alpha = __builtin_amdgcn_exp2f((m_reg - mn) * C); m_reg = mn; }
    const float mnC = -mn * C;
#pragma unroll
    for (int r = 0; r < 16; ++r) p0[r] = fmaf(p0[r], C, mnC);
#pragma unroll
    for (int r = 0; r < 16; ++r) p1[r] = fmaf(p1[r], C, mnC);
#pragma unroll
    for (int r = 0; r < 16; ++r) p0[r] = __builtin_amdgcn_exp2f(p0[r]);
}
__device__ __forceinline__ void finishSM(f32x16& p0, f32x16& p1, float alpha, float& l_reg, bf16x8& pa0, bf16x8& pa1, bf16x8& pa2, bf16x8& pa3) {
#pragma unroll
    for (int r = 0; r < 16; ++r) p1[r] = __builtin_amdgcn_exp2f(p1[r]);
    float ps = 0;
#pragma unroll
    for (int r = 0; r < 16; ++r) ps += p0[r];
#pragma unroll
    for (int r = 0; r < 16; ++r) ps += p1[r];
    { auto rr = __builtin_amdgcn_permlane32_swap(__float_as_uint(ps), __float_as_uint(ps), false, false);
      ps = __uint_as_float(rr[0]) + __uint_as_float(rr[1]); }
    l_reg = l_reg * alpha + ps;
#define PK4(P, BASE, OUT) do { unsigned a0 = cvtpk(P[BASE + 0], P[BASE + 1]), a1 = cvtpk(P[BASE + 2], P[BASE + 3]);   \
    unsigned b0 = cvtpk(P[BASE + 4], P[BASE + 5]), b1 = cvtpk(P[BASE + 6], P[BASE + 7]);                              \
    auto r0 = __builtin_amdgcn_permlane32_swap(a0, b0, false, false); auto r1 = __builtin_amdgcn_permlane32_swap(a1, b1, false, false); \
    u32x4 w = {r0[0], r1[0], r0[1], r1[1]}; OUT = __builtin_bit_cast(bf16x8, w); } while (0)
    PK4(p0, 0, pa0); PK4(p0, 8, pa1); PK4(p1, 0, pa2); PK4(p1, 8, pa3);
#undef PK4
}
template <int DQK>
__device__ __forceinline__ void qkt(f32x16& p0, f32x16& p1, const char* Ks, const bf16x8* qr, int r32, int hi) {
    constexpr int KROW = 2 * DQK + 16;
    p0 = f32x16{}; p1 = f32x16{};
#pragma unroll
    for (int d0 = 0; d0 < DQK / 16; ++d0) { const int cb = (d0 * 16 + hi * 8) * 2;
        const bf16x8 b0 = *reinterpret_cast<const bf16x8*>(Ks + r32 * KROW + cb);
        const bf16x8 b1 = *reinterpret_cast<const bf16x8*>(Ks + (32 + r32) * KROW + cb);
        p0 = __builtin_amdgcn_mfma_f32_32x32x16_bf16(b0, qr[d0], p0, 0, 0, 0);
        p1 = __builtin_amdgcn_mfma_f32_32x32x16_bf16(b1, qr[d0], p1, 0, 0, 0); }
}
template <int DV> __device__ __forceinline__ int v_st(int k, int c) { const int kk = (k & ~0xC) | ((k & 4) << 1) | ((k & 8) >> 1); return ((kk >> 3) * (DV / 32) + (c >> 5)) * 512 + ((kk & 7) * 32 + (c & 31)) * 2; }
__device__ __forceinline__ int v_rd_base(int lane) { return ((lane & 3) << 3) | (((lane >> 2) & 3) << 6) | (((lane >> 4) & 1) << 5) | (((lane >> 5) & 1) << 8); }
template <int OFF> __device__ __forceinline__ s16x4 tr_read(int vb) {
    s16x4 r; asm volatile("ds_read_b64_tr_b16 %0, %1 offset:%2" : "=&v"(r) : "v"(vb), "i"(OFF) : "memory"); return r;
}
template <int DV, int D0> __device__ __forceinline__ void pv_one(f32x16& od, int vb, bf16x8 pa0, bf16x8 pa1, bf16x8 pa2, bf16x8 pa3) {
    constexpr int KS = 2 * (DV / 32) * 512, HF = (DV / 32) * 512, B0 = D0 * 512;
    const s16x4 l0 = tr_read<B0>(vb), h0 = tr_read<B0 + HF>(vb), l1 = tr_read<B0 + KS>(vb), h1 = tr_read<B0 + KS + HF>(vb);
    const s16x4 l2 = tr_read<B0 + 2 * KS>(vb), h2 = tr_read<B0 + 2 * KS + HF>(vb), l3 = tr_read<B0 + 3 * KS>(vb), h3 = tr_read<B0 + 3 * KS + HF>(vb);
    asm volatile("s_waitcnt lgkmcnt(0)" ::: "memory"); SBAR();
#define PK(L, H) (bf16x8){L[0], L[1], L[2], L[3], H[0], H[1], H[2], H[3]}
    od = __builtin_amdgcn_mfma_f32_32x32x16_bf16(pa0, PK(l0, h0), od, 0, 0, 0);
    od = __builtin_amdgcn_mfma_f32_32x32x16_bf16(pa1, PK(l1, h1), od, 0, 0, 0);
    od = __builtin_amdgcn_mfma_f32_32x32x16_bf16(pa2, PK(l2, h2), od, 0, 0, 0);
    od = __builtin_amdgcn_mfma_f32_32x32x16_bf16(pa3, PK(l3, h3), od, 0, 0, 0);
#undef PK
}
template <int DV> __device__ __forceinline__ void pv_all(f32x16* o, int vb, bf16x8 pa0, bf16x8 pa1, bf16x8 pa2, bf16x8 pa3) {
    pv_one<DV, 0>(o[0], vb, pa0, pa1, pa2, pa3); pv_one<DV, 1>(o[1], vb, pa0, pa1, pa2, pa3);
    if constexpr (DV == 128) { pv_one<DV, 2>(o[2], vb, pa0, pa1, pa2, pa3); pv_one<DV, 3>(o[3], vb, pa0, pa1, pa2, pa3); }
}
template <int DQK, int DV>
__device__ __forceinline__ void attn_pass(const bf16_t* __restrict__ Qb, int ldq, const bf16_t* __restrict__ Kh, int ldk, const bf16_t* __restrict__ Vh, int ldv, int seq, char* lds, f32x16* o) {
    constexpr int KROW = 2 * DQK + 16, SHM_K = 64 * KROW, SHM_V = 64 * DV * 2, KCH = DQK / 8, VCH = DV / 8, KP = 64 * KCH, VP = 64 * VCH, KN = (KP + 511) / 512, VN = (VP + 511) / 512, ND = DV / 32;
    const int tid = threadIdx.x, wid = tid >> 6, lane = tid & 63, r32 = lane & 31, hi = lane >> 5;
    char* V_lds = lds; char* K_lds = lds + 2 * SHM_V;
    float* wsf = (float*)(lds + 2 * SHM_V + 2 * SHM_K) + wid * 64; float* li_l = wsf; float* al_l = wsf + 32;
    float m_reg = -1e30f, l_reg = 0; bf16x8 qr[DQK / 16];
#pragma unroll
    for (int d = 0; d < ND; ++d) o[d] = f32x16{};
    const bf16_t* Qw = Qb + (size_t)(wid * 32 + r32) * ldq + hi * 8;
#pragma unroll
    for (int d0 = 0; d0 < DQK / 16; ++d0) qr[d0] = *reinterpret_cast<const bf16x8*>(Qw + d0 * 16);
    unsigned koff[KN], voff[VN]; int kdst[KN], vdst[VN]; bool kval[KN], vval[VN];
#pragma unroll
    for (int i = 0; i < KN; ++i) { const int p = tid + 512 * i, row = p / KCH, ch = p % KCH; kval[i] = p < KP; koff[i] = (unsigned)(row * ldk + ch * 8) * 2u; kdst[i] = row * KROW + ch * 16; }
#pragma unroll
    for (int i = 0; i < VN; ++i) { const int p = tid + 512 * i, row = p / VCH, ch = p % VCH; vval[i] = p < VP; voff[i] = (unsigned)(row * ldv + ch * 8) * 2u; vdst[i] = v_st<DV>(row, ch * 8); }
    const int vb0 = (int)(uintptr_t)V_lds + v_rd_base(lane);
    bf16x8 sk[2][KN], sv[2][VN];
#define KOK(q_) (512 * (q_) + 511 < KP || kval[q_])
#define VOK(q_) (512 * (q_) + 511 < VP || vval[q_])
#define SLOAD(i, k0) do { const char* vb_ = (const char*)Vh + (size_t)(k0) * ldv * 2; const char* kb_ = (const char*)Kh + (size_t)(k0) * ldk * 2; \
    _Pragma("unroll") for (int q_ = 0; q_ < VN; ++q_) if (VOK(q_)) sv[i][q_] = *reinterpret_cast<const bf16x8*>(vb_ + voff[q_]); \
    _Pragma("unroll") for (int q_ = 0; q_ < KN; ++q_) if (KOK(q_)) sk[i][q_] = *reinterpret_cast<const bf16x8*>(kb_ + koff[q_]); } while (0)
#define SWRITE(b, i) do { _Pragma("unroll") for (int q_ = 0; q_ < VN; ++q_) if (VOK(q_)) *(bf16x8*)(V_lds + (b) * SHM_V + vdst[q_]) = sv[i][q_]; \
    _Pragma("unroll") for (int q_ = 0; q_ < KN; ++q_) if (KOK(q_)) *(bf16x8*)(K_lds + (b) * SHM_K + kdst[q_]) = sk[i][q_]; } while (0)
#define RESC(a) do { if (__any((a) < 1.f)) { if (hi == 0) al_l[r32] = (a); asm volatile("s_waitcnt lgkmcnt(0)" ::: "memory"); \
    _Pragma("unroll") for (int d = 0; d < ND; ++d) _Pragma("unroll") for (int r = 0; r < 16; ++r) o[d][r] *= al_l[crow(r, hi)]; } } while (0)
    f32x16 pA0, pA1, pB0, pB1; float mnA, mnB, alA, alB; bf16x8 pa0, pa1, pa2, pa3; const int NT = seq / 64;
    SLOAD(0, 0); SWRITE(0, 0); __syncthreads();
    qkt<DQK>(pA0, pA1, K_lds, qr, r32, hi); partialSM<DQK>(pA0, pA1, m_reg, mnA, alA);
    SLOAD(1, 64); if (2 < NT) SLOAD(0, 128);
    SWRITE(1, 1); __syncthreads();
    for (int j = 1; j + 1 < NT; j += 2) {
        SBAR(); qkt<DQK>(pB0, pB1, K_lds + SHM_K, qr, r32, hi);
        finishSM(pA0, pA1, alA, l_reg, pa0, pa1, pa2, pa3); SBAR();
        SLOAD(1, (j + 2) * 64); SBAR();
        pv_all<DV>(o, vb0, pa0, pa1, pa2, pa3); partialSM<DQK>(pB0, pB1, m_reg, mnB, alB);
        __syncthreads(); SWRITE(0, 0);
        RESC(alB); __syncthreads();
        SBAR(); qkt<DQK>(pA0, pA1, K_lds, qr, r32, hi);
        finishSM(pB0, pB1, alB, l_reg, pa0, pa1, pa2, pa3); SBAR();
        if (j + 3 < NT) SLOAD(0, (j + 3) * 64); SBAR();
        pv_all<DV>(o, vb0 + SHM_V, pa0, pa1, pa2, pa3); partialSM<DQK>(pA0, pA1, m_reg, mnA, alA);
        __syncthreads(); SWRITE(1, 1);
        RESC(alA); __syncthreads();
    }
    SBAR(); qkt<DQK>(pB0, pB1, K_lds + SHM_K, qr, r32, hi);
    finishSM(pA0, pA1, alA, l_reg, pa0, pa1, pa2, pa3); SBAR();
    pv_all<DV>(o, vb0, pa0, pa1, pa2, pa3); partialSM<DQK>(pB0, pB1, m_reg, mnB, alB);
    __syncthreads(); RESC(alB);
    finishSM(pB0, pB1, alB, l_reg, pa0, pa1, pa2, pa3); SBAR();
    pv_all<DV>(o, vb0 + SHM_V, pa0, pa1, pa2, pa3);
    if (hi == 0) li_l[r32] = l_reg; asm volatile("s_waitcnt lgkmcnt(0)" ::: "memory");
#pragma unroll
    for (int r = 0; r < 16; ++r) { const float rl = __builtin_amdgcn_rcpf(li_l[crow(r, hi)]);
#pragma unroll
        for (int d = 0; d < ND; ++d) o[d][r] *= rl; }
    __syncthreads();
#undef SLOAD
#undef SWRITE
#undef RESC
#undef KOK
#undef VOK
}

constexpr int OT_STRIDE = 132;
template <int ND> __device__ __forceinline__ void o_to_lds(const f32x16* o, LAS float* T, int r32, int hi) {
#pragma unroll
    for (int d = 0; d < ND; ++d)
#pragma unroll
        for (int r = 0; r < 16; ++r) T[crow(r, hi) * OT_STRIDE + d * 32 + r32] = o[d][r];
    asm volatile("s_waitcnt lgkmcnt(0)" ::: "memory");
}
__device__ __forceinline__ void attn_phase(const Params& P, const Frame& F) {
    const bf16_t* QA = (const bf16_t*)(P.ws + WS_QA); const bf16_t* KA = (const bf16_t*)(P.ws + WS_KA); const bf16_t* VA = (const bf16_t*)(P.ws + WS_VA);
    const bf16_t* QB = (const bf16_t*)(P.ws + WS_QB); const bf16_t* KB = (const bf16_t*)(P.ws + WS_KB); const bf16_t* VB = (const bf16_t*)(P.ws + WS_VB);
    bf16_t* CAT = (bf16_t*)(P.ws + WS_CAT);
    float* SCR = (float*)(P.ws + WS_SCR) + ((size_t)F.bid * NWAVES + F.wave) * 4096;
    const float lam = *(const float*)(P.ws + WS_LAM);
    const int vcu = (F.G % 8 == 0) ? (F.bid % 8) * (F.G / 8) + F.bid / 8 : F.bid;
    const int r32 = F.lane & 31, hi = F.lane >> 5, erow = F.lane >> 1, ehalf = F.lane & 1;
    char* lds = (char*)F.lds;
    LAS float* T = (LAS float*)(F.lds + F.wave * (32 * OT_STRIDE * 4));
    int u = vcu;
    for (; u < 512; u += F.G) {
        {
            const int b = u >> 5, h = (u >> 3) & 3, qb = u & 7;
            const size_t krow0 = (size_t)b * TPB, qrow0 = krow0 + CTXL + qb * 256;
            { f32x16 o[4];
              attn_pass<64, 128>(QA + qrow0 * 512 + h * 128, 512, KA + krow0 * 512 + h * 128, 512, VA + krow0 * 512 + h * 128, 512, TPB, lds, o);
              o_to_lds<4>(o, T, r32, hi); }
#pragma unroll 4
            for (int q = 0; q < 16; ++q) *(f32x4*)(SCR + erow * 128 + ehalf * 64 + 4 * q) = *(const LAS f32x4*)(T + erow * OT_STRIDE + ehalf * 64 + 4 * q);
            __syncthreads();
            { f32x16 o[4];
              attn_pass<64, 128>(QA + qrow0 * 512 + h * 128 + 64, 512, KA + krow0 * 512 + h * 128 + 64, 512, VA + krow0 * 512 + h * 128, 512, TPB, lds, o);
              o_to_lds<4>(o, T, r32, hi); }
            float ss = 0.f;
#pragma unroll 4
            for (int q = 0; q < 16; ++q) { LAS f32x4* tp = (LAS f32x4*)(T + erow * OT_STRIDE + ehalf * 64 + 4 * q);
                const f32x4 cv = *(const f32x4*)(SCR + erow * 128 + ehalf * 64 + 4 * q) - *tp * lam; *tp = cv;
                ss += (cv[0] * cv[0] + cv[1] * cv[1]) + (cv[2] * cv[2] + cv[3] * cv[3]); }
            ss += __shfl_xor(ss, 1);
            const float rstd = rsqrtf(ss * (1.f / 128.f) + EPS) * 0.8f;
            asm volatile("s_waitcnt lgkmcnt(0)" ::: "memory");
            bf16_t* dst = CAT + ((size_t)b * SEQ + qb * 256 + F.wave * 32 + erow) * DM + h * 128 + ehalf * 64;
#pragma unroll 2
            for (int q = 0; q < 8; ++q) { const LAS f32x4* tp = (const LAS f32x4*)(T + erow * OT_STRIDE + ehalf * 64 + 8 * q);
                const f32x4 g0 = *(const f32x4*)(P.diff_subln + ehalf * 64 + 8 * q), g1 = *(const f32x4*)(P.diff_subln + ehalf * 64 + 8 * q + 4);
                *(u32x4*)(dst + 8 * q) = pack8(tp[0] * g0 * rstd, tp[1] * g1 * rstd); }
            __syncthreads();
        }
    }
    for (; u < 1536; u += F.G) {
        {
            const int v = u - 512, b = v >> 6, h = (v >> 3) & 7, qb = v & 7;
            const size_t krow0 = (size_t)b * TPB, qrow0 = krow0 + CTXL + qb * 256;
            { f32x16 o[2];
              attn_pass<96, 64>(QB + qrow0 * 768 + h * 96, 768, KB + krow0 * 768 + h * 96, 768, VB + krow0 * 512 + h * 64, 512, TPB, lds, o);
              o_to_lds<2>(o, T, r32, hi); }
            bf16_t* dst = CAT + ((size_t)b * SEQ + qb * 256 + F.wave * 32 + erow) * DM + 512 + h * 64 + ehalf * 32;
#pragma unroll
            for (int q = 0; q < 4; ++q) { const LAS f32x4* tp = (const LAS f32x4*)(T + erow * OT_STRIDE + ehalf * 32 + 8 * q); *(u32x4*)(dst + 8 * q) = pack8(tp[0], tp[1]); }
            __syncthreads();
        }
    }
}

__device__ __forceinline__ void p8_phase(const Params& P, const Frame& F) {
    for (int r = F.gwi; r < MLAT; r += F.ngw) {
        float* row = P.out + (size_t)r * DM; f32x4 v[4]; float s = 0.f;
#pragma unroll
        for (int j = 0; j < 4; ++j) { v[j] = *(const f32x4*)(row + 4 * F.lane + 256 * j); s += (v[j].x * v[j].x + v[j].y * v[j].y) + (v[j].z * v[j].z + v[j].w * v[j].w); }
        const float rstd = rsqrtf(wave_sum(s) * (1.f / DM) + EPS);
#pragma unroll
        for (int j = 0; j < 4; ++j) { const f32x4 g = *(const f32x4*)(P.final_norm + 4 * F.lane + 256 * j); *(f32x4*)(row + 4 * F.lane + 256 * j) = v[j] * rstd * g; }
    }
}

constexpr int LDS_BYTES = 147456;
constexpr int NPHASE = 9;
__global__ void __launch_bounds__(NTHREADS, 2) mk_kernel(Params P, int lo, int hi) {
    extern __shared__ __attribute__((aligned(16))) unsigned char lds_raw[];
    Frame F; F.tid = threadIdx.x; F.lane = F.tid & 63; F.wave = __builtin_amdgcn_readfirstlane(F.tid >> 6); F.G = gridDim.x; F.bid = blockIdx.x;
    F.gwi = F.wave * F.G + F.bid; F.ngw = F.G * NWAVES; F.lds = (LAS unsigned char*)lds_raw;
    cg::grid_group grid = cg::this_grid();
#define IN(k) (lo <= (k) && (k) < hi)
#define SEAM(k) do { if (IN(k) && IN((k) + 1)) grid.sync(); } while (0)
    bf16_t* WS16 = (bf16_t*)P.ws; (void)WS16;
    if (IN(0)) p0_phase(P, F);
    SEAM(0);
    if (IN(1)) p1_phase(P, F);
    SEAM(1);
    if (IN(2)) {
        TileOrder S; S.init(MROWS / 256, NIN / 256, F.G, F.bid);
        EpiQKV E{(bf16_t*)(P.ws + WS_QA), (bf16_t*)(P.ws + WS_KA), (bf16_t*)(P.ws + WS_VA), (bf16_t*)(P.ws + WS_CQ), (bf16_t*)(P.ws + WS_CKV), (bf16_t*)(P.ws + WS_KB),
                 (float*)(P.ws + WS_SSQQ), (float*)(P.ws + WS_SSQKV), rope_tab(P)};
        Unit u; for (int i = 0; S.next(i, u); ++i) gemm_unit_simple(F, (const bf16_t*)(P.ws + WS_H), (const bf16_t*)(P.ws + WS_WIN), 1024, u, E);
    }
    SEAM(2);
    if (IN(3)) {
        { TileOrder S; S.init(MLAT / 256, 3, F.G, F.bid); EpiQup E{(bf16_t*)(P.ws + WS_QB), (const float*)(P.ws + WS_SSQQ), rope_tab(P)};
          Unit u; for (int i = 0; S.next(i, u); ++i) { u.pm = u.pm + (u.pm >> 3) + 1; gemm_unit_simple(F, (const bf16_t*)(P.ws + WS_CQ), (const bf16_t*)(P.ws + WS_WQUP), 256, u, E); } }
        { TileOrder S; S.init(MROWS / 256, 4, F.G, F.bid); EpiKVup E{(bf16_t*)(P.ws + WS_KB), (bf16_t*)(P.ws + WS_VB), (const float*)(P.ws + WS_SSQKV)};
          Unit u; for (int i = 0; S.next(i, u); ++i) gemm_unit_simple(F, (const bf16_t*)(P.ws + WS_CKV), (const bf16_t*)(P.ws + WS_WKVUP), 128, u, E); }
    }
    SEAM(3);
    if (IN(4)) attn_phase(P, F);
    SEAM(4);
    if (IN(5)) {
        TileOrder S; S.init(MLAT / 256, 4, F.G, F.bid); EpiOut E{P.x, P.out, (bf16_t*)(P.ws + WS_A2), (const float*)(P.ws + WS_MOD), (float*)(P.ws + WS_SSQ2)};
        Unit u; for (int i = 0; S.next(i, u); ++i) gemm_unit_simple(F, (const bf16_t*)(P.ws + WS_CAT), (const bf16_t*)(P.ws + WS_WOUT), 1024, u, E);
    }
    SEAM(5);
    if (IN(6)) {
        TileOrder S; S.init(MLAT / 256, 22, F.G, F.bid); EpiFfnIn E{(bf16_t*)(P.ws + WS_G), (const float*)(P.ws + WS_SSQ2), (const float*)(P.ws + WS_BIASF)};
        Unit u; for (int i = 0; S.next(i, u); ++i) gemm_unit_simple(F, (const bf16_t*)(P.ws + WS_A2), (const bf16_t*)(P.ws + WS_WFFI), 1024, u, E);
    }
    SEAM(6);
    if (IN(7)) {
        TileOrder S; S.init(MLAT / 256, 4, F.G, F.bid); EpiFfnOut E{P.out, (const float*)(P.ws + WS_MOD)};
        Unit u; for (int i = 0; S.next(i, u); ++i) gemm_unit_simple(F, (const bf16_t*)(P.ws + WS_G), (const bf16_t*)(P.ws + WS_WFFO), FFH, u, E);
    }
    SEAM(7);
    if (IN(8)) p8_phase(P, F);
#undef IN
#undef SEAM
}

#ifndef MK_FUSED
#define MK_FUSED 1
#endif
extern "C" void kernel_launch(void* const* d_in, const int* in_sizes, int n_in, void* d_out, int out_size, void* d_ws, size_t ws_size, hipStream_t stream) {
    static int grid = 0;
    if (grid == 0) {
        if (n_in != 17 || in_sizes[0] != MLAT * DM || out_size != MLAT * DM || ws_size < WS_END) {
            fprintf(stderr, "kernel_launch: unexpected shapes: n_in %d in0 %d out %d ws %zu (need %zu)\n", n_in, n_in > 0 ? in_sizes[0] : -1, out_size, ws_size, (size_t)WS_END); grid = -1; return; }
        if (hipFuncSetAttribute((const void*)mk_kernel, hipFuncAttributeMaxDynamicSharedMemorySize, LDS_BYTES) != hipSuccess) { fprintf(stderr, "kernel_launch: hipFuncSetAttribute failed\n"); grid = -1; return; }
        int dev = 0, cus = 0, per_cu = 0;
        (void)hipGetDevice(&dev); (void)hipDeviceGetAttribute(&cus, hipDeviceAttributeMultiprocessorCount, dev);
        if (hipOccupancyMaxActiveBlocksPerMultiprocessor(&per_cu, (const void*)mk_kernel, NTHREADS, LDS_BYTES) != hipSuccess || per_cu < 1) { fprintf(stderr, "kernel_launch: occupancy query says %d blocks/CU\n", per_cu); per_cu = 1; }
        (void)hipGetLastError();
        grid = cus;
        if (grid <= 0) grid = 256;
    }
    if (grid < 0) return;
    (void)hipMemsetAsync(d_ws, 0, CTL_BYTES, stream);
    Params p{};
    p.x = (const float*)d_in[0]; p.c = (const float*)d_in[1]; p.ctx = (const float*)d_in[2]; p.c_ctx = (const float*)d_in[3]; p.w_ada = (const float*)d_in[4]; p.b_ada = (const float*)d_in[5];
    p.w_in = (const float*)d_in[6]; p.q_a_norm = (const float*)d_in[7]; p.kv_a_norm = (const float*)d_in[8]; p.w_q_up = (const float*)d_in[9]; p.w_kv_up = (const float*)d_in[10];
    p.diff_lambda = (const float*)d_in[11]; p.diff_subln = (const float*)d_in[12]; p.w_out = (const float*)d_in[13]; p.w_ffn_in = (const float*)d_in[14]; p.w_ffn_out = (const float*)d_in[15];
    p.final_norm = (const float*)d_in[16]; p.out = (float*)d_out; p.ws = (unsigned char*)d_ws;
#if MK_FUSED
    int lo = 0, hi = NPHASE; void* args[] = {&p, &lo, &hi};
    hipError_t e = hipLaunchCooperativeKernel((const void*)mk_kernel, dim3(grid), dim3(NTHREADS), args, LDS_BYTES, stream);
    if (e != hipSuccess) fprintf(stderr, "kernel_launch: cooperative launch failed: %s (grid %d)\n", hipGetErrorString(e), grid);
#else
    for (int ph = 0; ph < NPHASE; ++ph) {
        hipLaunchKernelGGL(mk_kernel, dim3(grid), dim3(NTHREADS), LDS_BYTES, stream, p, ph, ph + 1);
        const hipError_t le = hipPeekAtLastError();
        if (le != hipSuccess) { fprintf(stderr, "kernel_launch: launch %d failed: %s\n", ph, hipGetErrorName(le)); break; }
    }
#endif
}
```

```cpp
#include <hip/hip_runtime.h>
#include <hip/hip_cooperative_groups.h>
#include <cstdint>
#include <cstdio>
namespace cg = cooperative_groups;

#define LAS __attribute__((address_space(3)))
typedef unsigned short bf16_t;
typedef short bf16x8 __attribute__((ext_vector_type(8)));
typedef short s16x4 __attribute__((ext_vector_type(4)));
typedef float f32x2 __attribute__((ext_vector_type(2)));
typedef float f32x4 __attribute__((ext_vector_type(4)));
typedef float f32x16 __attribute__((ext_vector_type(16)));
typedef unsigned u32x2 __attribute__((ext_vector_type(2)));
typedef unsigned u32x4 __attribute__((ext_vector_type(4)));
typedef __bf16 bf16x2_t __attribute__((ext_vector_type(2)));

constexpr int DM = 1024, NB = 16, SEQ = 2048, CTXL = 256, TPB = SEQ + CTXL;
constexpr int MROWS = NB * TPB, MLAT = NB * SEQ;
constexpr int FFH = 2816, NIN = 2048, NADA = 6 * DM;
constexpr float EPS = 1e-6f;
constexpr int NWAVES = 8, NTHREADS = 512;

constexpr size_t KiB = 1024, MiB = 1024 * 1024;
constexpr size_t WS_MOD = 0, WS_BIASF = 512 * KiB, WS_SSQQ = 1024 * KiB, WS_SSQKV = 1184 * KiB, WS_SSQ2 = 1344 * KiB, WS_LAM = 1536 * KiB, WS_BAR = 1792 * KiB;
constexpr size_t CTL_BYTES = 2 * MiB;
constexpr size_t WS_TAB = 2 * MiB;
constexpr size_t WS_WIN = 3 * MiB, WS_WQUP = 7 * MiB, WS_WKVUP = 7 * MiB + 512 * KiB, WS_WOUT = 8 * MiB, WS_WFFI = 10 * MiB, WS_WFFO = 21 * MiB;
constexpr size_t WS_A2 = 27 * MiB, WS_CAT = 91 * MiB;
constexpr size_t WS_H = 155 * MiB, WS_QB = 155 * MiB, WS_QA = 227 * MiB, WS_KA = 263 * MiB, WS_VA = 299 * MiB, WS_CQ = 335 * MiB, WS_CKV = 353 * MiB;
constexpr size_t WS_KB = 362 * MiB, WS_VB = 416 * MiB, WS_SCR = 452 * MiB, WS_G = 155 * MiB, WS_END = 484 * MiB;
static_assert(WS_G + (size_t)MLAT * FFH * 2 <= WS_CQ, "G overlay");
static_assert(WS_WFFO + (size_t)DM * FFH * 2 <= WS_A2, "wffo");

struct Params {
    const float *x, *c, *ctx, *c_ctx, *w_ada, *b_ada, *w_in, *q_a_norm, *kv_a_norm, *w_q_up, *w_kv_up, *diff_lambda, *diff_subln, *w_out, *w_ffn_in, *w_ffn_out, *final_norm;
    float* out; unsigned char* ws;
};

__device__ __forceinline__ unsigned cvtpk(float lo, float hi) { f32x2 v = {lo, hi}; bf16x2_t b = __builtin_convertvector(v, bf16x2_t); return __builtin_bit_cast(unsigned, b); }
__device__ __forceinline__ float wave_sum(float v) {
#pragma unroll
    for (int o = 1; o < 64; o <<= 1) v += __shfl_xor(v, o);
    return v;
}
__device__ __forceinline__ float silu_f(float v) { return v / (1.f + __expf(-v)); }
__device__ __forceinline__ u32x4 pack8(f32x4 a, f32x4 b) { u32x4 w; w.x = cvtpk(a[0], a[1]); w.y = cvtpk(a[2], a[3]); w.z = cvtpk(b[0], b[1]); w.w = cvtpk(b[2], b[3]); return w; }
__device__ __forceinline__ int ropeA_L(int q) { return 4 * ((q >> 3) & 3) + (q & 3) + 16 * ((q >> 2) & 1); }
__device__ __forceinline__ int ropeB_L(int q) { const int a = q >> 3, n = (q >> 2) & 1, j = q & 3; return (a >> 1) * 16 + (a & 1) * 4 + j + 8 * n; }

struct Frame { int tid, lane, wave, G, bid, gwi, ngw; LAS unsigned char* lds; };

__device__ __forceinline__ void p0_ada_task(const Params& P, float* MOD, int t, int lane) {
    const int cgp = t % 24, kc = t / 24, k0 = kc * 32, n = cgp * 256 + lane * 4, k = k0 + (lane & 31);
    float sv[17];
#pragma unroll
    for (int b = 0; b < 16; ++b) sv[b] = silu_f(P.c[b * DM + k]);
    sv[16] = silu_f(P.c_ctx[k]);
    f32x4 acc[17];
    const f32x4 binit = (kc == 0) ? *(const f32x4*)(P.b_ada + n) : (f32x4){0.f, 0.f, 0.f, 0.f};
#pragma unroll
    for (int b = 0; b < 17; ++b) acc[b] = binit;
#pragma unroll 2
    for (int kk = 0; kk < 32; ++kk) {
        const f32x4 w = *(const f32x4*)(P.w_ada + (size_t)(k0 + kk) * NADA + n);
#pragma unroll
        for (int b = 0; b < 17; ++b) { const float s = __shfl(sv[b], kk); acc[b] += w * s; }
    }
#pragma unroll
    for (int b = 0; b < 17; ++b)
#pragma unroll
        for (int j = 0; j < 4; ++j) atomicAdd(&MOD[b * NADA + n + j], acc[b][j]);
}
__device__ __forceinline__ int src_col(int mat, int p) {
    switch (mat) {
    case 0: if (p < 1024) return (p & ~31) + ropeA_L(p & 31); if (p < 1920) return p; if (p < 1952) return 1920 + ropeB_L(p - 1920); return -1;
    case 1: if (p < 512) return (p >> 6) * 96 + (p & 63); { const int q = p - 512; return (q >> 5) * 96 + 64 + ropeB_L(q & 31); }
    case 2: if (p < 512) return (p >> 6) * 128 + (p & 63); { const int q = p - 512; return (q >> 6) * 128 + 64 + (q & 63); }
    case 4: { const int t = p >> 8, q = p & 255; return q < 128 ? 128 * t + q : FFH + 128 * t + (q - 128); }
    default: return p;
    }
}
__device__ __forceinline__ void p0_transpose_item(const float* W, int K, int N, const float* gain, bf16_t* WT, int mat, int npb, LAS float* scr, int item, int lane) {
    const int kb = item / npb, pb = item % npb, k0 = 64 * kb, p0 = 32 * pb;
    const int sc = src_col(mat, p0 + (lane & 31));
#pragma unroll 8
    for (int i = 0; i < 32; ++i) { const int kk = 2 * i + (lane >> 5);
        float v = 0.f; if (sc >= 0) { v = W[(size_t)(k0 + kk) * N + sc]; if (gain) v *= gain[k0 + kk]; }
        scr[kk * 33 + (lane & 31)] = v; }
    asm volatile("s_waitcnt lgkmcnt(0)" ::: "memory");
    const int c = lane & 7;
#pragma unroll
    for (int j = 0; j < 4; ++j) { const int n = (lane >> 3) + 8 * j; const LAS float* s = scr + (8 * c) * 33 + n;
        u32x4 o; o.x = cvtpk(s[0 * 33], s[1 * 33]); o.y = cvtpk(s[2 * 33], s[3 * 33]); o.z = cvtpk(s[4 * 33], s[5 * 33]); o.w = cvtpk(s[6 * 33], s[7 * 33]);
        *(u32x4*)(WT + (size_t)(p0 + n) * K + k0 + 8 * c) = o; }
    asm volatile("s_waitcnt lgkmcnt(0)" ::: "memory");
}
__device__ __forceinline__ void sincos_d(double a, float& s, float& c) {
    const double k = __builtin_rint(a * 0.15915494309189535);
    double r = __builtin_fma(-k, 6.283185307179586, a); r = __builtin_fma(-k, 2.4492935982947064e-16, r);
    const double r2 = r * r; double ts = r, tc = 1.0, ss = r, cc = 1.0;
    for (int n = 0; n < 14; ++n) { tc = -tc * r2 / (double)((2 * n + 1) * (2 * n + 2)); cc += tc; ts = -ts * r2 / (double)((2 * n + 2) * (2 * n + 3)); ss += ts; }
    s = (float)ss; c = (float)cc;
}
__device__ __forceinline__ void p0_phase(const Params& P, const Frame& F) {
    float* MOD = (float*)(P.ws + WS_MOD);
    LAS float* scr = (LAS float*)(F.lds + F.wave * 8448);
    constexpr int NADA_T = 24 * 32;
    constexpr int I0 = 16 * 64, I1 = 4 * 24, I2 = 2 * 32, I3 = 16 * 32, I4 = 16 * 176, I5 = 44 * 32;
    constexpr int NT = NADA_T + I0 + I1 + I2 + I3 + I4 + I5;
    for (int t = F.gwi; t < NT; t += F.ngw) {
        int r = t;
        if (r < NADA_T) { p0_ada_task(P, MOD, r, F.lane); continue; } r -= NADA_T;
        if (r < I0) { p0_transpose_item(P.w_in, 1024, 1952, nullptr, (bf16_t*)(P.ws + WS_WIN), 0, 64, scr, r, F.lane); continue; } r -= I0;
        if (r < I1) { p0_transpose_item(P.w_q_up, 256, 768, P.q_a_norm, (bf16_t*)(P.ws + WS_WQUP), 1, 24, scr, r, F.lane); continue; } r -= I1;
        if (r < I2) { p0_transpose_item(P.w_kv_up, 128, 1024, P.kv_a_norm, (bf16_t*)(P.ws + WS_WKVUP), 2, 32, scr, r, F.lane); continue; } r -= I2;
        if (r < I3) { p0_transpose_item(P.w_out, 1024, 1024, nullptr, (bf16_t*)(P.ws + WS_WOUT), 3, 32, scr, r, F.lane); continue; } r -= I3;
        if (r < I4) { p0_transpose_item(P.w_ffn_in, 1024, 2 * FFH, nullptr, (bf16_t*)(P.ws + WS_WFFI), 4, 176, scr, r, F.lane); continue; } r -= I4;
        p0_transpose_item(P.w_ffn_out, FFH, 1024, nullptr, (bf16_t*)(P.ws + WS_WFFO), 5, 32, scr, r, F.lane);
    }
    if (F.bid == F.G - 1) {
        float* TAB = (float*)(P.ws + WS_TAB);
        for (int i = F.tid; i < 1536; i += NTHREADS) {
            float s, c;
            if (i < 1024) { const int pos = i >> 4, f = i & 15; double inv = 1.0; for (int q = 0; q < f; ++q) inv *= 0.5623413251903491; sincos_d((double)pos * inv, s, c); TAB[i] = c; TAB[1024 + i] = s; }
            else { const int e = i - 1024, pos = e >> 3, f = e & 7; double inv = 1.0; for (int q = 0; q < f; ++q) inv *= 0.31622776601683794; sincos_d((double)pos * inv, s, c); TAB[2048 + e] = c; TAB[2560 + e] = s; }
        }
        if (F.wave == 0) {
            const float* lp = P.diff_lambda; const float a = wave_sum(lp[F.lane] * lp[64 + F.lane]), b = wave_sum(lp[128 + F.lane] * lp[192 + F.lane]);
            if (F.lane == 0) *(float*)(P.ws + WS_LAM) = __expf(a) - __expf(b) + 0.2f;
        }
    }
}

__device__ __forceinline__ void p1_phase(const Params& P, const Frame& F) {
    const float* MOD = (const float*)(P.ws + WS_MOD);
    bf16_t* H = (bf16_t*)(P.ws + WS_H);
    for (int r = F.gwi; r < MROWS; r += F.ngw) {
        const int b = r / TPB, t = r - b * TPB;
        const float* src = (t < CTXL) ? P.ctx + ((size_t)b * CTXL + t) * DM : P.x + ((size_t)b * SEQ + (t - CTXL)) * DM;
        const float* mp = MOD + (size_t)((t < CTXL) ? 16 : b) * NADA;
        f32x4 v[4]; float s = 0.f;
#pragma unroll
        for (int j = 0; j < 4; ++j) { v[j] = *(const f32x4*)(src + 4 * F.lane + 256 * j); s += (v[j].x * v[j].x + v[j].y * v[j].y) + (v[j].z * v[j].z + v[j].w * v[j].w); }
        const float rstd = rsqrtf(wave_sum(s) * (1.f / DM) + EPS);
#pragma unroll
        for (int j = 0; j < 4; ++j) { const int col = 4 * F.lane + 256 * j; const f32x4 sh = *(const f32x4*)(mp + col), sc = *(const f32x4*)(mp + DM + col);
            const f32x4 h = v[j] * rstd * (sc + 1.f) + sh; u32x2 w; w.x = cvtpk(h[0], h[1]); w.y = cvtpk(h[2], h[3]);
            *(u32x2*)(H + (size_t)r * DM + col) = w; }
    }
    if (F.gwi < 22 * 16) {
        float* BIASF = (float*)(P.ws + WS_BIASF);
        const int cgp = F.gwi % 22, kc = F.gwi / 22, k0 = kc * 64, n = cgp * 256 + F.lane * 4;
        float sv[16];
#pragma unroll
        for (int b = 0; b < 16; ++b) sv[b] = MOD[(size_t)b * NADA + 3 * DM + k0 + F.lane];
        f32x4 acc[16];
#pragma unroll
        for (int b = 0; b < 16; ++b) acc[b] = (f32x4){0.f, 0.f, 0.f, 0.f};
#pragma unroll 2
        for (int kk = 0; kk < 64; ++kk) {
            const f32x4 w = *(const f32x4*)(P.w_ffn_in + (size_t)(k0 + kk) * (2 * FFH) + n);
#pragma unroll
            for (int b = 0; b < 16; ++b) { const float s = __shfl(sv[b], kk); acc[b] += w * s; }
        }
#pragma unroll
        for (int b = 0; b < 16; ++b)
#pragma unroll
            for (int j = 0; j < 4; ++j) atomicAdd(&BIASF[b * (2 * FFH) + n + j], acc[b][j]);
    }
}

struct Unit { int pm, pn; };
__device__ __forceinline__ int perm32(int rho) { const int n = rho >> 4, i = rho & 15; return 8 * (i >> 2) + 4 * n + (i & 3); }
struct TileOrder {
    int nM, nN, nwg, G, c;
    __device__ __forceinline__ void init(int nM_, int nN_, int G_, int c_) { nM = nM_; nN = nN_; nwg = nM * nN; G = G_; c = c_; }
    __device__ __forceinline__ bool next(int i, Unit& u) const {
        const long L = (long)i * G + c; if (L >= nwg) return false;
        int wgid = (int)L; { const int q = nwg / 8, r = nwg % 8, xcd = wgid % 8, off = wgid / 8; wgid = (xcd < r ? xcd * (q + 1) : r * (q + 1) + (xcd - r) * q) + off; }
        const int nig = 8 * nN, gid = wgid / nig, fm = gid * 8, gsz = (nM - fm) < 8 ? (nM - fm) : 8;
        u.pm = fm + ((wgid % nig) % gsz); u.pn = (wgid % nig) / gsz; return true;
    }
};
typedef f32x4 Acc[2][2][4][2];
constexpr int SG_STRIDE = 144;
template <class Epi>
__device__ __forceinline__ void gemm_unit_simple(const Frame& F, const bf16_t* A, const bf16_t* Bt, int K, const Unit u, const Epi& E) {
    const int wr = F.wave >> 2, wc = F.wave & 3, fr = F.lane & 15, fq = F.lane >> 4;
    LAS unsigned char* As = F.lds; LAS unsigned char* Bs = F.lds + 256 * SG_STRIDE;
    Acc acc;
#pragma unroll
    for (int a = 0; a < 2; ++a)
#pragma unroll
        for (int b = 0; b < 2; ++b)
#pragma unroll
            for (int m = 0; m < 4; ++m)
#pragma unroll
                for (int n = 0; n < 2; ++n) acc[a][b][m][n] = (f32x4){0.f, 0.f, 0.f, 0.f};
    const bf16_t* Ag = A + (size_t)u.pm * 256 * K; const bf16_t* Bg = Bt + (size_t)u.pn * 256 * K;
#pragma unroll 1
    for (int kt = 0; kt < K; kt += 64) {
        __syncthreads();
#pragma unroll
        for (int i = 0; i < 4; ++i) { const int p = F.tid + 512 * i, row = p >> 3, ch = p & 7;
            const u32x4 va = *(const u32x4*)(Ag + (size_t)row * K + kt + ch * 8), vb = *(const u32x4*)(Bg + (size_t)row * K + kt + ch * 8);
            *(LAS u32x4*)(As + row * SG_STRIDE + ch * 16) = va; *(LAS u32x4*)(Bs + row * SG_STRIDE + ch * 16) = vb; if (i & 1) asm volatile("" ::: "memory"); }
        __syncthreads();
#pragma unroll
        for (int k2 = 0; k2 < 2; ++k2) {
#pragma unroll
            for (int ai = 0; ai < 2; ++ai) {
                bf16x8 At[4];
#pragma unroll
                for (int m = 0; m < 4; ++m) At[m] = *(const LAS bf16x8*)(As + (128 * ai + 64 * wr + 16 * m + fr) * SG_STRIDE + (32 * k2 + 8 * fq) * 2);
#pragma unroll
                for (int bj = 0; bj < 2; ++bj) {
                    bf16x8 Bf[2];
#pragma unroll
                    for (int n = 0; n < 2; ++n) Bf[n] = *(const LAS bf16x8*)(Bs + (128 * bj + 32 * wc + perm32(16 * n + fr)) * SG_STRIDE + (32 * k2 + 8 * fq) * 2);
#pragma unroll
                    for (int m = 0; m < 4; ++m)
#pragma unroll
                        for (int n = 0; n < 2; ++n) acc[ai][bj][m][n] = __builtin_amdgcn_mfma_f32_16x16x32_bf16(Bf[n], At[m], acc[ai][bj][m][n], 0, 0, 0);
                }
            }
        }
    }
    E(acc, u, wr, wc, fr, fq);
}

struct RopeTab { const float *Ac, *As, *Bc, *Bs; };
__device__ __forceinline__ RopeTab rope_tab(const Params& P) { const float* T = (const float*)(P.ws + WS_TAB); return RopeTab{T, T + 1024, T + 2048, T + 2560}; }
__device__ __forceinline__ void rope_pair(f32x4& v0, f32x4& v1, const f32x4 cs, const f32x4 sn) { const f32x4 a = v0 * cs - v1 * sn, b = v1 * cs + v0 * sn; v0 = a; v1 = b; }

struct EpiQKV {
    bf16_t *QA, *KA, *VA, *CQ, *CKV, *KB; float *SSQQ, *SSQKV; RopeTab T;
    __device__ __forceinline__ void operator()(const Acc& acc, const Unit& u, int wr, int wc, int fr, int fq) const {
        const int jb = u.pm % 9; const bool lat = jb != 0; const int pn = u.pn;
        if (!lat && (pn < 2 || pn == 6)) return;
#pragma unroll
        for (int ai = 0; ai < 2; ++ai) {
            const int prow = (jb - 1) * 4 + 2 * ai + wr;
#pragma unroll
            for (int m = 0; m < 4; ++m) {
                const int pcol = 16 * m + fr; const size_t grow = (size_t)u.pm * 256 + 128 * ai + 64 * wr + 16 * m + fr;
                if (pn < 4) {
                    bf16_t* dst = (pn < 2 ? QA : KA) + grow * 512 + (pn & 1) * 256 + 32 * wc + 8 * fq;
                    const int pos = (wc & 1) ? pcol : prow;
                    f32x4 cs = {1.f, 1.f, 1.f, 1.f}, sn = {0.f, 0.f, 0.f, 0.f};
                    if (lat) { cs = *(const f32x4*)(T.Ac + pos * 16 + 4 * fq); sn = *(const f32x4*)(T.As + pos * 16 + 4 * fq); }
#pragma unroll
                    for (int bj = 0; bj < 2; ++bj) { f32x4 v0 = acc[ai][bj][m][0], v1 = acc[ai][bj][m][1]; rope_pair(v0, v1, cs, sn); *(u32x4*)(dst + 128 * bj) = pack8(v0, v1); }
                } else if (pn < 6) {
#pragma unroll
                    for (int bj = 0; bj < 2; ++bj) *(u32x4*)(VA + grow * 512 + (pn - 4) * 256 + 128 * bj + 32 * wc + 8 * fq) = pack8(acc[ai][bj][m][0], acc[ai][bj][m][1]);
                } else if (pn == 6) {
                    float s = 0.f;
#pragma unroll
                    for (int bj = 0; bj < 2; ++bj) { const f32x4 v0 = acc[ai][bj][m][0], v1 = acc[ai][bj][m][1];
                        s += (v0[0] * v0[0] + v0[1] * v0[1]) + (v0[2] * v0[2] + v0[3] * v0[3]) + (v1[0] * v1[0] + v1[1] * v1[1]) + (v1[2] * v1[2] + v1[3] * v1[3]);
                        *(u32x4*)(CQ + grow * 256 + 128 * bj + 32 * wc + 8 * fq) = pack8(v0, v1); }
                    s += __shfl_xor(s, 16); s += __shfl_xor(s, 32);
                    if (fq == 0) atomicAdd(SSQQ + grow, s);
                } else {
                    { const f32x4 v0 = acc[ai][0][m][0], v1 = acc[ai][0][m][1];
                      float s = (v0[0] * v0[0] + v0[1] * v0[1]) + (v0[2] * v0[2] + v0[3] * v0[3]) + (v1[0] * v1[0] + v1[1] * v1[1]) + (v1[2] * v1[2] + v1[3] * v1[3]);
                      *(u32x4*)(CKV + grow * 128 + 32 * wc + 8 * fq) = pack8(v0, v1);
                      s += __shfl_xor(s, 16); s += __shfl_xor(s, 32);
                      if (fq == 0) atomicAdd(SSQKV + grow, s); }
                    if (wc == 0) {
                        f32x4 v0 = acc[ai][1][m][0], v1 = acc[ai][1][m][1];
                        if (lat) { const int pos = (fq < 2) ? prow : pcol; const f32x4 cs = *(const f32x4*)(T.Bc + pos * 8 + 4 * (fq & 1)), sn = *(const f32x4*)(T.Bs + pos * 8 + 4 * (fq & 1)); rope_pair(v0, v1, cs, sn); }
                        const u32x4 w = pack8(v0, v1);
#pragma unroll
                        for (int h = 0; h < 8; ++h) *(u32x4*)(KB + grow * 768 + h * 96 + 64 + 8 * fq) = w;
                    }
                }
            }
        }
    }
};
struct EpiQup {
    bf16_t* QB; const float* SSQQ; RopeTab T;
    __device__ __forceinline__ void operator()(const Acc& acc, const Unit& u, int wr, int wc, int fr, int fq) const {
        const int jb = u.pm % 9, pn = u.pn;
#pragma unroll
        for (int ai = 0; ai < 2; ++ai) {
            const int prow = (jb - 1) * 4 + 2 * ai + wr;
#pragma unroll
            for (int m = 0; m < 4; ++m) {
                const int pcol = 16 * m + fr; const size_t grow = (size_t)u.pm * 256 + 128 * ai + 64 * wr + 16 * m + fr;
                const float rstd = rsqrtf(SSQQ[grow] * (1.f / 256.f) + EPS);
#pragma unroll
                for (int bj = 0; bj < 2; ++bj) {
                    f32x4 v0 = acc[ai][bj][m][0] * rstd, v1 = acc[ai][bj][m][1] * rstd;
                    if (pn < 2) { const int c = pn * 256 + 128 * bj + 32 * wc + 8 * fq; *(u32x4*)(QB + grow * 768 + (c >> 6) * 96 + (c & 63)) = pack8(v0, v1); }
                    else { const int h = 4 * bj + wc, pos = (fq < 2) ? prow : pcol;
                        const f32x4 cs = *(const f32x4*)(T.Bc + pos * 8 + 4 * (fq & 1)), sn = *(const f32x4*)(T.Bs + pos * 8 + 4 * (fq & 1)); rope_pair(v0, v1, cs, sn);
                        *(u32x4*)(QB + grow * 768 + h * 96 + 64 + 8 * fq) = pack8(v0, v1); }
                }
                asm volatile("" ::: "memory");
            }
        }
    }
};
struct EpiKVup {
    bf16_t *KB, *VB; const float* SSQKV;
    __device__ __forceinline__ void operator()(const Acc& acc, const Unit& u, int wr, int wc, int fr, int fq) const {
        const int pn = u.pn;
#pragma unroll
        for (int ai = 0; ai < 2; ++ai)
#pragma unroll
            for (int m = 0; m < 4; ++m) {
                const size_t grow = (size_t)u.pm * 256 + 128 * ai + 64 * wr + 16 * m + fr;
                const float rstd = rsqrtf(SSQKV[grow] * (1.f / 128.f) + EPS);
#pragma unroll
                for (int bj = 0; bj < 2; ++bj) {
                    const f32x4 v0 = acc[ai][bj][m][0] * rstd, v1 = acc[ai][bj][m][1] * rstd;
                    if (pn < 2) { const int c = pn * 256 + 128 * bj + 32 * wc + 8 * fq; *(u32x4*)(KB + grow * 768 + (c >> 6) * 96 + (c & 63)) = pack8(v0, v1); }
                    else *(u32x4*)(VB + grow * 512 + (pn - 2) * 256 + 128 * bj + 32 * wc + 8 * fq) = pack8(v0, v1);
                }
                asm volatile("" ::: "memory");
            }
    }
};
struct EpiOut {
    const float* x; float* out; bf16_t* A2; const float* MOD; float* SSQ2;
    __device__ __forceinline__ void operator()(const Acc& acc, const Unit& u, int wr, int wc, int fr, int fq) const {
        const float* mp = MOD + (size_t)(u.pm >> 3) * NADA;
#pragma unroll
        for (int ai = 0; ai < 2; ++ai)
#pragma unroll
            for (int m = 0; m < 4; ++m) {
                const size_t row = (size_t)u.pm * 256 + 128 * ai + 64 * wr + 16 * m + fr; float s = 0.f;
#pragma unroll
                for (int bj = 0; bj < 2; ++bj) {
                    const int col = u.pn * 256 + 128 * bj + 32 * wc + 8 * fq; const size_t off = row * DM + col;
                    f32x4 nv[2];
#pragma unroll
                    for (int n = 0; n < 2; ++n) { const f32x4 ga = *(const f32x4*)(mp + 2 * DM + col + 4 * n), xv = *(const f32x4*)(x + off + 4 * n);
                        nv[n] = xv + ga * acc[ai][bj][m][n]; *(f32x4*)(out + off + 4 * n) = nv[n];
                        s += (nv[n][0] * nv[n][0] + nv[n][1] * nv[n][1]) + (nv[n][2] * nv[n][2] + nv[n][3] * nv[n][3]); }
                    const f32x4 s0 = *(const f32x4*)(mp + 4 * DM + col), s1 = *(const f32x4*)(mp + 4 * DM + col + 4);
                    *(u32x4*)(A2 + off) = pack8(nv[0] * (s0 + 1.f), nv[1] * (s1 + 1.f));
                }
                s += __shfl_xor(s, 16); s += __shfl_xor(s, 32);
                if (fq == 0) atomicAdd(SSQ2 + row, s);
            }
    }
};
struct EpiFfnIn {
    bf16_t* G; const float* SSQ2; const float* BIASF;
    __device__ __forceinline__ void operator()(const Acc& acc, const Unit& u, int wr, int wc, int fr, int fq) const {
        const float* bp = BIASF + (size_t)(u.pm >> 3) * (2 * FFH); const int hc = u.pn * 128 + 32 * wc + 8 * fq;
        f32x4 bg[2], bu[2];
#pragma unroll
        for (int n = 0; n < 2; ++n) { bg[n] = *(const f32x4*)(bp + hc + 4 * n); bu[n] = *(const f32x4*)(bp + FFH + hc + 4 * n); }
#pragma unroll
        for (int ai = 0; ai < 2; ++ai)
#pragma unroll
            for (int m = 0; m < 4; ++m) {
                const size_t row = (size_t)u.pm * 256 + 128 * ai + 64 * wr + 16 * m + fr;
                const float rstd = rsqrtf(SSQ2[row] * (1.f / DM) + EPS);
                f32x4 o[2];
#pragma unroll
                for (int n = 0; n < 2; ++n) { const f32x4 g = acc[ai][0][m][n] * rstd + bg[n], up = acc[ai][1][m][n] * rstd + bu[n];
#pragma unroll
                    for (int j = 0; j < 4; ++j) o[n][j] = silu_f(g[j]) * up[j]; }
                *(u32x4*)(G + row * FFH + hc) = pack8(o[0], o[1]);
            }
    }
};
struct EpiFfnOut {
    float* out; const float* MOD;
    __device__ __forceinline__ void operator()(const Acc& acc, const Unit& u, int wr, int wc, int fr, int fq) const {
        const float* mp = MOD + (size_t)(u.pm >> 3) * NADA + 5 * DM;
#pragma unroll
        for (int ai = 0; ai < 2; ++ai)
#pragma unroll
            for (int m = 0; m < 4; ++m) {
                const size_t row = (size_t)u.pm * 256 + 128 * ai + 64 * wr + 16 * m + fr;
#pragma unroll
                for (int bj = 0; bj < 2; ++bj)
#pragma unroll
                    for (int n = 0; n < 2; ++n) { const int col = u.pn * 256 + 128 * bj + 32 * wc + 8 * fq + 4 * n; const size_t off = row * DM + col;
                        const f32x4 gf = *(const f32x4*)(mp + col), nl = *(const f32x4*)(out + off); *(f32x4*)(out + off) = nl + gf * acc[ai][bj][m][n]; }
            }
    }
};


namespace pg8 {
constexpr int BK = 64, HALF = 128, HTB = HALF * BK * 2, STAGE_BYTES = 8 * HTB;
__device__ __forceinline__ int lds_byte(int r, int c) { const int st = (r >> 4) * 2 + (c >> 5), rr = r & 15, cc = c & 31, ob = rr * 64 + cc * 2; return st * 1024 + (ob ^ (((ob >> 9) & 1) << 5)); }
__device__ __forceinline__ void stage_rc(int b, int& R, int& C) { const int st = b / 1024, sb = b % 1024, swz = sb ^ (((sb >> 9) & 1) << 5); R = (st >> 1) * 16 + swz / 64; C = (st & 1) * 32 + (swz % 64) / 2; }
struct Gemm { const bf16_t* A; const bf16_t* Bt; int K; };
template <class Epi, class Sched>
__device__ __forceinline__ void gemm_phase(LAS unsigned char* lds, const Gemm g, const Sched& S, const Epi& E) {
    const int tid = threadIdx.x, wid = __builtin_amdgcn_readfirstlane(tid >> 6), lane = tid & 63, wr = wid >> 2, wc = wid & 3, fr = lane & 15, fq = lane >> 4;
    const int K = g.K, nt = K / BK;
    unsigned voffA[2], voffB[2];
#pragma unroll
    for (int i = 0; i < 2; ++i) { int R, C; stage_rc(tid * 16 + i * 8192, R, C); const int Rb = (R & ~31) + perm32(R & 31);
        voffA[i] = (unsigned)(R * K + C) * 2u; voffB[i] = (unsigned)(Rb * K + C) * 2u; }
    const size_t kstep = (size_t)(BK * 2);
    const size_t hstep = (size_t)HALF * K * 2;
    const size_t tstep = 2 * hstep;
    const unsigned ldsw = (unsigned)wid * 1024u;
    const int aoff = lds_byte(wr * 64 + fr, fq * 8), boff = lds_byte(wc * 32 + fr, fq * 8);
#define PG8_SA(b, h) (((b) * 2 + (h)) * HTB)
#define PG8_SB(b, h) ((4 + (b) * 2 + (h)) * HTB)
#define PG8_STAGE(bufoff, gbase, voff) do { _Pragma("unroll") for (int _i = 0; _i < 2; ++_i) \
        __builtin_amdgcn_global_load_lds((const unsigned*)((const char*)(gbase) + (voff)[_i]), (LAS unsigned*)(lds + (bufoff) + ldsw + _i * 8192), 16, 0, 0); } while (0)
#define PG8_LDA(dst, b, h) do { _Pragma("unroll") for (int m = 0; m < 4; ++m) _Pragma("unroll") for (int k = 0; k < 2; ++k) dst[m][k] = *(const LAS bf16x8*)(lds + PG8_SA(b, h) + aoff + m * 2048 + k * 1024); } while (0)
#define PG8_LDB(dst, b, h) do { _Pragma("unroll") for (int n = 0; n < 2; ++n) _Pragma("unroll") for (int k = 0; k < 2; ++k) dst[n][k] = *(const LAS bf16x8*)(lds + PG8_SB(b, h) + boff + n * 2048 + k * 1024); } while (0)
#define PG8_MMA(ai, bj, At, Bt) do { __builtin_amdgcn_s_setprio(1); _Pragma("unroll") for (int m = 0; m < 4; ++m) _Pragma("unroll") for (int n = 0; n < 2; ++n) _Pragma("unroll") for (int k = 0; k < 2; ++k) \
        acc[ai][bj][m][n] = __builtin_amdgcn_mfma_f32_16x16x32_bf16(Bt[n][k], At[m][k], acc[ai][bj][m][n], 0, 0, 0); __builtin_amdgcn_s_setprio(0); } while (0)
#define PG8_WAIT_V(n) asm volatile("s_waitcnt vmcnt(" #n ")" ::: "memory")
#define PG8_WAIT_L(n) asm volatile("s_waitcnt lgkmcnt(" #n ")" ::: "memory")
#define PG8_BAR __builtin_amdgcn_s_barrier()
#define PG8_SCHED __builtin_amdgcn_sched_barrier(0)
    Unit cur, nxt; int ui = 0;
    if (!S.next(0, cur)) return;
    f32x4 acc[2][2][4][2];
#pragma unroll
    for (int a = 0; a < 2; ++a)
#pragma unroll
        for (int b = 0; b < 2; ++b)
#pragma unroll
            for (int m = 0; m < 4; ++m)
#pragma unroll
                for (int n = 0; n < 2; ++n) acc[a][b][m][n] = (f32x4){0.f, 0.f, 0.f, 0.f};
    bf16x8 At[4][2], B0[2][2], B1[2][2];
    const char* cA = (const char*)g.A + (size_t)cur.pm * tstep; const char* cB = (const char*)g.Bt + (size_t)cur.pn * tstep;
    PG8_STAGE(PG8_SB(0, 0), cB, voffB); PG8_STAGE(PG8_SB(0, 1), cB + hstep, voffB); PG8_STAGE(PG8_SA(0, 0), cA, voffA); PG8_STAGE(PG8_SA(0, 1), cA + hstep, voffA);
    if (wr == 1) PG8_BAR;
    PG8_WAIT_V(2); PG8_BAR;
    PG8_STAGE(PG8_SB(1, 0), cB + kstep, voffB); PG8_STAGE(PG8_SA(1, 0), cA + kstep, voffA); PG8_STAGE(PG8_SB(1, 1), cB + hstep + kstep, voffB);
    PG8_WAIT_V(6); PG8_BAR;
    for (;;) {
        const bool has_next = S.next(ui + 1, nxt);
        const char* nA = has_next ? (const char*)g.A + (size_t)nxt.pm * tstep : cA; const char* nB = has_next ? (const char*)g.Bt + (size_t)nxt.pn * tstep : cB;
        for (int t = 0; t < nt; t += 2) {
            const bool last = (t == nt - 2);
            const char* a1 = cA + (size_t)(t + 1) * kstep;
            const char* a2 = last ? nA : cA + (size_t)(t + 2) * kstep; const char* b2 = last ? nB : cB + (size_t)(t + 2) * kstep;
            const char* a3 = a2 + kstep; const char* b3 = b2 + kstep;
            PG8_LDB(B0, 0, 0); PG8_LDB(B1, 0, 1); PG8_SCHED; PG8_LDA(At, 0, 0); PG8_STAGE(PG8_SA(1, 1), a1 + hstep, voffA);
            PG8_WAIT_V(8); PG8_WAIT_L(0); PG8_BAR; PG8_MMA(0, 0, At, B0); PG8_MMA(0, 1, At, B1); PG8_BAR; PG8_SCHED;
            PG8_LDA(At, 0, 1); PG8_STAGE(PG8_SB(0, 0), b2, voffB); PG8_STAGE(PG8_SB(0, 1), b2 + hstep, voffB); PG8_STAGE(PG8_SA(0, 0), a2, voffA);
            PG8_WAIT_V(8); PG8_WAIT_L(0); PG8_BAR; PG8_MMA(1, 0, At, B0); PG8_MMA(1, 1, At, B1); PG8_BAR; PG8_SCHED;
            PG8_LDB(B0, 1, 0); PG8_LDB(B1, 1, 1); PG8_SCHED; PG8_LDA(At, 1, 0); PG8_STAGE(PG8_SA(0, 1), a2 + hstep, voffA);
            PG8_WAIT_V(8); PG8_WAIT_L(0); PG8_BAR; PG8_MMA(0, 0, At, B0); PG8_MMA(0, 1, At, B1); PG8_BAR; PG8_SCHED;
            PG8_LDA(At, 1, 1); PG8_STAGE(PG8_SB(1, 0), b3, voffB); PG8_STAGE(PG8_SB(1, 1), b3 + hstep, voffB); PG8_STAGE(PG8_SA(1, 0), a3, voffA);
            PG8_WAIT_V(8); PG8_WAIT_L(0); PG8_BAR; PG8_MMA(1, 0, At, B0); PG8_MMA(1, 1, At, B1); PG8_BAR; PG8_SCHED;
        }
        if (wr == 0) PG8_BAR;
        E(acc, cur, wr, wc, fr, fq);
        if (!has_next) break;
#pragma unroll
        for (int a = 0; a < 2; ++a)
#pragma unroll
            for (int b = 0; b < 2; ++b)
#pragma unroll
                for (int m = 0; m < 4; ++m)
#pragma unroll
                    for (int n = 0; n < 2; ++n) acc[a][b][m][n] = (f32x4){0.f, 0.f, 0.f, 0.f};
        cur = nxt; cA = nA; cB = nB; ++ui;
        if (wr == 1) PG8_BAR;
    }
    PG8_WAIT_V(0);
    PG8_BAR;
#undef PG8_SA
#undef PG8_SB
#undef PG8_STAGE
#undef PG8_LDA
#undef PG8_LDB
#undef PG8_MMA
#undef PG8_WAIT_V
#undef PG8_WAIT_L
#undef PG8_BAR
#undef PG8_SCHED
}
}

#define SBAR() __builtin_amdgcn_sched_barrier(0)
__device__ __forceinline__ int crow(int r, int hi) { return (r & 3) + 8 * (r >> 2) + 4 * hi; }
constexpr float ATT_THR = 8.f;
template <int DQK> struct AttC { static constexpr float SCALE = (DQK == 64) ? 0.125f : 0.10206207261596575f; static constexpr float C = SCALE * 1.4426950408889634f; };
template <int DQK>
__device__ __forceinline__ void partialSM(f32x16& p0, f32x16& p1, float& m_reg, float& mn, float& alpha) {
    constexpr float C = AttC<DQK>::C, SC = AttC<DQK>::SCALE;
    float pmax = p0[0];
#pragma unroll
    for (int r = 1; r < 16; ++r) pmax = fmaxf(pmax, p0[r]);
#pragma unroll
    for (int r = 0; r < 16; ++r) pmax = fmaxf(pmax, p1[r]);
    { auto rr = __builtin_amdgcn_permlane32_swap(__float_as_uint(pmax), __float_as_uint(pmax), false, false);
      pmax = fmaxf(__uint_as_float(rr[0]), __uint_as_float(rr[1])); }
    if (__builtin_expect(__all(pmax - m_reg <= ATT_THR / SC), 1)) { mn = m_reg; alpha = 1.f; }
    else { mn = fmaxf(m_reg, pmax); alpha = __builtin_amdgcn_exp2f((m_reg - mn) * C); m_reg = mn; }
    const float mnC = -mn * C;
#pragma unroll
    for (int r = 0; r < 16; ++r) p0[r] = fmaf(p0[r], C, mnC);
#pragma unroll
    for (int r = 0; r < 16; ++r) p1[r] = fmaf(p1[r], C, mnC);
#pragma unroll
    for (int r = 0; r < 16; ++r) p0[r] = __builtin_amdgcn_exp2f(p0[r]);
}
__device__ __forceinline__ void finishSM(f32x16& p0, f32x16& p1, float alpha, float& l_reg, bf16x8& pa0, bf16x8& pa1, bf16x8& pa2, bf16x8& pa3) {
#pragma unroll
    for (int r = 0; r < 16; ++r) p1[r] = __builtin_amdgcn_exp2f(p1[r]);
    float ps = 0;
#pragma unroll
    for (int r = 0; r < 16; ++r) ps += p0[r];
#pragma unroll
    for (int r = 0; r < 16; ++r) ps += p1[r];
    { auto rr = __builtin_amdgcn_permlane32_swap(__float_as_uint(ps), __float_as_uint(ps), false, false);
      ps = __uint_as_float(rr[0]) + __uint_as_float(rr[1]); }
    l_reg = l_reg * alpha + ps;
#define PK4(P, BASE, OUT) do { unsigned a0 = cvtpk(P[BASE + 0], P[BASE + 1]), a1 = cvtpk(P[BASE + 2], P[BASE + 3]);   \
    unsigned b0 = cvtpk(P[BASE + 4], P[BASE + 5]), b1 = cvtpk(P[BASE + 6], P[BASE + 7]);                              \
    auto r0 = __builtin_amdgcn_permlane32_swap(a0, b0, false, false); auto r1 = __builtin_amdgcn_permlane32_swap(a1, b1, false, false); \
    u32x4 w = {r0[0], r1[0], r0[1], r1[1]}; OUT = __builtin_bit_cast(bf16x8, w); } while (0)
    PK4(p0, 0, pa0); PK4(p0, 8, pa1); PK4(p1, 0, pa2); PK4(p1, 8, pa3);
#undef PK4
}
template <int DQK>
__device__ __forceinline__ void qkt(f32x16& p0, f32x16& p1, const char* Ks, const bf16x8* qr, int r32, int hi) {
    constexpr int KROW = 2 * DQK + 16;
    p0 = f32x16{}; p1 = f32x16{};
#pragma unroll
    for (int d0 = 0; d0 < DQK / 16; ++d0) { const int cb = (d0 * 16 + hi * 8) * 2;
        const bf16x8 b0 = *reinterpret_cast<const bf16x8*>(Ks + r32 * KROW + cb);
        const bf16x8 b1 = *reinterpret_cast<const bf16x8*>(Ks + (32 + r32) * KROW + cb);
        p0 = __builtin_amdgcn_mfma_f32_32x32x16_bf16(b0, qr[d0], p0, 0, 0, 0);
        p1 = __builtin_amdgcn_mfma_f32_32x32x16_bf16(b1, qr[d0], p1, 0, 0, 0); }
}
template <int DV> __device__ __forceinline__ int v_st(int k, int c) { const int kk = (k & ~0xC) | ((k & 4) << 1) | ((k & 8) >> 1); return ((kk >> 3) * (DV / 32) + (c >> 5)) * 512 + ((kk & 7) * 32 + (c & 31)) * 2; }
__device__ __forceinline__ int v_rd_base(int lane) { return ((lane & 3) << 3) | (((lane >> 2) & 3) << 6) | (((lane >> 4) & 1) << 5) | (((lane >> 5) & 1) << 8); }
template <int OFF> __device__ __forceinline__ s16x4 tr_read(int vb) {
    s16x4 r; asm volatile("ds_read_b64_tr_b16 %0, %1 offset:%2" : "=&v"(r) : "v"(vb), "i"(OFF) : "memory"); return r;
}
template <int DV, int D0> __device__ __forceinline__ void pv_one(f32x16& od, int vb, bf16x8 pa0, bf16x8 pa1, bf16x8 pa2, bf16x8 pa3) {
    constexpr int KS = 2 * (DV / 32) * 512, HF = (DV / 32) * 512, B0 = D0 * 512;
    const s16x4 l0 = tr_read<B0>(vb), h0 = tr_read<B0 + HF>(vb), l1 = tr_read<B0 + KS>(vb), h1 = tr_read<B0 + KS + HF>(vb);
    const s16x4 l2 = tr_read<B0 + 2 * KS>(vb), h2 = tr_read<B0 + 2 * KS + HF>(vb), l3 = tr_read<B0 + 3 * KS>(vb), h3 = tr_read<B0 + 3 * KS + HF>(vb);
    asm volatile("s_waitcnt lgkmcnt(0)" ::: "memory"); SBAR();
#define PK(L, H) (bf16x8){L[0], L[1], L[2], L[3], H[0], H[1], H[2], H[3]}
    od = __builtin_amdgcn_mfma_f32_32x32x16_bf16(pa0, PK(l0, h0), od, 0, 0, 0);
    od = __builtin_amdgcn_mfma_f32_32x32x16_bf16(pa1, PK(l1, h1), od, 0, 0, 0);
    od = __builtin_amdgcn_mfma_f32_32x32x16_bf16(pa2, PK(l2, h2), od, 0, 0, 0);
    od = __builtin_amdgcn_mfma_f32_32x32x16_bf16(pa3, PK(l3, h3), od, 0, 0, 0);
#undef PK
}
template <int DV> __device__ __forceinline__ void pv_all(f32x16* o, int vb, bf16x8 pa0, bf16x8 pa1, bf16x8 pa2, bf16x8 pa3) {
    pv_one<DV, 0>(o[0], vb, pa0, pa1, pa2, pa3); pv_one<DV, 1>(o[1], vb, pa0, pa1, pa2, pa3);
    if constexpr (DV == 128) { pv_one<DV, 2>(o[2], vb, pa0, pa1, pa2, pa3); pv_one<DV, 3>(o[3], vb, pa0, pa1, pa2, pa3); }
}
template <int DQK, int DV>
__device__ __forceinline__ void attn_pass(const bf16_t* __restrict__ Qb, int ldq, const bf16_t* __restrict__ Kh, int ldk, const bf16_t* __restrict__ Vh, int ldv, int seq, char* lds, f32x16* o) {
    constexpr int KROW = 2 * DQK + 16, SHM_K = 64 * KROW, SHM_V = 64 * DV * 2, KCH = DQK / 8, VCH = DV / 8, KP = 64 * KCH, VP = 64 * VCH, KN = (KP + 511) / 512, VN = (VP + 511) / 512, ND = DV / 32;
    const int tid = threadIdx.x, wid = tid >> 6, lane = tid & 63, r32 = lane & 31, hi = lane >> 5;
    char* V_lds = lds; char* K_lds = lds + 2 * SHM_V;
    float* wsf = (float*)(lds + 2 * SHM_V + 2 * SHM_K) + wid * 64; float* li_l = wsf; float* al_l = wsf + 32;
    float m_reg = -1e30f, l_reg = 0; bf16x8 qr[DQK / 16];
#pragma unroll
    for (int d = 0; d < ND; ++d) o[d] = f32x16{};
    const bf16_t* Qw = Qb + (size_t)(wid * 32 + r32) * ldq + hi * 8;
#pragma unroll
    for (int d0 = 0; d0 < DQK / 16; ++d0) qr[d0] = *reinterpret_cast<const bf16x8*>(Qw + d0 * 16);
    unsigned koff[KN], voff[VN]; int kdst[KN], vdst[VN]; bool kval[KN], vval[VN];
#pragma unroll
    for (int i = 0; i < KN; ++i) { const int p = tid + 512 * i, row = p / KCH, ch = p % KCH; kval[i] = p < KP; koff[i] = (unsigned)(row * ldk + ch * 8) * 2u; kdst[i] = row * KROW + ch * 16; }
#pragma unroll
    for (int i = 0; i < VN; ++i) { const int p = tid + 512 * i, row = p / VCH, ch = p % VCH; vval[i] = p < VP; voff[i] = (unsigned)(row * ldv + ch * 8) * 2u; vdst[i] = v_st<DV>(row, ch * 8); }
    const int vb0 = (int)(uintptr_t)V_lds + v_rd_base(lane);
    bf16x8 sk[2][KN], sv[2][VN];
#define KOK(q_) (512 * (q_) + 511 < KP || kval[q_])
#define VOK(q_) (512 * (q_) + 511 < VP || vval[q_])
#define SLOAD(i, k0) do { const char* vb_ = (const char*)Vh + (size_t)(k0) * ldv * 2; const char* kb_ = (const char*)Kh + (size_t)(k0) * ldk * 2; \
    _Pragma("unroll") for (int q_ = 0; q_ < VN; ++q_) if (VOK(q_)) sv[i][q_] = *reinterpret_cast<const bf16x8*>(vb_ + voff[q_]); \
    _Pragma("unroll") for (int q_ = 0; q_ < KN; ++q_) if (KOK(q_)) sk[i][q_] = *reinterpret_cast<const bf16x8*>(kb_ + koff[q_]); } while (0)
#define SWRITE(b, i) do { _Pragma("unroll") for (int q_ = 0; q_ < VN; ++q_) if (VOK(q_)) *(bf16x8*)(V_lds + (b) * SHM_V + vdst[q_]) = sv[i][q_]; \
    _Pragma("unroll") for (int q_ = 0; q_ < KN; ++q_) if (KOK(q_)) *(bf16x8*)(K_lds + (b) * SHM_K + kdst[q_]) = sk[i][q_]; } while (0)
#define RESC(a) do { if (__any((a) < 1.f)) { if (hi == 0) al_l[r32] = (a); asm volatile("s_waitcnt lgkmcnt(0)" ::: "memory"); \
    _Pragma("unroll") for (int d = 0; d < ND; ++d) _Pragma("unroll") for (int r = 0; r < 16; ++r) o[d][r] *= al_l[crow(r, hi)]; } } while (0)
    f32x16 pA0, pA1, pB0, pB1; float mnA, mnB, alA, alB; bf16x8 pa0, pa1, pa2, pa3; const int NT = seq / 64;
    SLOAD(0, 0); SWRITE(0, 0); __syncthreads();
    qkt<DQK>(pA0, pA1, K_lds, qr, r32, hi); partialSM<DQK>(pA0, pA1, m_reg, mnA, alA);
    SLOAD(1, 64); if (2 < NT) SLOAD(0, 128);
    SWRITE(1, 1); __syncthreads();
    for (int j = 1; j + 1 < NT; j += 2) {
        SBAR(); qkt<DQK>(pB0, pB1, K_lds + SHM_K, qr, r32, hi);
        finishSM(pA0, pA1, alA, l_reg, pa0, pa1, pa2, pa3); SBAR();
        SLOAD(1, (j + 2) * 64); SBAR();
        pv_all<DV>(o, vb0, pa0, pa1, pa2, pa3); partialSM<DQK>(pB0, pB1, m_reg, mnB, alB);
        __syncthreads(); SWRITE(0, 0);
        RESC(alB); __syncthreads();
        SBAR(); qkt<DQK>(pA0, pA1, K_lds, qr, r32, hi);
        finishSM(pB0, pB1, alB, l_reg, pa0, pa1, pa2, pa3); SBAR();
        if (j + 3 < NT) SLOAD(0, (j + 3) * 64); SBAR();
        pv_all<DV>(o, vb0 + SHM_V, pa0, pa1, pa2, pa3); partialSM<DQK>(pA0, pA1, m_reg, mnA, alA);
        __syncthreads(); SWRITE(1, 1);
        RESC(alA); __syncthreads();
    }
    SBAR(); qkt<DQK>(pB0, pB1, K_lds + SHM_K, qr, r32, hi);
    finishSM(pA0, pA1, alA, l_reg, pa0, pa1, pa2, pa3); SBAR();
    pv_all<DV>(o, vb0, pa0, pa1, pa2, pa3); partialSM<DQK>(pB0, pB1, m_reg, mnB, alB);
    __syncthreads(); RESC(alB);
    finishSM(pB0, pB1, alB, l_reg, pa0, pa1, pa2, pa3); SBAR();
    pv_all<DV>(o, vb0 + SHM_V, pa0, pa1, pa2, pa3);
    if (hi == 0) li_l[r32] = l_reg; asm volatile("s_waitcnt lgkmcnt(0)" ::: "memory");
#pragma unroll
    for (int r = 0; r < 16; ++r) { const float rl = __builtin_amdgcn_rcpf(li_l[crow(r, hi)]);
#pragma unroll
        for (int d = 0; d < ND; ++d) o[d][r] *= rl; }
    __syncthreads();
#undef SLOAD
#undef SWRITE
#undef RESC
#undef KOK
#undef VOK
}

constexpr int OT_STRIDE = 132;
template <int ND> __device__ __forceinline__ void o_to_lds(const f32x16* o, LAS float* T, int r32, int hi) {
#pragma unroll
    for (int d = 0; d < ND; ++d)
#pragma unroll
        for (int r = 0; r < 16; ++r) T[crow(r, hi) * OT_STRIDE + d * 32 + r32] = o[d][r];
    asm volatile("s_waitcnt lgkmcnt(0)" ::: "memory");
}
__device__ __forceinline__ void attn_phase(const Params& P, const Frame& F) {
    const bf16_t* QA = (const bf16_t*)(P.ws + WS_QA); const bf16_t* KA = (const bf16_t*)(P.ws + WS_KA); const bf16_t* VA = (const bf16_t*)(P.ws + WS_VA);
    const bf16_t* QB = (const bf16_t*)(P.ws + WS_QB); const bf16_t* KB = (const bf16_t*)(P.ws + WS_KB); const bf16_t* VB = (const bf16_t*)(P.ws + WS_VB);
    bf16_t* CAT = (bf16_t*)(P.ws + WS_CAT);
    float* SCR = (float*)(P.ws + WS_SCR) + ((size_t)F.bid * NWAVES + F.wave) * 4096;
    const float lam = *(const float*)(P.ws + WS_LAM);
    const int vcu = (F.G % 8 == 0) ? (F.bid % 8) * (F.G / 8) + F.bid / 8 : F.bid;
    const int r32 = F.lane & 31, hi = F.lane >> 5, erow = F.lane >> 1, ehalf = F.lane & 1;
    char* lds = (char*)F.lds;
    LAS float* T = (LAS float*)(F.lds + F.wave * (32 * OT_STRIDE * 4));
    int u = vcu;
    for (; u < 512; u += F.G) {
        {
            const int b = u >> 5, h = (u >> 3) & 3, qb = u & 7;
            const size_t krow0 = (size_t)b * TPB, qrow0 = krow0 + CTXL + qb * 256;
            { f32x16 o[4];
              attn_pass<64, 128>(QA + qrow0 * 512 + h * 128, 512, KA + krow0 * 512 + h * 128, 512, VA + krow0 * 512 + h * 128, 512, TPB, lds, o);
              o_to_lds<4>(o, T, r32, hi); }
#pragma unroll 4
            for (int q = 0; q < 16; ++q) *(f32x4*)(SCR + erow * 128 + ehalf * 64 + 4 * q) = *(const LAS f32x4*)(T + erow * OT_STRIDE + ehalf * 64 + 4 * q);
            __syncthreads();
            { f32x16 o[4];
              attn_pass<64, 128>(QA + qrow0 * 512 + h * 128 + 64, 512, KA + krow0 * 512 + h * 128 + 64, 512, VA + krow0 * 512 + h * 128, 512, TPB, lds, o);
              o_to_lds<4>(o, T, r32, hi); }
            float ss = 0.f;
#pragma unroll 4
            for (int q = 0; q < 16; ++q) { LAS f32x4* tp = (LAS f32x4*)(T + erow * OT_STRIDE + ehalf * 64 + 4 * q);
                const f32x4 cv = *(const f32x4*)(SCR + erow * 128 + ehalf * 64 + 4 * q) - *tp * lam; *tp = cv;
                ss += (cv[0] * cv[0] + cv[1] * cv[1]) + (cv[2] * cv[2] + cv[3] * cv[3]); }
            ss += __shfl_xor(ss, 1);
            const float rstd = rsqrtf(ss * (1.f / 128.f) + EPS) * 0.8f;
            asm volatile("s_waitcnt lgkmcnt(0)" ::: "memory");
            bf16_t* dst = CAT + ((size_t)b * SEQ + qb * 256 + F.wave * 32 + erow) * DM + h * 128 + ehalf * 64;
#pragma unroll 2
            for (int q = 0; q < 8; ++q) { const LAS f32x4* tp = (const LAS f32x4*)(T + erow * OT_STRIDE + ehalf * 64 + 8 * q);
                const f32x4 g0 = *(const f32x4*)(P.diff_subln + ehalf * 64 + 8 * q), g1 = *(const f32x4*)(P.diff_subln + ehalf * 64 + 8 * q + 4);
                *(u32x4*)(dst + 8 * q) = pack8(tp[0] * g0 * rstd, tp[1] * g1 * rstd); }
            __syncthreads();
        }
    }
    for (; u < 1536; u += F.G) {
        {
            const int v = u - 512, b = v >> 6, h = (v >> 3) & 7, qb = v & 7;
            const size_t krow0 = (size_t)b * TPB, qrow0 = krow0 + CTXL + qb * 256;
            { f32x16 o[2];
              attn_pass<96, 64>(QB + qrow0 * 768 + h * 96, 768, KB + krow0 * 768 + h * 96, 768, VB + krow0 * 512 + h * 64, 512, TPB, lds, o);
              o_to_lds<2>(o, T, r32, hi); }
            bf16_t* dst = CAT + ((size_t)b * SEQ + qb * 256 + F.wave * 32 + erow) * DM + 512 + h * 64 + ehalf * 32;
#pragma unroll
            for (int q = 0; q < 4; ++q) { const LAS f32x4* tp = (const LAS f32x4*)(T + erow * OT_STRIDE + ehalf * 32 + 8 * q); *(u32x4*)(dst + 8 * q) = pack8(tp[0], tp[1]); }
            __syncthreads();
        }
    }
}

__device__ __forceinline__ void p8_phase(const Params& P, const Frame& F) {
    for (int r = F.gwi; r < MLAT; r += F.ngw) {
        float* row = P.out + (size_t)r * DM; f32x4 v[4]; float s = 0.f;
#pragma unroll
        for (int j = 0; j < 4; ++j) { v[j] = *(const f32x4*)(row + 4 * F.lane + 256 * j); s += (v[j].x * v[j].x + v[j].y * v[j].y) + (v[j].z * v[j].z + v[j].w * v[j].w); }
        const float rstd = rsqrtf(wave_sum(s) * (1.f / DM) + EPS);
#pragma unroll
        for (int j = 0; j < 4; ++j) { const f32x4 g = *(const f32x4*)(P.final_norm + 4 * F.lane + 256 * j); *(f32x4*)(row + 4 * F.lane + 256 * j) = v[j] * rstd * g; }
    }
}

constexpr int LDS_BYTES = 147456;
constexpr int NPHASE = 9;
__global__ void __launch_bounds__(NTHREADS, 2) mk_kernel(Params P, int lo, int hi) {
    extern __shared__ __attribute__((aligned(16))) unsigned char lds_raw[];
    Frame F; F.tid = threadIdx.x; F.lane = F.tid & 63; F.wave = __builtin_amdgcn_readfirstlane(F.tid >> 6); F.G = gridDim.x; F.bid = blockIdx.x;
    F.gwi = F.wave * F.G + F.bid; F.ngw = F.G * NWAVES; F.lds = (LAS unsigned char*)lds_raw;
    cg::grid_group grid = cg::this_grid();
#define IN(k) (lo <= (k) && (k) < hi)
#define SEAM(k) do { if (IN(k) && IN((k) + 1)) grid.sync(); } while (0)
    bf16_t* WS16 = (bf16_t*)P.ws; (void)WS16;
    if (IN(0)) p0_phase(P, F);
    SEAM(0);
    if (IN(1)) p1_phase(P, F);
    SEAM(1);
    if (IN(2)) {
        TileOrder S; S.init(MROWS / 256, NIN / 256, F.G, F.bid);
        EpiQKV E{(bf16_t*)(P.ws + WS_QA), (bf16_t*)(P.ws + WS_KA), (bf16_t*)(P.ws + WS_VA), (bf16_t*)(P.ws + WS_CQ), (bf16_t*)(P.ws + WS_CKV), (bf16_t*)(P.ws + WS_KB),
                 (float*)(P.ws + WS_SSQQ), (float*)(P.ws + WS_SSQKV), rope_tab(P)};
        pg8::gemm_phase(F.lds, pg8::Gemm{(const bf16_t*)(P.ws + WS_H), (const bf16_t*)(P.ws + WS_WIN), 1024}, S, E);
    }
    SEAM(2);
    if (IN(3)) {
        { TileOrder S; S.init(MLAT / 256, 3, F.G, F.bid); EpiQup E{(bf16_t*)(P.ws + WS_QB), (const float*)(P.ws + WS_SSQQ), rope_tab(P)};
          Unit u; for (int i = 0; S.next(i, u); ++i) { u.pm = u.pm + (u.pm >> 3) + 1; gemm_unit_simple(F, (const bf16_t*)(P.ws + WS_CQ), (const bf16_t*)(P.ws + WS_WQUP), 256, u, E); } }
        { TileOrder S; S.init(MROWS / 256, 4, F.G, F.bid); EpiKVup E{(bf16_t*)(P.ws + WS_KB), (bf16_t*)(P.ws + WS_VB), (const float*)(P.ws + WS_SSQKV)};
          Unit u; for (int i = 0; S.next(i, u); ++i) gemm_unit_simple(F, (const bf16_t*)(P.ws + WS_CKV), (const bf16_t*)(P.ws + WS_WKVUP), 128, u, E); }
    }
    SEAM(3);
    if (IN(4)) attn_phase(P, F);
    SEAM(4);
    if (IN(5)) {
        TileOrder S; S.init(MLAT / 256, 4, F.G, F.bid); EpiOut E{P.x, P.out, (bf16_t*)(P.ws + WS_A2), (const float*)(P.ws + WS_MOD), (float*)(P.ws + WS_SSQ2)};
        pg8::gemm_phase(F.lds, pg8::Gemm{(const bf16_t*)(P.ws + WS_CAT), (const bf16_t*)(P.ws + WS_WOUT), 1024}, S, E);
    }
    SEAM(5);
    if (IN(6)) {
        TileOrder S; S.init(MLAT / 256, 22, F.G, F.bid); EpiFfnIn E{(bf16_t*)(P.ws + WS_G), (const float*)(P.ws + WS_SSQ2), (const float*)(P.ws + WS_BIASF)};
        pg8::gemm_phase(F.lds, pg8::Gemm{(const bf16_t*)(P.ws + WS_A2), (const bf16_t*)(P.ws + WS_WFFI), 1024}, S, E);
    }
    SEAM(6);
    if (IN(7)) {
        TileOrder S; S.init(MLAT / 256, 4, F.G, F.bid); EpiFfnOut E{P.out, (const float*)(P.ws + WS_MOD)};
        pg8::gemm_phase(F.lds, pg8::Gemm{(const bf16_t*)(P.ws + WS_G), (const bf16_t*)(P.ws + WS_WFFO), FFH}, S, E);
    }
    SEAM(7);
    if (IN(8)) p8_phase(P, F);
#undef IN
#undef SEAM
}

#ifndef MK_FUSED
#define MK_FUSED 1
#endif
extern "C" void kernel_launch(void* const* d_in, const int* in_sizes, int n_in, void* d_out, int out_size, void* d_ws, size_t ws_size, hipStream_t stream) {
    static int grid = 0;
    if (grid == 0) {
        if (n_in != 17 || in_sizes[0] != MLAT * DM || out_size != MLAT * DM || ws_size < WS_END) {
            fprintf(stderr, "kernel_launch: unexpected shapes: n_in %d in0 %d out %d ws %zu (need %zu)\n", n_in, n_in > 0 ? in_sizes[0] : -1, out_size, ws_size, (size_t)WS_END); grid = -1; return; }
        if (hipFuncSetAttribute((const void*)mk_kernel, hipFuncAttributeMaxDynamicSharedMemorySize, LDS_BYTES) != hipSuccess) { fprintf(stderr, "kernel_launch: hipFuncSetAttribute failed\n"); grid = -1; return; }
        int dev = 0, cus = 0, per_cu = 0;
        (void)hipGetDevice(&dev); (void)hipDeviceGetAttribute(&cus, hipDeviceAttributeMultiprocessorCount, dev);
        if (hipOccupancyMaxActiveBlocksPerMultiprocessor(&per_cu, (const void*)mk_kernel, NTHREADS, LDS_BYTES) != hipSuccess || per_cu < 1) { fprintf(stderr, "kernel_launch: occupancy query says %d blocks/CU\n", per_cu); per_cu = 1; }
        (void)hipGetLastError();
        grid = cus;
        if (grid <= 0) grid = 256;
    }
    if (grid < 0) return;
    (void)hipMemsetAsync(d_ws, 0, CTL_BYTES, stream);
    Params p{};
    p.x = (const float*)d_in[0]; p.c = (const float*)d_in[1]; p.ctx = (const float*)d_in[2]; p.c_ctx = (const float*)d_in[3]; p.w_ada = (const float*)d_in[4]; p.b_ada = (const float*)d_in[5];
    p.w_in = (const float*)d_in[6]; p.q_a_norm = (const float*)d_in[7]; p.kv_a_norm = (const float*)d_in[8]; p.w_q_up = (const float*)d_in[9]; p.w_kv_up = (const float*)d_in[10];
    p.diff_lambda = (const float*)d_in[11]; p.diff_subln = (const float*)d_in[12]; p.w_out = (const float*)d_in[13]; p.w_ffn_in = (const float*)d_in[14]; p.w_ffn_out = (const float*)d_in[15];
    p.final_norm = (const float*)d_in[16]; p.out = (float*)d_out; p.ws = (unsigned char*)d_ws;
#if MK_FUSED
    int lo = 0, hi = NPHASE; void* args[] = {&p, &lo, &hi};
    hipError_t e = hipLaunchCooperativeKernel((const void*)mk_kernel, dim3(grid), dim3(NTHREADS), args, LDS_BYTES, stream);
    if (e != hipSuccess) fprintf(stderr, "kernel_launch: cooperative launch failed: %s (grid %d)\n", hipGetErrorString(e), grid);
#else
    for (int ph = 0; ph < NPHASE; ++ph) {
        hipLaunchKernelGGL(mk_kernel, dim3(grid), dim3(NTHREADS), LDS_BYTES, stream, p, ph, ph + 1);
        const hipError_t le = hipPeekAtLastError();
        if (le != hipSuccess) { fprintf(stderr, "kernel_launch: launch %d failed: %s\n", ph, hipGetErrorName(le)); break; }
    }
#endif
}
```

```cpp
#include <hip/hip_runtime.h>
#include <hip/hip_cooperative_groups.h>
#include <cstdint>
#include <cstdio>
namespace cg = cooperative_groups;

#define LAS __attribute__((address_space(3)))
typedef unsigned short bf16_t;
typedef short bf16x8 __attribute__((ext_vector_type(8)));
typedef short s16x4 __attribute__((ext_vector_type(4)));
typedef float f32x2 __attribute__((ext_vector_type(2)));
typedef float f32x4 __attribute__((ext_vector_type(4)));
typedef float f32x16 __attribute__((ext_vector_type(16)));
typedef unsigned u32x2 __attribute__((ext_vector_type(2)));
typedef unsigned u32x4 __attribute__((ext_vector_type(4)));
typedef __bf16 bf16x2_t __attribute__((ext_vector_type(2)));

constexpr int DM = 1024, NB = 16, SEQ = 2048, CTXL = 256, TPB = SEQ + CTXL;
constexpr int MROWS = NB * TPB, MLAT = NB * SEQ;
constexpr int FFH = 2816, NIN = 2048, NADA = 6 * DM;
constexpr float EPS = 1e-6f;
constexpr int NWAVES = 8, NTHREADS = 512;

constexpr size_t KiB = 1024, MiB = 1024 * 1024;
constexpr size_t WS_MOD = 0, WS_BIASF = 512 * KiB, WS_SSQQ = 1024 * KiB, WS_SSQKV = 1184 * KiB, WS_SSQ2 = 1344 * KiB, WS_LAM = 1536 * KiB, WS_BAR = 1792 * KiB;
constexpr size_t CTL_BYTES = 2 * MiB;
constexpr size_t WS_TAB = 2 * MiB;
constexpr size_t WS_WIN = 3 * MiB, WS_WQUP = 7 * MiB, WS_WKVUP = 7 * MiB + 512 * KiB, WS_WOUT = 8 * MiB, WS_WFFI = 10 * MiB, WS_WFFO = 21 * MiB;
constexpr size_t WS_A2 = 27 * MiB, WS_CAT = 91 * MiB;
constexpr size_t WS_H = 155 * MiB, WS_QB = 155 * MiB, WS_QA = 227 * MiB, WS_KA = 263 * MiB, WS_VA = 299 * MiB, WS_CQ = 335 * MiB, WS_CKV = 353 * MiB;
constexpr size_t WS_KB = 362 * MiB, WS_VB = 416 * MiB, WS_SCR = 452 * MiB, WS_G = 155 * MiB, WS_END = 484 * MiB;
static_assert(WS_G + (size_t)MLAT * FFH * 2 <= WS_CQ, "G overlay");
static_assert(WS_WFFO + (size_t)DM * FFH * 2 <= WS_A2, "wffo");

struct Params {
    const float *x, *c, *ctx, *c_ctx, *w_ada, *b_ada, *w_in, *q_a_norm, *kv_a_norm, *w_q_up, *w_kv_up, *diff_lambda, *diff_subln, *w_out, *w_ffn_in, *w_ffn_out, *final_norm;
    float* out; unsigned char* ws;
};

__device__ __forceinline__ unsigned cvtpk(float lo, float hi) { f32x2 v = {lo, hi}; bf16x2_t b = __builtin_convertvector(v, bf16x2_t); return __builtin_bit_cast(unsigned, b); }
__device__ __forceinline__ float wave_sum(float v) {
#pragma unroll
    for (int o = 1; o < 64; o <<= 1) v += __shfl_xor(v, o);
    return v;
}
__device__ __forceinline__ float silu_f(float v) { return v / (1.f + __expf(-v)); }
__device__ __forceinline__ u32x4 pack8(f32x4 a, f32x4 b) { u32x4 w; w.x = cvtpk(a[0], a[1]); w.y = cvtpk(a[2], a[3]); w.z = cvtpk(b[0], b[1]); w.w = cvtpk(b[2], b[3]); return w; }
__device__ __forceinline__ int ropeA_L(int q) { return 4 * ((q >> 3) & 3) + (q & 3) + 16 * ((q >> 2) & 1); }
__device__ __forceinline__ int ropeB_L(int q) { const int a = q >> 3, n = (q >> 2) & 1, j = q & 3; return (a >> 1) * 16 + (a & 1) * 4 + j + 8 * n; }

struct Frame { int tid, lane, wave, G, bid, gwi, ngw; LAS unsigned char* lds; };

__device__ __forceinline__ void p0_ada_task(const Params& P, float* MOD, int t, int lane) {
    const int cgp = t % 24, kc = t / 24, k0 = kc * 32, n = cgp * 256 + lane * 4, k = k0 + (lane & 31);
    float sv[17];
#pragma unroll
    for (int b = 0; b < 16; ++b) sv[b] = silu_f(P.c[b * DM + k]);
    sv[16] = silu_f(P.c_ctx[k]);
    f32x4 acc[17];
    const f32x4 binit = (kc == 0) ? *(const f32x4*)(P.b_ada + n) : (f32x4){0.f, 0.f, 0.f, 0.f};
#pragma unroll
    for (int b = 0; b < 17; ++b) acc[b] = binit;
#pragma unroll 2
    for (int kk = 0; kk < 32; ++kk) {
        const f32x4 w = *(const f32x4*)(P.w_ada + (size_t)(k0 + kk) * NADA + n);
#pragma unroll
        for (int b = 0; b < 17; ++b) { const float s = __shfl(sv[b], kk); acc[b] += w * s; }
    }
#pragma unroll
    for (int b = 0; b < 17; ++b)
#pragma unroll
        for (int j = 0; j < 4; ++j) atomicAdd(&MOD[b * NADA + n + j], acc[b][j]);
}
__device__ __forceinline__ int src_col(int mat, int p) {
    switch (mat) {
    case 0: if (p < 1024) return (p & ~31) + ropeA_L(p & 31); if (p < 1920) return p; if (p < 1952) return 1920 + ropeB_L(p - 1920); return -1;
    case 1: if (p < 512) return (p >> 6) * 96 + (p & 63); { const int q = p - 512; return (q >> 5) * 96 + 64 + ropeB_L(q & 31); }
    case 2: if (p < 512) return (p >> 6) * 128 + (p & 63); { const int q = p - 512; return (q >> 6) * 128 + 64 + (q & 63); }
    case 4: { const int t = p >> 8, q = p & 255; return q < 128 ? 128 * t + q : FFH + 128 * t + (q - 128); }
    default: return p;
    }
}
__device__ __forceinline__ void p0_transpose_item(const float* W, int K, int N, const float* gain, bf16_t* WT, int mat, int npb, LAS float* scr, int item, int lane) {
    const int kb = item / npb, pb = item % npb, k0 = 64 * kb, p0 = 32 * pb;
    const int sc = src_col(mat, p0 + (lane & 31));
#pragma unroll 8
    for (int i = 0; i < 32; ++i) { const int kk = 2 * i + (lane >> 5);
        float v = 0.f; if (sc >= 0) { v = W[(size_t)(k0 + kk) * N + sc]; if (gain) v *= gain[k0 + kk]; }
        scr[kk * 33 + (lane & 31)] = v; }
    asm volatile("s_waitcnt lgkmcnt(0)" ::: "memory");
    const int c = lane & 7;
#pragma unroll
    for (int j = 0; j < 4; ++j) { const int n = (lane >> 3) + 8 * j; const LAS float* s = scr + (8 * c) * 33 + n;
        u32x4 o; o.x = cvtpk(s[0 * 33], s[1 * 33]); o.y = cvtpk(s[2 * 33], s[3 * 33]); o.z = cvtpk(s[4 * 33], s[5 * 33]); o.w = cvtpk(s[6 * 33], s[7 * 33]);
        *(u32x4*)(WT + (size_t)(p0 + n) * K + k0 + 8 * c) = o; }
    asm volatile("s_waitcnt lgkmcnt(0)" ::: "memory");
}
__device__ __forceinline__ void sincos_d(double a, float& s, float& c) {
    const double k = __builtin_rint(a * 0.15915494309189535);
    double r = __builtin_fma(-k, 6.283185307179586, a); r = __builtin_fma(-k, 2.4492935982947064e-16, r);
    const double r2 = r * r; double ts = r, tc = 1.0, ss = r, cc = 1.0;
    for (int n = 0; n < 14; ++n) { tc = -tc * r2 / (double)((2 * n + 1) * (2 * n + 2)); cc += tc; ts = -ts * r2 / (double)((2 * n + 2) * (2 * n + 3)); ss += ts; }
    s = (float)ss; c = (float)cc;
}
__device__ __forceinline__ void p0_phase(const Params& P, const Frame& F) {
    float* MOD = (float*)(P.ws + WS_MOD);
    LAS float* scr = (LAS float*)(F.lds + F.wave * 8448);
    constexpr int NADA_T = 24 * 32;
    constexpr int I0 = 16 * 64, I1 = 4 * 24, I2 = 2 * 32, I3 = 16 * 32, I4 = 16 * 176, I5 = 44 * 32;
    constexpr int NT = NADA_T + I0 + I1 + I2 + I3 + I4 + I5;
    for (int t = F.gwi; t < NT; t += F.ngw) {
        int r = t;
        if (r < NADA_T) { p0_ada_task(P, MOD, r, F.lane); continue; } r -= NADA_T;
        if (r < I0) { p0_transpose_item(P.w_in, 1024, 1952, nullptr, (bf16_t*)(P.ws + WS_WIN), 0, 64, scr, r, F.lane); continue; } r -= I0;
        if (r < I1) { p0_transpose_item(P.w_q_up, 256, 768, P.q_a_norm, (bf16_t*)(P.ws + WS_WQUP), 1, 24, scr, r, F.lane); continue; } r -= I1;
        if (r < I2) { p0_transpose_item(P.w_kv_up, 128, 1024, P.kv_a_norm, (bf16_t*)(P.ws + WS_WKVUP), 2, 32, scr, r, F.lane); continue; } r -= I2;
        if (r < I3) { p0_transpose_item(P.w_out, 1024, 1024, nullptr, (bf16_t*)(P.ws + WS_WOUT), 3, 32, scr, r, F.lane); continue; } r -= I3;
        if (r < I4) { p0_transpose_item(P.w_ffn_in, 1024, 2 * FFH, nullptr, (bf16_t*)(P.ws + WS_WFFI), 4, 176, scr, r, F.lane); continue; } r -= I4;
        p0_transpose_item(P.w_ffn_out, FFH, 1024, nullptr, (bf16_t*)(P.ws + WS_WFFO), 5, 32, scr, r, F.lane);
    }
    if (F.bid == F.G - 1) {
        float* TAB = (float*)(P.ws + WS_TAB);
        for (int i = F.tid; i < 1536; i += NTHREADS) {
            float s, c;
            if (i < 1024) { const int pos = i >> 4, f = i & 15; double inv = 1.0; for (int q = 0; q < f; ++q) inv *= 0.5623413251903491; sincos_d((double)pos * inv, s, c); TAB[i] = c; TAB[1024 + i] = s; }
            else { const int e = i - 1024, pos = e >> 3, f = e & 7; double inv = 1.0; for (int q = 0; q < f; ++q) inv *= 0.31622776601683794; sincos_d((double)pos * inv, s, c); TAB[2048 + e] = c; TAB[2560 + e] = s; }
        }
        if (F.wave == 0) {
            const float* lp = P.diff_lambda; const float a = wave_sum(lp[F.lane] * lp[64 + F.lane]), b = wave_sum(lp[128 + F.lane] * lp[192 + F.lane]);
            if (F.lane == 0) *(float*)(P.ws + WS_LAM) = __expf(a) - __expf(b) + 0.2f;
        }
    }
}

__device__ __forceinline__ void p1_phase(const Params& P, const Frame& F) {
    const float* MOD = (const float*)(P.ws + WS_MOD);
    bf16_t* H = (bf16_t*)(P.ws + WS_H);
    for (int r = F.gwi; r < MROWS; r += F.ngw) {
        const int b = r / TPB, t = r - b * TPB;
        const float* src = (t < CTXL) ? P.ctx + ((size_t)b * CTXL + t) * DM : P.x + ((size_t)b * SEQ + (t - CTXL)) * DM;
        const float* mp = MOD + (size_t)((t < CTXL) ? 16 : b) * NADA;
        f32x4 v[4]; float s = 0.f;
#pragma unroll
        for (int j = 0; j < 4; ++j) { v[j] = *(const f32x4*)(src + 4 * F.lane + 256 * j); s += (v[j].x * v[j].x + v[j].y * v[j].y) + (v[j].z * v[j].z + v[j].w * v[j].w); }
        const float rstd = rsqrtf(wave_sum(s) * (1.f / DM) + EPS);
#pragma unroll
        for (int j = 0; j < 4; ++j) { const int col = 4 * F.lane + 256 * j; const f32x4 sh = *(const f32x4*)(mp + col), sc = *(const f32x4*)(mp + DM + col);
            const f32x4 h = v[j] * rstd * (sc + 1.f) + sh; u32x2 w; w.x = cvtpk(h[0], h[1]); w.y = cvtpk(h[2], h[3]);
            *(u32x2*)(H + (size_t)r * DM + col) = w; }
    }
    if (F.gwi < 22 * 16) {
        float* BIASF = (float*)(P.ws + WS_BIASF);
        const int cgp = F.gwi % 22, kc = F.gwi / 22, k0 = kc * 64, n = cgp * 256 + F.lane * 4;
        float sv[16];
#pragma unroll
        for (int b = 0; b < 16; ++b) sv[b] = MOD[(size_t)b * NADA + 3 * DM + k0 + F.lane];
        f32x4 acc[16];
#pragma unroll
        for (int b = 0; b < 16; ++b) acc[b] = (f32x4){0.f, 0.f, 0.f, 0.f};
#pragma unroll 2
        for (int kk = 0; kk < 64; ++kk) {
            const f32x4 w = *(const f32x4*)(P.w_ffn_in + (size_t)(k0 + kk) * (2 * FFH) + n);
#pragma unroll
            for (int b = 0; b < 16; ++b) { const float s = __shfl(sv[b], kk); acc[b] += w * s; }
        }
#pragma unroll
        for (int b = 0; b < 16; ++b)
#pragma unroll
            for (int j = 0; j < 4; ++j) atomicAdd(&BIASF[b * (2 * FFH) + n + j], acc[b][j]);
    }
}

struct Unit { int pm, pn; };
__device__ __forceinline__ int perm32(int rho) { const int n = rho >> 4, i = rho & 15; return 8 * (i >> 2) + 4 * n + (i & 3); }
struct TileOrder {
    int nM, nN, nwg, G, c;
    __device__ __forceinline__ void init(int nM_, int nN_, int G_, int c_) { nM = nM_; nN = nN_; nwg = nM * nN; G = G_; c = c_; }
    __device__ __forceinline__ bool next(int i, Unit& u) const {
        const long L = (long)i * G + c; if (L >= nwg) return false;
        int wgid = (int)L; { const int q = nwg / 8, r = nwg % 8, xcd = wgid % 8, off = wgid / 8; wgid = (xcd < r ? xcd * (q + 1) : r * (q + 1) + (xcd - r) * q) + off; }
        const int nig = 8 * nN, gid = wgid / nig, fm = gid * 8, gsz = (nM - fm) < 8 ? (nM - fm) : 8;
        u.pm = fm + ((wgid % nig) % gsz); u.pn = (wgid % nig) / gsz; return true;
    }
};
typedef f32x4 Acc[2][2][4][2];
constexpr int SG_STRIDE = 144;
template <class Epi>
__device__ __forceinline__ void gemm_unit_simple(const Frame& F, const bf16_t* A, const bf16_t* Bt, int K, const Unit u, const Epi& E) {
    const int wr = F.wave >> 2, wc = F.wave & 3, fr = F.lane & 15, fq = F.lane >> 4;
    LAS unsigned char* As = F.lds; LAS unsigned char* Bs = F.lds + 256 * SG_STRIDE;
    Acc acc;
#pragma unroll
    for (int a = 0; a < 2; ++a)
#pragma unroll
        for (int b = 0; b < 2; ++b)
#pragma unroll
            for (int m = 0; m < 4; ++m)
#pragma unroll
                for (int n = 0; n < 2; ++n) acc[a][b][m][n] = (f32x4){0.f, 0.f, 0.f, 0.f};
    const bf16_t* Ag = A + (size_t)u.pm * 256 * K; const bf16_t* Bg = Bt + (size_t)u.pn * 256 * K;
#pragma unroll 1
    for (int kt = 0; kt < K; kt += 64) {
        __syncthreads();
#pragma unroll
        for (int i = 0; i < 4; ++i) { const int p = F.tid + 512 * i, row = p >> 3, ch = p & 7;
            const u32x4 va = *(const u32x4*)(Ag + (size_t)row * K + kt + ch * 8), vb = *(const u32x4*)(Bg + (size_t)row * K + kt + ch * 8);
            *(LAS u32x4*)(As + row * SG_STRIDE + ch * 16) = va; *(LAS u32x4*)(Bs + row * SG_STRIDE + ch * 16) = vb; if (i & 1) asm volatile("" ::: "memory"); }
        __syncthreads();
#pragma unroll
        for (int k2 = 0; k2 < 2; ++k2) {
#pragma unroll
            for (int ai = 0; ai < 2; ++ai) {
                bf16x8 At[4];
#pragma unroll
                for (int m = 0; m < 4; ++m) At[m] = *(const LAS bf16x8*)(As + (128 * ai + 64 * wr + 16 * m + fr) * SG_STRIDE + (32 * k2 + 8 * fq) * 2);
#pragma unroll
                for (int bj = 0; bj < 2; ++bj) {
                    bf16x8 Bf[2];
#pragma unroll
                    for (int n = 0; n < 2; ++n) Bf[n] = *(const LAS bf16x8*)(Bs + (128 * bj + 32 * wc + perm32(16 * n + fr)) * SG_STRIDE + (32 * k2 + 8 * fq) * 2);
#pragma unroll
                    for (int m = 0; m < 4; ++m)
#pragma unroll
                        for (int n = 0; n < 2; ++n) acc[ai][bj][m][n] = __builtin_amdgcn_mfma_f32_16x16x32_bf16(Bf[n], At[m], acc[ai][bj][m][n], 0, 0, 0);
                }
            }
        }
    }
    E(acc, u, wr, wc, fr, fq);
}

struct RopeTab { const float *Ac, *As, *Bc, *Bs; };
__device__ __forceinline__ RopeTab rope_tab(const Params& P) { const float* T = (const float*)(P.ws + WS_TAB); return RopeTab{T, T + 1024, T + 2048, T + 2560}; }
__device__ __forceinline__ void rope_pair(f32x4& v0, f32x4& v1, const f32x4 cs, const f32x4 sn) { const f32x4 a = v0 * cs - v1 * sn, b = v1 * cs + v0 * sn; v0 = a; v1 = b; }

struct EpiQKV {
    bf16_t *QA, *KA, *VA, *CQ, *CKV, *KB; float *SSQQ, *SSQKV; RopeTab T;
    __device__ __forceinline__ void operator()(const Acc& acc, const Unit& u, int wr, int wc, int fr, int fq) const {
        const int jb = u.pm % 9; const bool lat = jb != 0; const int pn = u.pn;
        if (!lat && (pn < 2 || pn == 6)) return;
#pragma unroll
        for (int ai = 0; ai < 2; ++ai) {
            const int prow = (jb - 1) * 4 + 2 * ai + wr;
#pragma unroll
            for (int m = 0; m < 4; ++m) {
                const int pcol = 16 * m + fr; const size_t grow = (size_t)u.pm * 256 + 128 * ai + 64 * wr + 16 * m + fr;
                if (pn < 4) {
                    bf16_t* dst = (pn < 2 ? QA : KA) + grow * 512 + (pn & 1) * 256 + 32 * wc + 8 * fq;
                    const int pos = (wc & 1) ? pcol : prow;
                    f32x4 cs = {1.f, 1.f, 1.f, 1.f}, sn = {0.f, 0.f, 0.f, 0.f};
                    if (lat) { cs = *(const f32x4*)(T.Ac + pos * 16 + 4 * fq); sn = *(const f32x4*)(T.As + pos * 16 + 4 * fq); }
#pragma unroll
                    for (int bj = 0; bj < 2; ++bj) { f32x4 v0 = acc[ai][bj][m][0], v1 = acc[ai][bj][m][1]; rope_pair(v0, v1, cs, sn); *(u32x4*)(dst + 128 * bj) = pack8(v0, v1); }
                } else if (pn < 6) {
#pragma unroll
                    for (int bj = 0; bj < 2; ++bj) *(u32x4*)(VA + grow * 512 + (pn - 4) * 256 + 128 * bj + 32 * wc + 8 * fq) = pack8(acc[ai][bj][m][0], acc[ai][bj][m][1]);
                } else if (pn == 6) {
                    float s = 0.f;
#pragma unroll
                    for (int bj = 0; bj < 2; ++bj) { const f32x4 v0 = acc[ai][bj][m][0], v1 = acc[ai][bj][m][1];
                        s += (v0[0] * v0[0] + v0[1] * v0[1]) + (v0[2] * v0[2] + v0[3] * v0[3]) + (v1[0] * v1[0] + v1[1] * v1[1]) + (v1[2] * v1[2] + v1[3] * v1[3]);
                        *(u32x4*)(CQ + grow * 256 + 128 * bj + 32 * wc + 8 * fq) = pack8(v0, v1); }
                    s += __shfl_xor(s, 16); s += __shfl_xor(s, 32);
                    if (fq == 0) atomicAdd(SSQQ + grow, s);
                } else {
                    { const f32x4 v0 = acc[ai][0][m][0], v1 = acc[ai][0][m][1];
                      float s = (v0[0] * v0[0] + v0[1] * v0[1]) + (v0[2] * v0[2] + v0[3] * v0[3]) + (v1[0] * v1[0] + v1[1] * v1[1]) + (v1[2] * v1[2] + v1[3] * v1[3]);
                      *(u32x4*)(CKV + grow * 128 + 32 * wc + 8 * fq) = pack8(v0, v1);
                      s += __shfl_xor(s, 16); s += __shfl_xor(s, 32);
                      if (fq == 0) atomicAdd(SSQKV + grow, s); }
                    if (wc == 0) {
                        f32x4 v0 = acc[ai][1][m][0], v1 = acc[ai][1][m][1];
                        if (lat) { const int pos = (fq < 2) ? prow : pcol; const f32x4 cs = *(const f32x4*)(T.Bc + pos * 8 + 4 * (fq & 1)), sn = *(const f32x4*)(T.Bs + pos * 8 + 4 * (fq & 1)); rope_pair(v0, v1, cs, sn); }
                        const u32x4 w = pack8(v0, v1);
#pragma unroll
                        for (int h = 0; h < 8; ++h) *(u32x4*)(KB + grow * 768 + h * 96 + 64 + 8 * fq) = w;
                    }
                }
            }
        }
    }
};
struct EpiQup {
    bf16_t* QB; const float* SSQQ; RopeTab T;
    __device__ __forceinline__ void operator()(const Acc& acc, const Unit& u, int wr, int wc, int fr, int fq) const {
        const int jb = u.pm % 9, pn = u.pn;
#pragma unroll
        for (int ai = 0; ai < 2; ++ai) {
            const int prow = (jb - 1) * 4 + 2 * ai + wr;
#pragma unroll
            for (int m = 0; m < 4; ++m) {
                const int pcol = 16 * m + fr; const size_t grow = (size_t)u.pm * 256 + 128 * ai + 64 * wr + 16 * m + fr;
                const float rstd = rsqrtf(SSQQ[grow] * (1.f / 256.f) + EPS);
#pragma unroll
                for (int bj = 0; bj < 2; ++bj) {
                    f32x4 v0 = acc[ai][bj][m][0] * rstd, v1 = acc[ai][bj][m][1] * rstd;
                    if (pn < 2) { const int c = pn * 256 + 128 * bj + 32 * wc + 8 * fq; *(u32x4*)(QB + grow * 768 + (c >> 6) * 96 + (c & 63)) = pack8(v0, v1); }
                    else { const int h = 4 * bj + wc, pos = (fq < 2) ? prow : pcol;
                        const f32x4 cs = *(const f32x4*)(T.Bc + pos * 8 + 4 * (fq & 1)), sn = *(const f32x4*)(T.Bs + pos * 8 + 4 * (fq & 1)); rope_pair(v0, v1, cs, sn);
                        *(u32x4*)(QB + grow * 768 + h * 96 + 64 + 8 * fq) = pack8(v0, v1); }
                }
                asm volatile("" ::: "memory");
            }
        }
    }
};
struct EpiKVup {
    bf16_t *KB, *VB; const float* SSQKV;
    __device__ __forceinline__ void operator()(const Acc& acc, const Unit& u, int wr, int wc, int fr, int fq) const {
        const int pn = u.pn;
#pragma unroll
        for (int ai = 0; ai < 2; ++ai)
#pragma unroll
            for (int m = 0; m < 4; ++m) {
                const size_t grow = (size_t)u.pm * 256 + 128 * ai + 64 * wr + 16 * m + fr;
                const float rstd = rsqrtf(SSQKV[grow] * (1.f / 128.f) + EPS);
#pragma unroll
                for (int bj = 0; bj < 2; ++bj) {
                    const f32x4 v0 = acc[ai][bj][m][0] * rstd, v1 = acc[ai][bj][m][1] * rstd;
                    if (pn < 2) { const int c = pn * 256 + 128 * bj + 32 * wc + 8 * fq; *(u32x4*)(KB + grow * 768 + (c >> 6) * 96 + (c & 63)) = pack8(v0, v1); }
                    else *(u32x4*)(VB + grow * 512 + (pn - 2) * 256 + 128 * bj + 32 * wc + 8 * fq) = pack8(v0, v1);
                }
                asm volatile("" ::: "memory");
            }
    }
};
struct EpiOut {
    const float* x; float* out; bf16_t* A2; const float* MOD; float* SSQ2;
    __device__ __forceinline__ void operator()(const Acc& acc, const Unit& u, int wr, int wc, int fr, int fq) const {
        const float* mp = MOD + (size_t)(u.pm >> 3) * NADA;
#pragma unroll
        for (int ai = 0; ai < 2; ++ai)
#pragma unroll
            for (int m = 0; m < 4; ++m) {
                const size_t row = (size_t)u.pm * 256 + 128 * ai + 64 * wr + 16 * m + fr; float s = 0.f;
#pragma unroll
                for (int bj = 0; bj < 2; ++bj) {
                    const int col = u.pn * 256 + 128 * bj + 32 * wc + 8 * fq; const size_t off = row * DM + col;
                    f32x4 nv[2];
#pragma unroll
                    for (int n = 0; n < 2; ++n) { const f32x4 ga = *(const f32x4*)(mp + 2 * DM + col + 4 * n), xv = *(const f32x4*)(x + off + 4 * n);
                        nv[n] = xv + ga * acc[ai][bj][m][n]; *(f32x4*)(out + off + 4 * n) = nv[n];
                        s += (nv[n][0] * nv[n][0] + nv[n][1] * nv[n][1]) + (nv[n][2] * nv[n][2] + nv[n][3] * nv[n][3]); }
                    const f32x4 s0 = *(const f32x4*)(mp + 4 * DM + col), s1 = *(const f32x4*)(mp + 4 * DM + col + 4);
                    *(u32x4*)(A2 + off) = pack8(nv[0] * (s0 + 1.f), nv[1] * (s1 + 1.f));
                }
                s += __shfl_xor(s, 16); s += __shfl_xor(s, 32);
                if (fq == 0) atomicAdd(SSQ2 + row, s);
            }
    }
};
struct EpiFfnIn {
    bf16_t* G; const float* SSQ2; const float* BIASF;
    __device__ __forceinline__ void operator()(const Acc& acc, const Unit& u, int wr, int wc, int fr, int fq) const {
        const float* bp = BIASF + (size_t)(u.pm >> 3) * (2 * FFH); const int hc = u.pn * 128 + 32 * wc + 8 * fq;
        f32x4 bg[2], bu[2];
#pragma unroll
        for (int n = 0; n < 2; ++n) { bg[n] = *(const f32x4*)(bp + hc + 4 * n); bu[n] = *(const f32x4*)(bp + FFH + hc + 4 * n); }
#pragma unroll
        for (int ai = 0; ai < 2; ++ai)
#pragma unroll
            for (int m = 0; m < 4; ++m) {
                const size_t row = (size_t)u.pm * 256 + 128 * ai + 64 * wr + 16 * m + fr;
                const float rstd = rsqrtf(SSQ2[row] * (1.f / DM) + EPS);
                f32x4 o[2];
#pragma unroll
                for (int n = 0; n < 2; ++n) { const f32x4 g = acc[ai][0][m][n] * rstd + bg[n], up = acc[ai][1][m][n] * rstd + bu[n];
#pragma unroll
                    for (int j = 0; j < 4; ++j) o[n][j] = silu_f(g[j]) * up[j]; }
                *(u32x4*)(G + row * FFH + hc) = pack8(o[0], o[1]);
            }
    }
};
struct EpiFfnOut {
    float* out; const float* MOD;
    __device__ __forceinline__ void operator()(const Acc& acc, const Unit& u, int wr, int wc, int fr, int fq) const {
        const float* mp = MOD + (size_t)(u.pm >> 3) * NADA + 5 * DM;
#pragma unroll
        for (int ai = 0; ai < 2; ++ai)
#pragma unroll
            for (int m = 0; m < 4; ++m) {
                const size_t row = (size_t)u.pm * 256 + 128 * ai + 64 * wr + 16 * m + fr;
#pragma unroll
                for (int bj = 0; bj < 2; ++bj)
#pragma unroll
                    for (int n = 0; n < 2; ++n) { const int col = u.pn * 256 + 128 * bj + 32 * wc + 8 * fq + 4 * n; const size_t off = row * DM + col;
                        const f32x4 gf = *(const f32x4*)(mp + col), nl = *(const f32x4*)(out + off); *(f32x4*)(out + off) = nl + gf * acc[ai][bj][m][n]; }
            }
    }
};


namespace pg8 {
constexpr int BK = 64, HALF = 128, HTB = HALF * BK * 2, STAGE_BYTES = 8 * HTB;
__device__ __forceinline__ int lds_byte(int r, int c) { const int st = (r >> 4) * 2 + (c >> 5), rr = r & 15, cc = c & 31, ob = rr * 64 + cc * 2; return st * 1024 + (ob ^ (((ob >> 9) & 1) << 5)); }
__device__ __forceinline__ void stage_rc(int b, int& R, int& C) { const int st = b / 1024, sb = b % 1024, swz = sb ^ (((sb >> 9) & 1) << 5); R = (st >> 1) * 16 + swz / 64; C = (st & 1) * 32 + (swz % 64) / 2; }
struct Gemm { const bf16_t* A; const bf16_t* Bt; int K; };
template <class Epi, class Sched>
__device__ __forceinline__ void gemm_phase(LAS unsigned char* lds, const Gemm g, const Sched& S, const Epi& E) {
    const int tid = threadIdx.x, wid = __builtin_amdgcn_readfirstlane(tid >> 6), lane = tid & 63, wr = wid >> 2, wc = wid & 3, fr = lane & 15, fq = lane >> 4;
    const int K = g.K, nt = K / BK;
    unsigned voffA[2], voffB[2];
#pragma unroll
    for (int i = 0; i < 2; ++i) { int R, C; stage_rc(tid * 16 + i * 8192, R, C); const int Rb = (R & ~31) + perm32(R & 31);
        voffA[i] = (unsigned)(R * K + C) * 2u; voffB[i] = (unsigned)(Rb * K + C) * 2u; }
    const size_t kstep = (size_t)(BK * 2);
    const size_t hstep = (size_t)HALF * K * 2;
    const size_t tstep = 2 * hstep;
    const unsigned ldsw = (unsigned)wid * 1024u;
    const int aoff = lds_byte(wr * 64 + fr, fq * 8), boff = lds_byte(wc * 32 + fr, fq * 8);
#define PG8_SA(b, h) (((b) * 2 + (h)) * HTB)
#define PG8_SB(b, h) ((4 + (b) * 2 + (h)) * HTB)
#define PG8_STAGE(bufoff, gbase, voff) do { _Pragma("unroll") for (int _i = 0; _i < 2; ++_i) \
        __builtin_amdgcn_global_load_lds((const unsigned*)((const char*)(gbase) + (voff)[_i]), (LAS unsigned*)(lds + (bufoff) + ldsw + _i * 8192), 16, 0, 0); } while (0)
#define PG8_LDA(dst, b, h) do { _Pragma("unroll") for (int m = 0; m < 4; ++m) _Pragma("unroll") for (int k = 0; k < 2; ++k) dst[m][k] = *(const LAS bf16x8*)(lds + PG8_SA(b, h) + aoff + m * 2048 + k * 1024); } while (0)
#define PG8_LDB(dst, b, h) do { _Pragma("unroll") for (int n = 0; n < 2; ++n) _Pragma("unroll") for (int k = 0; k < 2; ++k) dst[n][k] = *(const LAS bf16x8*)(lds + PG8_SB(b, h) + boff + n * 2048 + k * 1024); } while (0)
#define PG8_MMA(ai, bj, At, Bt) do { __builtin_amdgcn_s_setprio(1); _Pragma("unroll") for (int m = 0; m < 4; ++m) _Pragma("unroll") for (int n = 0; n < 2; ++n) _Pragma("unroll") for (int k = 0; k < 2; ++k) \
        acc[ai][bj][m][n] = __builtin_amdgcn_mfma_f32_16x16x32_bf16(Bt[n][k], At[m][k], acc[ai][bj][m][n], 0, 0, 0); __builtin_amdgcn_s_setprio(0); } while (0)
#define PG8_WAIT_V(n) asm volatile("s_waitcnt vmcnt(" #n ")" ::: "memory")
#define PG8_WAIT_L(n) asm volatile("s_waitcnt lgkmcnt(" #n ")" ::: "memory")
#define PG8_BAR __builtin_amdgcn_s_barrier()
#define PG8_SCHED __builtin_amdgcn_sched_barrier(0)
    Unit cur, nxt; int ui = 0;
    if (!S.next(0, cur)) return;
    f32x4 acc[2][2][4][2];
#pragma unroll
    for (int a = 0; a < 2; ++a)
#pragma unroll
        for (int b = 0; b < 2; ++b)
#pragma unroll
            for (int m = 0; m < 4; ++m)
#pragma unroll
                for (int n = 0; n < 2; ++n) acc[a][b][m][n] = (f32x4){0.f, 0.f, 0.f, 0.f};
    bf16x8 At[4][2], B0[2][2], B1[2][2];
    const char* cA = (const char*)g.A + (size_t)cur.pm * tstep; const char* cB = (const char*)g.Bt + (size_t)cur.pn * tstep;
    PG8_STAGE(PG8_SB(0, 0), cB, voffB); PG8_STAGE(PG8_SB(0, 1), cB + hstep, voffB); PG8_STAGE(PG8_SA(0, 0), cA, voffA); PG8_STAGE(PG8_SA(0, 1), cA + hstep, voffA);
    if (wr == 1) PG8_BAR;
    PG8_WAIT_V(2); PG8_BAR;
    PG8_STAGE(PG8_SB(1, 0), cB + kstep, voffB); PG8_STAGE(PG8_SA(1, 0), cA + kstep, voffA); PG8_STAGE(PG8_SB(1, 1), cB + hstep + kstep, voffB);
    PG8_WAIT_V(6); PG8_BAR;
    for (;;) {
        const bool has_next = S.next(ui + 1, nxt);
        const char* nA = has_next ? (const char*)g.A + (size_t)nxt.pm * tstep : cA; const char* nB = has_next ? (const char*)g.Bt + (size_t)nxt.pn * tstep : cB;
        for (int t = 0; t < nt; t += 2) {
            const bool last = (t == nt - 2);
            const char* a1 = cA + (size_t)(t + 1) * kstep;
            const char* a2 = last ? nA : cA + (size_t)(t + 2) * kstep; const char* b2 = last ? nB : cB + (size_t)(t + 2) * kstep;
            const char* a3 = a2 + kstep; const char* b3 = b2 + kstep;
            PG8_LDB(B0, 0, 0); PG8_LDB(B1, 0, 1); PG8_SCHED; PG8_LDA(At, 0, 0); PG8_STAGE(PG8_SA(1, 1), a1 + hstep, voffA);
            PG8_WAIT_V(8); PG8_WAIT_L(0); PG8_BAR; PG8_MMA(0, 0, At, B0); PG8_MMA(0, 1, At, B1); PG8_BAR; PG8_SCHED;
            PG8_LDA(At, 0, 1); PG8_STAGE(PG8_SB(0, 0), b2, voffB); PG8_STAGE(PG8_SB(0, 1), b2 + hstep, voffB); PG8_STAGE(PG8_SA(0, 0), a2, voffA);
            PG8_WAIT_V(8); PG8_WAIT_L(0); PG8_BAR; PG8_MMA(1, 0, At, B0); PG8_MMA(1, 1, At, B1); PG8_BAR; PG8_SCHED;
            PG8_LDB(B0, 1, 0); PG8_LDB(B1, 1, 1); PG8_SCHED; PG8_LDA(At, 1, 0); PG8_STAGE(PG8_SA(0, 1), a2 + hstep, voffA);
            PG8_WAIT_V(8); PG8_WAIT_L(0); PG8_BAR; PG8_MMA(0, 0, At, B0); PG8_MMA(0, 1, At, B1); PG8_BAR; PG8_SCHED;
            PG8_LDA(At, 1, 1); PG8_STAGE(PG8_SB(1, 0), b3, voffB); PG8_STAGE(PG8_SB(1, 1), b3 + hstep, voffB); PG8_STAGE(PG8_SA(1, 0), a3, voffA);
            PG8_WAIT_V(8); PG8_WAIT_L(0); PG8_BAR; PG8_MMA(1, 0, At, B0); PG8_MMA(1, 1, At, B1); PG8_BAR; PG8_SCHED;
        }
        if (wr == 0) PG8_BAR;
        E(acc, cur, wr, wc, fr, fq);
        if (!has_next) break;
#pragma unroll
        for (int a = 0; a < 2; ++a)
#pragma unroll
            for (int b = 0; b < 2; ++b)
#pragma unroll
                for (int m = 0; m < 4; ++m)
#pragma unroll
                    for (int n = 0; n < 2; ++n) acc[a][b][m][n] = (f32x4){0.f, 0.f, 0.f, 0.f};
        cur = nxt; cA = nA; cB = nB; ++ui;
        if (wr == 1) PG8_BAR;
    }
    PG8_WAIT_V(0);
    PG8_BAR;
#undef PG8_SA
#undef PG8_SB
#undef PG8_STAGE
#undef PG8_LDA
#undef PG8_LDB
#undef PG8_MMA
#undef PG8_WAIT_V
#undef PG8_WAIT_L
#undef PG8_BAR
#undef PG8_SCHED
}
}

#define SBAR() __builtin_amdgcn_sched_barrier(0)
__device__ __forceinline__ int crow(int r, int hi) { return (r & 3) + 8 * (r >> 2) + 4 * hi; }
constexpr float ATT_THR = 8.f;
template <int DQK> struct AttC { static constexpr float SCALE = (DQK == 64) ? 0.125f : 0.10206207261596575f; static constexpr float C = SCALE * 1.4426950408889634f; };
template <int DQK>
__device__ __forceinline__ void partialSM(f32x16& p0, f32x16& p1, float& m_reg, float& mn, float& alpha) {
    constexpr float C = AttC<DQK>::C, SC = AttC<DQK>::SCALE;
    float pmax = p0[0];
#pragma unroll
    for (int r = 1; r < 16; ++r) pmax = fmaxf(pmax, p0[r]);
#pragma unroll
    for (int r = 0; r < 16; ++r) pmax = fmaxf(pmax, p1[r]);
    { auto rr = __builtin_amdgcn_permlane32_swap(__float_as_uint(pmax), __float_as_uint(pmax), false, false);
      pmax = fmaxf(__uint_as_float(rr[0]), __uint_as_float(rr[1])); }
    if (__builtin_expect(__all(pmax - m_reg <= ATT_THR / SC), 1)) { mn = m_reg; alpha = 1.f; }
    else { mn = fmaxf(m_reg, pmax); alpha = __builtin_amdgcn_exp2f((m_reg - mn) * C); m_reg = mn; }
    const float mnC = -mn * C;
#pragma unroll
    for (int r = 0; r < 16; ++r) p0[r] = fmaf(p0[r], C, mnC);
#pragma unroll
    for (int r = 0; r < 16; ++r) p1[r] = fmaf(p1[r], C, mnC);
#pragma unroll
    for (int r = 0; r < 16; ++r) p0[r] = __builtin_amdgcn_exp2f(p0[r]);
}
__device__ __forceinline__ void finishSM(f32x16& p0, f32x16& p1, float alpha, float& l_reg, bf16x8& pa0, bf16x8& pa1, bf16x8& pa2, bf16x8& pa3) {
#pragma unroll
    for (int r = 0; r < 16; ++r) p1[r] = __builtin_amdgcn_exp2f(p1[r]);
    float ps = 0;
#pragma unroll
    for (int r = 0; r < 16; ++r) ps += p0[r];
#pragma unroll
    for (int r = 0; r < 16; ++r) ps += p1[r];
    { auto rr = __builtin_amdgcn_permlane32_swap(__float_as_uint(ps), __float_as_uint(ps), false, false);
      ps = __uint_as_float(rr[0]) + __uint_as_float(rr[1]); }
    l_reg = l_reg * alpha + ps;
#define PK4(P, BASE, OUT) do { unsigned a0 = cvtpk(P[BASE + 0], P[BASE + 1]), a1 = cvtpk(P[BASE + 2], P[BASE + 3]);   \
    unsigned b0 = cvtpk(P[BASE + 4], P[BASE + 5]), b1 = cvtpk(P[BASE + 6], P[BASE + 7]);                              \
    auto r0 = __builtin_amdgcn_permlane32_swap(a0, b0, false, false); auto r1 = __builtin_amdgcn_permlane32_swap(a1, b1, false, false); \
    u32x4 w = {r0[0], r1[0], r0[1], r1[1]}; OUT = __builtin_bit_cast(bf16x8, w); } while (0)
    PK4(p0, 0, pa0); PK4(p0, 8, pa1); PK4(p1, 0, pa2); PK4(p1, 8, pa3);
#undef PK4
}
template <int DQK>
__device__ __forceinline__ void qkt(f32x16& p0, f32x16& p1, const char* Ks, const bf16x8* qr, int r32, int hi) {
    constexpr int KROW = 2 * DQK + 16;
    p0 = f32x16{}; p1 = f32x16{};
#pragma unroll
    for (int d0 = 0; d0 < DQK / 16; ++d0) { const int cb = (d0 * 16 + hi * 8) * 2;
        const bf16x8 b0 = *reinterpret_cast<const bf16x8*>(Ks + r32 * KROW + cb);
        const bf16x8 b1 = *reinterpret_cast<const bf16x8*>(Ks + (32 + r32) * KROW + cb);
        p0 = __builtin_amdgcn_mfma_f32_32x32x16_bf16(b0, qr[d0], p0, 0, 0, 0);
        p1 = __builtin_amdgcn_mfma_f32_32x32x16_bf16(b1, qr[d0], p1, 0, 0, 0); }
}
template <int DV> __device__ __forceinline__ int v_st(int k, int c) { const int kk = (k & ~0xC) | ((k & 4) << 1) | ((k & 8) >> 1); return ((kk >> 3) * (DV / 32) + (c >> 5)) * 512 + ((kk & 7) * 32 + (c & 31)) * 2; }
__device__ __forceinline__ int v_rd_base(int lane) { return ((lane & 3) << 3) | (((lane >> 2) & 3) << 6) | (((lane >> 4) & 1) << 5) | (((lane >> 5) & 1) << 8); }
template <int OFF> __device__ __forceinline__ s16x4 tr_read(int vb) {
    s16x4 r; asm volatile("ds_read_b64_tr_b16 %0, %1 offset:%2" : "=&v"(r) : "v"(vb), "i"(OFF) : "memory"); return r;
}
template <int DV, int D0> __device__ __forceinline__ void pv_one(f32x16& od, int vb, bf16x8 pa0, bf16x8 pa1, bf16x8 pa2, bf16x8 pa3) {
    constexpr int KS = 2 * (DV / 32) * 512, HF = (DV / 32) * 512, B0 = D0 * 512;
    const s16x4 l0 = tr_read<B0>(vb), h0 = tr_read<B0 + HF>(vb), l1 = tr_read<B0 + KS>(vb), h1 = tr_read<B0 + KS + HF>(vb);
    const s16x4 l2 = tr_read<B0 + 2 * KS>(vb), h2 = tr_read<B0 + 2 * KS + HF>(vb), l3 = tr_read<B0 + 3 * KS>(vb), h3 = tr_read<B0 + 3 * KS + HF>(vb);
    asm volatile("s_waitcnt lgkmcnt(0)" ::: "memory"); SBAR();
#define PK(L, H) (bf16x8){L[0], L[1], L[2], L[3], H[0], H[1], H[2], H[3]}
    od = __builtin_amdgcn_mfma_f32_32x32x16_bf16(pa0, PK(l0, h0), od, 0, 0, 0);
    od = __builtin_amdgcn_mfma_f32_32x32x16_bf16(pa1, PK(l1, h1), od, 0, 0, 0);
    od = __builtin_amdgcn_mfma_f32_32x32x16_bf16(pa2, PK(l2, h2), od, 0, 0, 0);
    od = __builtin_amdgcn_mfma_f32_32x32x16_bf16(pa3, PK(l3, h3), od, 0, 0, 0);
#undef PK
}
template <int DV> __device__ __forceinline__ void pv_all(f32x16* o, int vb, bf16x8 pa0, bf16x8 pa1, bf16x8 pa2, bf16x8 pa3) {
    pv_one<DV, 0>(o[0], vb, pa0, pa1, pa2, pa3); pv_one<DV, 1>(o[1], vb, pa0, pa1, pa2, pa3);
    if constexpr (DV == 128) { pv_one<DV, 2>(o[2], vb, pa0, pa1, pa2, pa3); pv_one<DV, 3>(o[3], vb, pa0, pa1, pa2, pa3); }
}
template <int DQK, int DV>
__device__ __forceinline__ void attn_pass(const bf16_t* __restrict__ Qb, int ldq, const bf16_t* __restrict__ Kh, int ldk, const bf16_t* __restrict__ Vh, int ldv, int seq, char* lds, f32x16* o) {
    constexpr int KROW = 2 * DQK + 16, SHM_K = 64 * KROW, SHM_V = 64 * DV * 2, KCH = DQK / 8, VCH = DV / 8, KP = 64 * KCH, VP = 64 * VCH, KN = (KP + 511) / 512, VN = (VP + 511) / 512, ND = DV / 32;
    const int tid = threadIdx.x, wid = tid >> 6, lane = tid & 63, r32 = lane & 31, hi = lane >> 5;
    char* V_lds = lds; char* K_lds = lds + 2 * SHM_V;
    float* wsf = (float*)(lds + 2 * SHM_V + 2 * SHM_K) + wid * 64; float* li_l = wsf; float* al_l = wsf + 32;
    float m_reg = -1e30f, l_reg = 0; bf16x8 qr[DQK / 16];
#pragma unroll
    for (int d = 0; d < ND; ++d) o[d] = f32x16{};
    const bf16_t* Qw = Qb + (size_t)(wid * 32 + r32) * ldq + hi * 8;
#pragma unroll
    for (int d0 = 0; d0 < DQK / 16; ++d0) qr[d0] = *reinterpret_cast<const bf16x8*>(Qw + d0 * 16);
    unsigned koff[KN], voff[VN]; int kdst[KN], vdst[VN]; bool kval[KN], vval[VN];
#pragma unroll
    for (int i = 0; i < KN; ++i) { const int p = tid + 512 * i, row = p / KCH, ch = p % KCH; kval[i] = p < KP; koff[i] = (unsigned)(row * ldk + ch * 8) * 2u; kdst[i] = row * KROW + ch * 16; }
#pragma unroll
    for (int i = 0; i < VN; ++i) { const int p = tid + 512 * i, row = p / VCH, ch = p % VCH; vval[i] = p < VP; voff[i] = (unsigned)(row * ldv + ch * 8) * 2u; vdst[i] = v_st<DV>(row, ch * 8); }
    const int vb0 = (int)(uintptr_t)V_lds + v_rd_base(lane);
    bf16x8 sk[2][KN], sv[2][VN];
#define KOK(q_) (512 * (q_) + 511 < KP || kval[q_])
#define VOK(q_) (512 * (q_) + 511 < VP || vval[q_])
#define SLOAD(i, k0) do { const char* vb_ = (const char*)Vh + (size_t)(k0) * ldv * 2; const char* kb_ = (const char*)Kh + (size_t)(k0) * ldk * 2; \
    _Pragma("unroll") for (int q_ = 0; q_ < VN; ++q_) if (VOK(q_)) sv[i][q_] = *reinterpret_cast<const bf16x8*>(vb_ + voff[q_]); \
    _Pragma("unroll") for (int q_ = 0; q_ < KN; ++q_) if (KOK(q_)) sk[i][q_] = *reinterpret_cast<const bf16x8*>(kb_ + koff[q_]); } while (0)
#define SWRITE(b, i) do { _Pragma("unroll") for (int q_ = 0; q_ < VN; ++q_) if (VOK(q_)) *(bf16x8*)(V_lds + (b) * SHM_V + vdst[q_]) = sv[i][q_]; \
    _Pragma("unroll") for (int q_ = 0; q_ < KN; ++q_) if (KOK(q_)) *(bf16x8*)(K_lds + (b) * SHM_K + kdst[q_]) = sk[i][q_]; } while (0)
#define RESC(a) do { if (__any((a) < 1.f)) { if (hi == 0) al_l[r32] = (a); asm volatile("s_waitcnt lgkmcnt(0)" ::: "memory"); \
    _Pragma("unroll") for (int d = 0; d < ND; ++d) _Pragma("unroll") for (int r = 0; r < 16; ++r) o[d][r] *= al_l[crow(r, hi)]; } } while (0)
    f32x16 pA0, pA1, pB0, pB1; float mnA, mnB, alA, alB; bf16x8 pa0, pa1, pa2, pa3; const int NT = seq / 64;
    SLOAD(0, 0); SWRITE(0, 0); __syncthreads();
    qkt<DQK>(pA0, pA1, K_lds, qr, r32, hi); partialSM<DQK>(pA0, pA1, m_reg, mnA, alA);
    SLOAD(1, 64); if (2 < NT) SLOAD(0, 128);
    SWRITE(1, 1); __syncthreads();
    for (int j = 1; j + 1 < NT; j += 2) {
        SBAR(); qkt<DQK>(pB0, pB1, K_lds + SHM_K, qr, r32, hi);
        finishSM(pA0, pA1, alA, l_reg, pa0, pa1, pa2, pa3); SBAR();
        SLOAD(1, (j + 2) * 64); SBAR();
        pv_all<DV>(o, vb0, pa0, pa1, pa2, pa3); partialSM<DQK>(pB0, pB1, m_reg, mnB, alB);
        __syncthreads(); SWRITE(0, 0);
        RESC(alB); __syncthreads();
        SBAR(); qkt<DQK>(pA0, pA1, K_lds, qr, r32, hi);
        finishSM(pB0, pB1, alB, l_reg, pa0, pa1, pa2, pa3); SBAR();
        if (j + 3 < NT) SLOAD(0, (j + 3) * 64); SBAR();
        pv_all<DV>(o, vb0 + SHM_V, pa0, pa1, pa2, pa3); partialSM<DQK>(pA0, pA1, m_reg, mnA, alA);
        __syncthreads(); SWRITE(1, 1);
        RESC(alA); __syncthreads();
    }
    SBAR(); qkt<DQK>(pB0, pB1, K_lds + SHM_K, qr, r32, hi);
    finishSM(pA0, pA1, alA, l_reg, pa0, pa1, pa2, pa3); SBAR();
    pv_all<DV>(o, vb0, pa0, pa1, pa2, pa3); partialSM<DQK>(pB0, pB1, m_reg, mnB, alB);
    __syncthreads(); RESC(alB);
    finishSM(pB0, pB1, alB, l_reg, pa0, pa1, pa2, pa3); SBAR();
    pv_all<DV>(o, vb0 + SHM_V, pa0, pa1, pa2, pa3);
    if (hi == 0) li_l[r32] = l_reg; asm volatile("s_waitcnt lgkmcnt(0)" ::: "memory");
#pragma unroll
    for (int r = 0; r < 16; ++r) { const float rl = __builtin_amdgcn_rcpf(li_l[crow(r, hi)]);
#pragma unroll
        for (int d = 0; d < ND; ++d) o[d][r] *= rl; }
    __syncthreads();
#undef SLOAD
#undef SWRITE
#undef RESC
#undef KOK
#undef VOK
}

constexpr int OT_STRIDE = 132;
template <int ND> __device__ __forceinline__ void o_to_lds(const f32x16* o, LAS float* T, int r32, int hi) {
#pragma unroll
    for (int d = 0; d < ND; ++d)
#pragma unroll
        for (int r = 0; r < 16; ++r) T[crow(r, hi) * OT_STRIDE + d * 32 + r32] = o[d][r];
    asm volatile("s_waitcnt lgkmcnt(0)" ::: "memory");
}
__device__ __forceinline__ void attn_phase(const Params& P, const Frame& F) {
    const bf16_t* QA = (const bf16_t*)(P.ws + WS_QA); const bf16_t* KA = (const bf16_t*)(P.ws + WS_KA); const bf16_t* VA = (const bf16_t*)(P.ws + WS_VA);
    const bf16_t* QB = (const bf16_t*)(P.ws + WS_QB); const bf16_t* KB = (const bf16_t*)(P.ws + WS_KB); const bf16_t* VB = (const bf16_t*)(P.ws + WS_VB);
    bf16_t* CAT = (bf16_t*)(P.ws + WS_CAT);
    float* SCR = (float*)(P.ws + WS_SCR) + ((size_t)F.bid * NWAVES + F.wave) * 4096;
    const float lam = *(const float*)(P.ws + WS_LAM);
    const int vcu = (F.G % 8 == 0) ? (F.bid % 8) * (F.G / 8) + F.bid / 8 : F.bid;
    const int r32 = F.lane & 31, hi = F.lane >> 5, erow = F.lane >> 1, ehalf = F.lane & 1;
    char* lds = (char*)F.lds;
    LAS float* T = (LAS float*)(F.lds + F.wave * (32 * OT_STRIDE * 4));
    int u = vcu;
    for (; u < 512; u += F.G) {
        {
            const int b = u >> 5, h = (u >> 3) & 3, qb = u & 7;
            const size_t krow0 = (size_t)b * TPB, qrow0 = krow0 + CTXL + qb * 256;
            { f32x16 o[4];
              attn_pass<64, 128>(QA + qrow0 * 512 + h * 128, 512, KA + krow0 * 512 + h * 128, 512, VA + krow0 * 512 + h * 128, 512, TPB, lds, o);
              o_to_lds<4>(o, T, r32, hi); }
#pragma unroll 4
            for (int q = 0; q < 16; ++q) *(f32x4*)(SCR + erow * 128 + ehalf * 64 + 4 * q) = *(const LAS f32x4*)(T + erow * OT_STRIDE + ehalf * 64 + 4 * q);
            __syncthreads();
            { f32x16 o[4];
              attn_pass<64, 128>(QA + qrow0 * 512 + h * 128 + 64, 512, KA + krow0 * 512 + h * 128 + 64, 512, VA + krow0 * 512 + h * 128, 512, TPB, lds, o);
              o_to_lds<4>(o, T, r32, hi); }
            float ss = 0.f;
#pragma unroll 4
            for (int q = 0; q < 16; ++q) { LAS f32x4* tp = (LAS f32x4*)(T + erow * OT_STRIDE + ehalf * 64 + 4 * q);
                const f32x4 cv = *(const f32x4*)(SCR + erow * 128 + ehalf * 64 + 4 * q) - *tp * lam; *tp = cv;
                ss += (cv[0] * cv[0] + cv[1] * cv[1]) + (cv[2] * cv[2] + cv[3] * cv[3]); }
            ss += __shfl_xor(ss, 1);
            const float rstd = rsqrtf(ss * (1.f / 128.f) + EPS) * 0.8f;
            asm volatile("s_waitcnt lgkmcnt(0)" ::: "memory");
            bf16_t* dst = CAT + ((size_t)b * SEQ + qb * 256 + F.wave * 32 + erow) * DM + h * 128 + ehalf * 64;
#pragma unroll 2
            for (int q = 0; q < 8; ++q) { const LAS f32x4* tp = (const LAS f32x4*)(T + erow * OT_STRIDE + ehalf * 64 + 8 * q);
                const f32x4 g0 = *(const f32x4*)(P.diff_subln + ehalf * 64 + 8 * q), g1 = *(const f32x4*)(P.diff_subln + ehalf * 64 + 8 * q + 4);
                *(u32x4*)(dst + 8 * q) = pack8(tp[0] * g0 * rstd, tp[1] * g1 * rstd); }
            __syncthreads();
        }
    }
    for (; u < 1536; u += F.G) {
        {
            const int v = u - 512, b = v >> 6, h = (v >> 3) & 7, qb = v & 7;
            const size_t krow0 = (size_t)b * TPB, qrow0 = krow0 + CTXL + qb * 256;
            { f32x16 o[2];
              attn_pass<96, 64>(QB + qrow0 * 768 + h * 96, 768, KB + krow0 * 768 + h * 96, 768, VB + krow0 * 512 + h * 64, 512, TPB, lds, o);
              o_to_lds<2>(o, T, r32, hi); }
            bf16_t* dst = CAT + ((size_t)b * SEQ + qb * 256 + F.wave * 32 + erow) * DM + 512 + h * 64 + ehalf * 32;
#pragma unroll
            for (int q = 0; q < 4; ++q) { const LAS f32x4* tp = (const LAS f32x4*)(T + erow * OT_STRIDE + ehalf * 32 + 8 * q); *(u32x4*)(dst + 8 * q) = pack8(tp[0], tp[1]); }
            __syncthreads();
        }
    }
}

__device__ __forceinline__ void p8_phase(const Params& P, const Frame& F) {
    for (int r = F.gwi; r < MLAT; r += F.ngw) {
        float* row = P.out + (size_t)r * DM; f32x4 v[4]; float s = 0.f;
#pragma unroll
        for (int j = 0; j < 4; ++j) { v[j] = *(const f32x4*)(row + 4 * F.lane + 256 * j); s += (v[j].x * v[j].x + v[j].y * v[j].y) + (v[j].z * v[j].z + v[j].w * v[j].w); }
        const float rstd = rsqrtf(wave_sum(s) * (1.f / DM) + EPS);
#pragma unroll
        for (int j = 0; j < 4; ++j) { const f32x4 g = *(const f32x4*)(P.final_norm + 4 * F.lane + 256 * j); *(f32x4*)(row + 4 * F.lane + 256 * j) = v[j] * rstd * g; }
    }
}


#define XB_TMO      128
#define XB_XCNT(j)  (256  + 64 * (j))
#define XB_XSUB(j)  (1280 + 64 * (j))
#define XB_XGEN(j)  (2304 + 64 * (j))
#define XB_TOP      3328
#define XB_TOPGEN   3392
#define XCD_BAR_WORDS 3456
#define XB_SPIN_CAP (1u << 20)
__device__ __forceinline__ unsigned xb_ld(unsigned* p)              { return __hip_atomic_load(p, __ATOMIC_RELAXED, __HIP_MEMORY_SCOPE_AGENT); }
__device__ __forceinline__ unsigned xb_add(unsigned* p, unsigned v) { return __hip_atomic_fetch_add(p, v, __ATOMIC_RELAXED, __HIP_MEMORY_SCOPE_AGENT); }
__device__ __forceinline__ unsigned xb_xcc_id() { return (unsigned)__builtin_amdgcn_s_getreg((3 << 11) | 20) & 0xFu; }
#define XB_SPIN(cond, bar) do { unsigned _sp = 0; while (cond) { __builtin_amdgcn_s_sleep(1); \
    if ((++_sp & 255u) == 0u) { if (xb_ld(&(bar)[XB_TMO])) break; if (_sp > XB_SPIN_CAP) { atomicAdd(&(bar)[XB_TMO], 1u); break; } } } } while (0)
struct XcdBarrier { unsigned* bar; unsigned x; volatile LAS unsigned* st; };
__device__ __forceinline__ XcdBarrier xcd_barrier_post(unsigned* bar, volatile LAS unsigned* st) {
    XcdBarrier b; b.bar = bar; b.x = xb_xcc_id(); b.st = st;
    if (threadIdx.x == 0) (void)xb_add(&bar[XB_XCNT(b.x)], 1u);
    return b;
}
__device__ __forceinline__ void xcd_barrier_complete(unsigned* bar, unsigned x, unsigned& nloc, unsigned& nx) {
    const unsigned G = gridDim.x * gridDim.y * gridDim.z;
    unsigned sum, cnt, mine, sp = 0u;
    for (;;) {
        sum = 0u; cnt = 0u; mine = 0u;
#pragma unroll
        for (unsigned j = 0; j < 16; ++j) { const unsigned c = xb_ld(&bar[XB_XCNT(j)]); sum += c; cnt += (c > 0u) ? 1u : 0u; mine = (j == x) ? c : mine; }
        if (sum == G) break;
        __builtin_amdgcn_s_sleep(1);
        if ((++sp & 255u) == 0u) { if (xb_ld(&bar[XB_TMO])) break; if (sp > XB_SPIN_CAP) { atomicAdd(&bar[XB_TMO], 1u); break; } }
    }
    nloc = mine > 0u ? mine : 1u; nx = cnt > 0u ? cnt : 1u;
}
__device__ __forceinline__ void xcd_barrier(const XcdBarrier& b) {
    asm volatile("s_waitcnt vmcnt(0)" ::: "memory");
    __syncthreads();
    if (threadIdx.x == 0) {
        unsigned* bar = b.bar;
        __builtin_amdgcn_s_waitcnt(0);
        unsigned nloc = b.st[0], nx = b.st[1];
        if (nloc == 0u) { xcd_barrier_complete(bar, b.x, nloc, nx); b.st[0] = nloc; b.st[1] = nx; }
        const unsigned old = xb_add(&bar[XB_XSUB(b.x)], 1u);
        const unsigned gen = old / nloc;
        if (old + 1u == (gen + 1u) * nloc) {
            __builtin_amdgcn_fence(__ATOMIC_RELEASE, "agent");
            asm volatile("s_waitcnt vmcnt(0)" ::: "memory");
            const unsigned og = xb_add(&bar[XB_TOP], 1u);
            const unsigned tg = og / nx;
            if (og + 1u == (tg + 1u) * nx) xb_add(&bar[XB_TOPGEN], 1u);
            else XB_SPIN(xb_ld(&bar[XB_TOPGEN]) == tg, bar);
            __builtin_amdgcn_fence(__ATOMIC_ACQUIRE, "agent");
            xb_add(&bar[XB_XGEN(b.x)], 1u);
            asm volatile("s_waitcnt vmcnt(0)" ::: "memory");
        } else {
            XB_SPIN(xb_ld(&bar[XB_XGEN(b.x)]) == gen, bar);
            __builtin_amdgcn_fence(__ATOMIC_ACQUIRE, "agent");
            asm volatile("s_waitcnt vmcnt(0)" ::: "memory");
        }
    }
    __syncthreads();
}

#ifndef MK_FUSED
#define MK_FUSED 1
#endif
#ifndef MK_SYNC
#define MK_SYNC 1
#endif
constexpr int LDS_BYTES = 147456;
constexpr int NPHASE = 9;
__global__ void __launch_bounds__(NTHREADS, 2) mk_kernel(Params P, int lo, int hi) {
    extern __shared__ __attribute__((aligned(16))) unsigned char lds_raw[];
    Frame F; F.tid = threadIdx.x; F.lane = F.tid & 63; F.wave = __builtin_amdgcn_readfirstlane(F.tid >> 6); F.G = gridDim.x; F.bid = blockIdx.x;
    F.gwi = F.wave * F.G + F.bid; F.ngw = F.G * NWAVES; F.lds = (LAS unsigned char*)lds_raw;
#if MK_SYNC == 0
    cg::grid_group grid = cg::this_grid();
#define GRID_BAR() grid.sync()
#else
    volatile LAS unsigned* MISC = (volatile LAS unsigned*)(F.lds + LDS_BYTES - 256);
    if (F.tid < 64) MISC[F.tid] = 0u;
    __syncthreads();
    XcdBarrier xbar; xbar.bar = (unsigned*)(P.ws + WS_BAR); xbar.x = 0; xbar.st = nullptr;
    if (hi - lo > 1) xbar = xcd_barrier_post((unsigned*)(P.ws + WS_BAR), MISC);
#define GRID_BAR() xcd_barrier(xbar)
#endif
#define IN(k) (lo <= (k) && (k) < hi)
#define SEAM(k) do { if (IN(k) && IN((k) + 1)) GRID_BAR(); } while (0)
    bf16_t* WS16 = (bf16_t*)P.ws; (void)WS16;
    if (IN(0)) p0_phase(P, F);
    SEAM(0);
    if (IN(1)) p1_phase(P, F);
    SEAM(1);
    if (IN(2)) {
        TileOrder S; S.init(MROWS / 256, NIN / 256, F.G, F.bid);
        EpiQKV E{(bf16_t*)(P.ws + WS_QA), (bf16_t*)(P.ws + WS_KA), (bf16_t*)(P.ws + WS_VA), (bf16_t*)(P.ws + WS_CQ), (bf16_t*)(P.ws + WS_CKV), (bf16_t*)(P.ws + WS_KB),
                 (float*)(P.ws + WS_SSQQ), (float*)(P.ws + WS_SSQKV), rope_tab(P)};
        pg8::gemm_phase(F.lds, pg8::Gemm{(const bf16_t*)(P.ws + WS_H), (const bf16_t*)(P.ws + WS_WIN), 1024}, S, E);
    }
    SEAM(2);
    if (IN(3)) {
        { TileOrder S; S.init(MLAT / 256, 3, F.G, F.bid); EpiQup E{(bf16_t*)(P.ws + WS_QB), (const float*)(P.ws + WS_SSQQ), rope_tab(P)};
          Unit u; for (int i = 0; S.next(i, u); ++i) { u.pm = u.pm + (u.pm >> 3) + 1; gemm_unit_simple(F, (const bf16_t*)(P.ws + WS_CQ), (const bf16_t*)(P.ws + WS_WQUP), 256, u, E); } }
        { TileOrder S; S.init(MROWS / 256, 4, F.G, F.bid); EpiKVup E{(bf16_t*)(P.ws + WS_KB), (bf16_t*)(P.ws + WS_VB), (const float*)(P.ws + WS_SSQKV)};
          Unit u; for (int i = 0; S.next(i, u); ++i) gemm_unit_simple(F, (const bf16_t*)(P.ws + WS_CKV), (const bf16_t*)(P.ws + WS_WKVUP), 128, u, E); }
    }
    SEAM(3);
    if (IN(4)) attn_phase(P, F);
    SEAM(4);
    if (IN(5)) {
        TileOrder S; S.init(MLAT / 256, 4, F.G, F.bid); EpiOut E{P.x, P.out, (bf16_t*)(P.ws + WS_A2), (const float*)(P.ws + WS_MOD), (float*)(P.ws + WS_SSQ2)};
        pg8::gemm_phase(F.lds, pg8::Gemm{(const bf16_t*)(P.ws + WS_CAT), (const bf16_t*)(P.ws + WS_WOUT), 1024}, S, E);
    }
    SEAM(5);
    if (IN(6)) {
        TileOrder S; S.init(MLAT / 256, 22, F.G, F.bid); EpiFfnIn E{(bf16_t*)(P.ws + WS_G), (const float*)(P.ws + WS_SSQ2), (const float*)(P.ws + WS_BIASF)};
        pg8::gemm_phase(F.lds, pg8::Gemm{(const bf16_t*)(P.ws + WS_A2), (const bf16_t*)(P.ws + WS_WFFI), 1024}, S, E);
    }
    SEAM(6);
    if (IN(7)) {
        TileOrder S; S.init(MLAT / 256, 4, F.G, F.bid); EpiFfnOut E{P.out, (const float*)(P.ws + WS_MOD)};
        pg8::gemm_phase(F.lds, pg8::Gemm{(const bf16_t*)(P.ws + WS_G), (const bf16_t*)(P.ws + WS_WFFO), FFH}, S, E);
    }
    SEAM(7);
    if (IN(8)) p8_phase(P, F);
#undef IN
#undef SEAM
#undef GRID_BAR
}

extern "C" void kernel_launch(void* const* d_in, const int* in_sizes, int n_in, void* d_out, int out_size, void* d_ws, size_t ws_size, hipStream_t stream) {
    static int grid = 0;
    if (grid == 0) {
        if (n_in != 17 || in_sizes[0] != MLAT * DM || out_size != MLAT * DM || ws_size < WS_END) {
            fprintf(stderr, "kernel_launch: unexpected shapes: n_in %d in0 %d out %d ws %zu (need %zu)\n", n_in, n_in > 0 ? in_sizes[0] : -1, out_size, ws_size, (size_t)WS_END); grid = -1; return; }
        if (hipFuncSetAttribute((const void*)mk_kernel, hipFuncAttributeMaxDynamicSharedMemorySize, LDS_BYTES) != hipSuccess) { fprintf(stderr, "kernel_launch: hipFuncSetAttribute failed\n"); grid = -1; return; }
        int dev = 0, cus = 0, per_cu = 0;
        (void)hipGetDevice(&dev); (void)hipDeviceGetAttribute(&cus, hipDeviceAttributeMultiprocessorCount, dev);
        if (hipOccupancyMaxActiveBlocksPerMultiprocessor(&per_cu, (const void*)mk_kernel, NTHREADS, LDS_BYTES) != hipSuccess || per_cu < 1) { fprintf(stderr, "kernel_launch: occupancy query says %d blocks/CU\n", per_cu); per_cu = 1; }
        (void)hipGetLastError();
        grid = cus;
        if (grid <= 0) grid = 256;
    }
    if (grid < 0) return;
    (void)hipMemsetAsync(d_ws, 0, CTL_BYTES, stream);
    Params p{};
    p.x = (const float*)d_in[0]; p.c = (const float*)d_in[1]; p.ctx = (const float*)d_in[2]; p.c_ctx = (const float*)d_in[3]; p.w_ada = (const float*)d_in[4]; p.b_ada = (const float*)d_in[5];
    p.w_in = (const float*)d_in[6]; p.q_a_norm = (const float*)d_in[7]; p.kv_a_norm = (const float*)d_in[8]; p.w_q_up = (const float*)d_in[9]; p.w_kv_up = (const float*)d_in[10];
    p.diff_lambda = (const float*)d_in[11]; p.diff_subln = (const float*)d_in[12]; p.w_out = (const float*)d_in[13]; p.w_ffn_in = (const float*)d_in[14]; p.w_ffn_out = (const float*)d_in[15];
    p.final_norm = (const float*)d_in[16]; p.out = (float*)d_out; p.ws = (unsigned char*)d_ws;
#if MK_FUSED
#if MK_SYNC == 0
    int lo = 0, hi = NPHASE; void* args[] = {&p, &lo, &hi};
    hipError_t e = hipLaunchCooperativeKernel((const void*)mk_kernel, dim3(grid), dim3(NTHREADS), args, LDS_BYTES, stream);
    if (e != hipSuccess) fprintf(stderr, "kernel_launch: cooperative launch failed: %s (grid %d)\n", hipGetErrorString(e), grid);
#else
    hipLaunchKernelGGL(mk_kernel, dim3(grid), dim3(NTHREADS), LDS_BYTES, stream, p, 0, NPHASE);
    { const hipError_t le = hipPeekAtLastError(); if (le != hipSuccess) fprintf(stderr, "kernel_launch: launch failed: %s\n", hipGetErrorName(le)); }
#endif
#else
    for (int ph = 0; ph < NPHASE; ++ph) {
        hipLaunchKernelGGL(mk_kernel, dim3(grid), dim3(NTHREADS), LDS_BYTES, stream, p, ph, ph + 1);
        const hipError_t le = hipPeekAtLastError();
        if (le != hipSuccess) { fprintf(stderr, "kernel_launch: launch %d failed: %s\n", ph, hipGetErrorName(le)); break; }
    }
#endif
}
```

```cpp
#include <hip/hip_runtime.h>
#include <hip/hip_cooperative_groups.h>
#include <cstdint>
#include <cstdio>
namespace cg = cooperative_groups;

#define LAS __attribute__((address_space(3)))
typedef unsigned short bf16_t;
typedef short bf16x8 __attribute__((ext_vector_type(8)));
typedef short s16x4 __attribute__((ext_vector_type(4)));
typedef float f32x2 __attribute__((ext_vector_type(2)));
typedef float f32x4 __attribute__((ext_vector_type(4)));
typedef float f32x16 __attribute__((ext_vector_type(16)));
typedef unsigned u32x2 __attribute__((ext_vector_type(2)));
typedef unsigned u32x4 __attribute__((ext_vector_type(4)));
typedef __bf16 bf16x2_t __attribute__((ext_vector_type(2)));

constexpr int DM = 1024, NB = 16, SEQ = 2048, CTXL = 256, TPB = SEQ + CTXL;
constexpr int MROWS = NB * TPB, MLAT = NB * SEQ;
constexpr int FFH = 2816, NIN = 2048, NADA = 6 * DM;
constexpr float EPS = 1e-6f;
constexpr int NWAVES = 8, NTHREADS = 512;

constexpr size_t KiB = 1024, MiB = 1024 * 1024;
constexpr size_t WS_MOD = 0, WS_BIASF = 512 * KiB, WS_SSQQ = 1024 * KiB, WS_SSQKV = 1184 * KiB, WS_SSQ2 = 1344 * KiB, WS_LAM = 1536 * KiB, WS_BAR = 1792 * KiB;
constexpr size_t CTL_BYTES = 2 * MiB;
constexpr size_t WS_TAB = 2 * MiB;
constexpr size_t WS_WIN = 3 * MiB, WS_WQUP = 7 * MiB, WS_WKVUP = 7 * MiB + 512 * KiB, WS_WOUT = 8 * MiB, WS_WFFI = 10 * MiB, WS_WFFO = 21 * MiB;
constexpr size_t WS_A2 = 27 * MiB, WS_CAT = 91 * MiB;
constexpr size_t WS_H = 155 * MiB, WS_QB = 155 * MiB, WS_QA = 227 * MiB, WS_KA = 263 * MiB, WS_VA = 299 * MiB, WS_CQ = 335 * MiB, WS_CKV = 353 * MiB;
constexpr size_t WS_KB = 362 * MiB, WS_VB = 416 * MiB, WS_SCR = 452 * MiB, WS_G = 155 * MiB, WS_END = 484 * MiB;
static_assert(WS_G + (size_t)MLAT * FFH * 2 <= WS_CQ, "G overlay");
static_assert(WS_WFFO + (size_t)DM * FFH * 2 <= WS_A2, "wffo");

struct Params {
    const float *x, *c, *ctx, *c_ctx, *w_ada, *b_ada, *w_in, *q_a_norm, *kv_a_norm, *w_q_up, *w_kv_up, *diff_lambda, *diff_subln, *w_out, *w_ffn_in, *w_ffn_out, *final_norm;
    float* out; unsigned char* ws;
};

__device__ __forceinline__ unsigned cvtpk(float lo, float hi) { f32x2 v = {lo, hi}; bf16x2_t b = __builtin_convertvector(v, bf16x2_t); return __builtin_bit_cast(unsigned, b); }
__device__ __forceinline__ float wave_sum(float v) {
#pragma unroll
    for (int o = 1; o < 64; o <<= 1) v += __shfl_xor(v, o);
    return v;
}
__device__ __forceinline__ float silu_f(float v) { return v / (1.f + __expf(-v)); }
__device__ __forceinline__ u32x4 pack8(f32x4 a, f32x4 b) { u32x4 w; w.x = cvtpk(a[0], a[1]); w.y = cvtpk(a[2], a[3]); w.z = cvtpk(b[0], b[1]); w.w = cvtpk(b[2], b[3]); return w; }
__device__ __forceinline__ int ropeA_L(int q) { return 4 * ((q >> 3) & 3) + (q & 3) + 16 * ((q >> 2) & 1); }
__device__ __forceinline__ int ropeB_L(int q) { const int a = q >> 3, n = (q >> 2) & 1, j = q & 3; return (a >> 1) * 16 + (a & 1) * 4 + j + 8 * n; }

struct Frame { int tid, lane, wave, G, bid, gwi, ngw; bool dry; LAS unsigned char* lds; };

__device__ __forceinline__ void p0_ada_task(const Params& P, float* MOD, int t, int lane, bool dry) {
    const int cgp = t % 24, kc = t / 24, k0 = kc * 32, n = cgp * 256 + lane * 4, k = k0 + (lane & 31);
    float sv[17];
#pragma unroll
    for (int b = 0; b < 16; ++b) sv[b] = silu_f(P.c[b * DM + k]);
    sv[16] = silu_f(P.c_ctx[k]);
    f32x4 acc[17];
    const f32x4 binit = (kc == 0) ? *(const f32x4*)(P.b_ada + n) : (f32x4){0.f, 0.f, 0.f, 0.f};
#pragma unroll
    for (int b = 0; b < 17; ++b) acc[b] = binit;
#pragma unroll 2
    for (int kk = 0; kk < 32; ++kk) {
        const f32x4 w = *(const f32x4*)(P.w_ada + (size_t)(k0 + kk) * NADA + n);
#pragma unroll
        for (int b = 0; b < 17; ++b) { const float s = __shfl(sv[b], kk); acc[b] += w * s; }
    }
#pragma unroll
    for (int b = 0; b < 17; ++b)
#pragma unroll
        for (int j = 0; j < 4; ++j) { if (!dry) atomicAdd(&MOD[b * NADA + n + j], acc[b][j]); else asm volatile("" :: "v"(acc[b][j])); }
}
__device__ __forceinline__ int src_col(int mat, int p) {
    switch (mat) {
    case 0: if (p < 1024) return (p & ~31) + ropeA_L(p & 31); if (p < 1920) return p; if (p < 1952) return 1920 + ropeB_L(p - 1920); return -1;
    case 1: if (p < 512) return (p >> 6) * 96 + (p & 63); { const int q = p - 512; return (q >> 5) * 96 + 64 + ropeB_L(q & 31); }
    case 2: if (p < 512) return (p >> 6) * 128 + (p & 63); { const int q = p - 512; return (q >> 6) * 128 + 64 + (q & 63); }
    case 4: { const int t = p >> 8, q = p & 255; return q < 128 ? 128 * t + q : FFH + 128 * t + (q - 128); }
    default: return p;
    }
}
__device__ __forceinline__ void p0_transpose_item(const float* W, int K, int N, const float* gain, bf16_t* WT, int mat, int npb, LAS float* scr, int item, int lane) {
    const int kb = item / npb, pb = item % npb, k0 = 64 * kb, p0 = 32 * pb;
    const int sc = src_col(mat, p0 + (lane & 31));
#pragma unroll 8
    for (int i = 0; i < 32; ++i) { const int kk = 2 * i + (lane >> 5);
        float v = 0.f; if (sc >= 0) { v = W[(size_t)(k0 + kk) * N + sc]; if (gain) v *= gain[k0 + kk]; }
        scr[kk * 33 + (lane & 31)] = v; }
    asm volatile("s_waitcnt lgkmcnt(0)" ::: "memory");
    const int c = lane & 7;
#pragma unroll
    for (int j = 0; j < 4; ++j) { const int n = (lane >> 3) + 8 * j; const LAS float* s = scr + (8 * c) * 33 + n;
        u32x4 o; o.x = cvtpk(s[0 * 33], s[1 * 33]); o.y = cvtpk(s[2 * 33], s[3 * 33]); o.z = cvtpk(s[4 * 33], s[5 * 33]); o.w = cvtpk(s[6 * 33], s[7 * 33]);
        *(u32x4*)(WT + (size_t)(p0 + n) * K + k0 + 8 * c) = o; }
    asm volatile("s_waitcnt lgkmcnt(0)" ::: "memory");
}
__device__ __forceinline__ void sincos_d(double a, float& s, float& c) {
    const double k = __builtin_rint(a * 0.15915494309189535);
    double r = __builtin_fma(-k, 6.283185307179586, a); r = __builtin_fma(-k, 2.4492935982947064e-16, r);
    const double r2 = r * r; double ts = r, tc = 1.0, ss = r, cc = 1.0;
    for (int n = 0; n < 14; ++n) { tc = -tc * r2 / (double)((2 * n + 1) * (2 * n + 2)); cc += tc; ts = -ts * r2 / (double)((2 * n + 2) * (2 * n + 3)); ss += ts; }
    s = (float)ss; c = (float)cc;
}
__device__ __forceinline__ void p0_phase(const Params& P, const Frame& F) {
    float* MOD = (float*)(P.ws + WS_MOD);
    LAS float* scr = (LAS float*)(F.lds + F.wave * 8448);
    constexpr int NADA_T = 24 * 32;
    constexpr int I0 = 16 * 64, I1 = 4 * 24, I2 = 2 * 32, I3 = 16 * 32, I4 = 16 * 176, I5 = 44 * 32;
    constexpr int NT = NADA_T + I0 + I1 + I2 + I3 + I4 + I5;
    for (int t = F.gwi; t < NT; t += F.ngw) {
        int r = t;
        if (r < NADA_T) { p0_ada_task(P, MOD, r, F.lane, F.dry); continue; } r -= NADA_T;
        if (r < I0) { p0_transpose_item(P.w_in, 1024, 1952, nullptr, (bf16_t*)(P.ws + WS_WIN), 0, 64, scr, r, F.lane); continue; } r -= I0;
        if (r < I1) { p0_transpose_item(P.w_q_up, 256, 768, P.q_a_norm, (bf16_t*)(P.ws + WS_WQUP), 1, 24, scr, r, F.lane); continue; } r -= I1;
        if (r < I2) { p0_transpose_item(P.w_kv_up, 128, 1024, P.kv_a_norm, (bf16_t*)(P.ws + WS_WKVUP), 2, 32, scr, r, F.lane); continue; } r -= I2;
        if (r < I3) { p0_transpose_item(P.w_out, 1024, 1024, nullptr, (bf16_t*)(P.ws + WS_WOUT), 3, 32, scr, r, F.lane); continue; } r -= I3;
        if (r < I4) { p0_transpose_item(P.w_ffn_in, 1024, 2 * FFH, nullptr, (bf16_t*)(P.ws + WS_WFFI), 4, 176, scr, r, F.lane); continue; } r -= I4;
        p0_transpose_item(P.w_ffn_out, FFH, 1024, nullptr, (bf16_t*)(P.ws + WS_WFFO), 5, 32, scr, r, F.lane);
    }
    if (F.bid == F.G - 1) {
        float* TAB = (float*)(P.ws + WS_TAB);
        for (int i = F.tid; i < 1536; i += NTHREADS) {
            float s, c;
            if (i < 1024) { const int pos = i >> 4, f = i & 15; double inv = 1.0; for (int q = 0; q < f; ++q) inv *= 0.5623413251903491; sincos_d((double)pos * inv, s, c); TAB[i] = c; TAB[1024 + i] = s; }
            else { const int e = i - 1024, pos = e >> 3, f = e & 7; double inv = 1.0; for (int q = 0; q < f; ++q) inv *= 0.31622776601683794; sincos_d((double)pos * inv, s, c); TAB[2048 + e] = c; TAB[2560 + e] = s; }
        }
        if (F.wave == 0) {
            const float* lp = P.diff_lambda; const float a = wave_sum(lp[F.lane] * lp[64 + F.lane]), b = wave_sum(lp[128 + F.lane] * lp[192 + F.lane]);
            if (F.lane == 0) *(float*)(P.ws + WS_LAM) = __expf(a) - __expf(b) + 0.2f;
        }
    }
}

__device__ __forceinline__ void p1_phase(const Params& P, const Frame& F) {
    const float* MOD = (const float*)(P.ws + WS_MOD);
    bf16_t* H = (bf16_t*)(P.ws + WS_H);
    for (int r = F.gwi; r < MROWS; r += F.ngw) {
        const int b = r / TPB, t = r - b * TPB;
        const float* src = (t < CTXL) ? P.ctx + ((size_t)b * CTXL + t) * DM : P.x + ((size_t)b * SEQ + (t - CTXL)) * DM;
        const float* mp = MOD + (size_t)((t < CTXL) ? 16 : b) * NADA;
        f32x4 v[4]; float s = 0.f;
#pragma unroll
        for (int j = 0; j < 4; ++j) { v[j] = *(const f32x4*)(src + 4 * F.lane + 256 * j); s += (v[j].x * v[j].x + v[j].y * v[j].y) + (v[j].z * v[j].z + v[j].w * v[j].w); }
        const float rstd = rsqrtf(wave_sum(s) * (1.f / DM) + EPS);
#pragma unroll
        for (int j = 0; j < 4; ++j) { const int col = 4 * F.lane + 256 * j; const f32x4 sh = *(const f32x4*)(mp + col), sc = *(const f32x4*)(mp + DM + col);
            const f32x4 h = v[j] * rstd * (sc + 1.f) + sh; u32x2 w; w.x = cvtpk(h[0], h[1]); w.y = cvtpk(h[2], h[3]);
            *(u32x2*)(H + (size_t)r * DM + col) = w; }
    }
    if (F.gwi < 22 * 16) {
        float* BIASF = (float*)(P.ws + WS_BIASF);
        const int cgp = F.gwi % 22, kc = F.gwi / 22, k0 = kc * 64, n = cgp * 256 + F.lane * 4;
        float sv[16];
#pragma unroll
        for (int b = 0; b < 16; ++b) sv[b] = MOD[(size_t)b * NADA + 3 * DM + k0 + F.lane];
        f32x4 acc[16];
#pragma unroll
        for (int b = 0; b < 16; ++b) acc[b] = (f32x4){0.f, 0.f, 0.f, 0.f};
#pragma unroll 2
        for (int kk = 0; kk < 64; ++kk) {
            const f32x4 w = *(const f32x4*)(P.w_ffn_in + (size_t)(k0 + kk) * (2 * FFH) + n);
#pragma unroll
            for (int b = 0; b < 16; ++b) { const float s = __shfl(sv[b], kk); acc[b] += w * s; }
        }
#pragma unroll
        for (int b = 0; b < 16; ++b)
#pragma unroll
            for (int j = 0; j < 4; ++j) { if (!F.dry) atomicAdd(&BIASF[b * (2 * FFH) + n + j], acc[b][j]); else asm volatile("" :: "v"(acc[b][j])); }
    }
}

struct Unit { int pm, pn; };
__device__ __forceinline__ int perm32(int rho) { const int n = rho >> 4, i = rho & 15; return 8 * (i >> 2) + 4 * n + (i & 3); }
struct TileOrder {
    int nM, nN, nwg, G, c; bool skipctx;
    __device__ __forceinline__ void init(int nM_, int nN_, int G_, int c_, bool skip_ = false) { nM = nM_; nN = nN_; nwg = nM * nN; G = G_; c = c_; skipctx = skip_; }
    __device__ __forceinline__ bool next(int i, Unit& u) const {
        const long L = (long)i * G + c; if (L >= nwg) return false;
        int wgid = (int)L; { const int q = nwg / 8, r = nwg % 8, xcd = wgid % 8, off = wgid / 8; wgid = (xcd < r ? xcd * (q + 1) : r * (q + 1) + (xcd - r) * q) + off; }
        const int nig = 8 * nN, gid = wgid / nig, fm = gid * 8, gsz = (nM - fm) < 8 ? (nM - fm) : 8;
        u.pm = fm + ((wgid % nig) % gsz); u.pn = (wgid % nig) / gsz; if (skipctx) u.pm += (u.pm >> 3) + 1; return true;
    }
};
typedef f32x4 Acc[2][2][4][2];
constexpr int SG_STRIDE = 144;
template <class Epi>
__device__ __forceinline__ void gemm_unit_simple(const Frame& F, const bf16_t* A, const bf16_t* Bt, int K, const Unit u, const Epi& E) {
    const int wr = F.wave >> 2, wc = F.wave & 3, fr = F.lane & 15, fq = F.lane >> 4;
    LAS unsigned char* As = F.lds; LAS unsigned char* Bs = F.lds + 256 * SG_STRIDE;
    Acc acc;
#pragma unroll
    for (int a = 0; a < 2; ++a)
#pragma unroll
        for (int b = 0; b < 2; ++b)
#pragma unroll
            for (int m = 0; m < 4; ++m)
#pragma unroll
                for (int n = 0; n < 2; ++n) acc[a][b][m][n] = (f32x4){0.f, 0.f, 0.f, 0.f};
    const bf16_t* Ag = A + (size_t)u.pm * 256 * K; const bf16_t* Bg = Bt + (size_t)u.pn * 256 * K;
#pragma unroll 1
    for (int kt = 0; kt < K; kt += 64) {
        __syncthreads();
#pragma unroll
        for (int i = 0; i < 4; ++i) { const int p = F.tid + 512 * i, row = p >> 3, ch = p & 7;
            const u32x4 va = *(const u32x4*)(Ag + (size_t)row * K + kt + ch * 8), vb = *(const u32x4*)(Bg + (size_t)row * K + kt + ch * 8);
            *(LAS u32x4*)(As + row * SG_STRIDE + ch * 16) = va; *(LAS u32x4*)(Bs + row * SG_STRIDE + ch * 16) = vb; if (i & 1) asm volatile("" ::: "memory"); }
        __syncthreads();
#pragma unroll
        for (int k2 = 0; k2 < 2; ++k2) {
#pragma unroll
            for (int ai = 0; ai < 2; ++ai) {
                bf16x8 At[4];
#pragma unroll
                for (int m = 0; m < 4; ++m) At[m] = *(const LAS bf16x8*)(As + (128 * ai + 64 * wr + 16 * m + fr) * SG_STRIDE + (32 * k2 + 8 * fq) * 2);
#pragma unroll
                for (int bj = 0; bj < 2; ++bj) {
                    bf16x8 Bf[2];
#pragma unroll
                    for (int n = 0; n < 2; ++n) Bf[n] = *(const LAS bf16x8*)(Bs + (128 * bj + 32 * wc + perm32(16 * n + fr)) * SG_STRIDE + (32 * k2 + 8 * fq) * 2);
#pragma unroll
                    for (int m = 0; m < 4; ++m)
#pragma unroll
                        for (int n = 0; n < 2; ++n) acc[ai][bj][m][n] = __builtin_amdgcn_mfma_f32_16x16x32_bf16(Bf[n], At[m], acc[ai][bj][m][n], 0, 0, 0);
                }
            }
        }
    }
    E(acc, u, wr, wc, fr, fq);
}

struct RopeTab { const float *Ac, *As, *Bc, *Bs; };
__device__ __forceinline__ RopeTab rope_tab(const Params& P) { const float* T = (const float*)(P.ws + WS_TAB); return RopeTab{T, T + 1024, T + 2048, T + 2560}; }
__device__ __forceinline__ void rope_pair(f32x4& v0, f32x4& v1, const f32x4 cs, const f32x4 sn) { const f32x4 a = v0 * cs - v1 * sn, b = v1 * cs + v0 * sn; v0 = a; v1 = b; }

struct EpiQKV {
    bf16_t *QA, *KA, *VA, *CQ, *CKV, *KB; float *SSQQ, *SSQKV; RopeTab T; bool dry;
    __device__ __forceinline__ void operator()(const Acc& acc, const Unit& u, int wr, int wc, int fr, int fq) const {
        const int jb = u.pm % 9; const bool lat = jb != 0; const int pn = u.pn;
        if (!lat && (pn < 2 || pn == 6)) return;
#pragma unroll
        for (int ai = 0; ai < 2; ++ai) {
            const int prow = (jb - 1) * 4 + 2 * ai + wr;
#pragma unroll
            for (int m = 0; m < 4; ++m) {
                const int pcol = 16 * m + fr; const size_t grow = (size_t)u.pm * 256 + 128 * ai + 64 * wr + 16 * m + fr;
                if (pn < 4) {
                    bf16_t* dst = (pn < 2 ? QA : KA) + grow * 512 + (pn & 1) * 256 + 32 * wc + 8 * fq;
                    const int pos = (wc & 1) ? pcol : prow;
                    f32x4 cs = {1.f, 1.f, 1.f, 1.f}, sn = {0.f, 0.f, 0.f, 0.f};
                    if (lat) { cs = *(const f32x4*)(T.Ac + pos * 16 + 4 * fq); sn = *(const f32x4*)(T.As + pos * 16 + 4 * fq); }
#pragma unroll
                    for (int bj = 0; bj < 2; ++bj) { f32x4 v0 = acc[ai][bj][m][0], v1 = acc[ai][bj][m][1]; rope_pair(v0, v1, cs, sn); *(u32x4*)(dst + 128 * bj) = pack8(v0, v1); }
                } else if (pn < 6) {
#pragma unroll
                    for (int bj = 0; bj < 2; ++bj) *(u32x4*)(VA + grow * 512 + (pn - 4) * 256 + 128 * bj + 32 * wc + 8 * fq) = pack8(acc[ai][bj][m][0], acc[ai][bj][m][1]);
                } else if (pn == 6) {
                    float s = 0.f;
#pragma unroll
                    for (int bj = 0; bj < 2; ++bj) { const f32x4 v0 = acc[ai][bj][m][0], v1 = acc[ai][bj][m][1];
                        s += (v0[0] * v0[0] + v0[1] * v0[1]) + (v0[2] * v0[2] + v0[3] * v0[3]) + (v1[0] * v1[0] + v1[1] * v1[1]) + (v1[2] * v1[2] + v1[3] * v1[3]);
                        *(u32x4*)(CQ + grow * 256 + 128 * bj + 32 * wc + 8 * fq) = pack8(v0, v1); }
                    s += __shfl_xor(s, 16); s += __shfl_xor(s, 32);
                    if (fq == 0 && !dry) atomicAdd(SSQQ + grow, s);
                } else {
                    { const f32x4 v0 = acc[ai][0][m][0], v1 = acc[ai][0][m][1];
                      float s = (v0[0] * v0[0] + v0[1] * v0[1]) + (v0[2] * v0[2] + v0[3] * v0[3]) + (v1[0] * v1[0] + v1[1] * v1[1]) + (v1[2] * v1[2] + v1[3] * v1[3]);
                      *(u32x4*)(CKV + grow * 128 + 32 * wc + 8 * fq) = pack8(v0, v1);
                      s += __shfl_xor(s, 16); s += __shfl_xor(s, 32);
                      if (fq == 0 && !dry) atomicAdd(SSQKV + grow, s); }
                    if (wc == 0) {
                        f32x4 v0 = acc[ai][1][m][0], v1 = acc[ai][1][m][1];
                        if (lat) { const int pos = (fq < 2) ? prow : pcol; const f32x4 cs = *(const f32x4*)(T.Bc + pos * 8 + 4 * (fq & 1)), sn = *(const f32x4*)(T.Bs + pos * 8 + 4 * (fq & 1)); rope_pair(v0, v1, cs, sn); }
                        const u32x4 w = pack8(v0, v1);
#pragma unroll
                        for (int h = 0; h < 8; ++h) *(u32x4*)(KB + grow * 768 + h * 96 + 64 + 8 * fq) = w;
                    }
                }
            }
        }
    }
};
struct EpiQup {
    bf16_t* QB; const float* SSQQ; RopeTab T;
    __device__ __forceinline__ void operator()(const Acc& acc, const Unit& u, int wr, int wc, int fr, int fq) const {
        const int jb = u.pm % 9, pn = u.pn;
#pragma unroll
        for (int ai = 0; ai < 2; ++ai) {
            const int prow = (jb - 1) * 4 + 2 * ai + wr;
#pragma unroll
            for (int m = 0; m < 4; ++m) {
                const int pcol = 16 * m + fr; const size_t grow = (size_t)u.pm * 256 + 128 * ai + 64 * wr + 16 * m + fr;
                const float rstd = rsqrtf(SSQQ[grow] * (1.f / 256.f) + EPS);
#pragma unroll
                for (int bj = 0; bj < 2; ++bj) {
                    f32x4 v0 = acc[ai][bj][m][0] * rstd, v1 = acc[ai][bj][m][1] * rstd;
                    if (pn < 2) { const int c = pn * 256 + 128 * bj + 32 * wc + 8 * fq; *(u32x4*)(QB + grow * 768 + (c >> 6) * 96 + (c & 63)) = pack8(v0, v1); }
                    else { const int h = 4 * bj + wc, pos = (fq < 2) ? prow : pcol;
                        const f32x4 cs = *(const f32x4*)(T.Bc + pos * 8 + 4 * (fq & 1)), sn = *(const f32x4*)(T.Bs + pos * 8 + 4 * (fq & 1)); rope_pair(v0, v1, cs, sn);
                        *(u32x4*)(QB + grow * 768 + h * 96 + 64 + 8 * fq) = pack8(v0, v1); }
                }
                asm volatile("" ::: "memory");
            }
        }
    }
};
struct EpiKVup {
    bf16_t *KB, *VB; const float* SSQKV;
    __device__ __forceinline__ void operator()(const Acc& acc, const Unit& u, int wr, int wc, int fr, int fq) const {
        const int pn = u.pn;
#pragma unroll
        for (int ai = 0; ai < 2; ++ai)
#pragma unroll
            for (int m = 0; m < 4; ++m) {
                const size_t grow = (size_t)u.pm * 256 + 128 * ai + 64 * wr + 16 * m + fr;
                const float rstd = rsqrtf(SSQKV[grow] * (1.f / 128.f) + EPS);
#pragma unroll
                for (int bj = 0; bj < 2; ++bj) {
                    const f32x4 v0 = acc[ai][bj][m][0] * rstd, v1 = acc[ai][bj][m][1] * rstd;
                    if (pn < 2) { const int c = pn * 256 + 128 * bj + 32 * wc + 8 * fq; *(u32x4*)(KB + grow * 768 + (c >> 6) * 96 + (c & 63)) = pack8(v0, v1); }
                    else *(u32x4*)(VB + grow * 512 + (pn - 2) * 256 + 128 * bj + 32 * wc + 8 * fq) = pack8(v0, v1);
                }
                asm volatile("" ::: "memory");
            }
    }
};
struct EpiOut {
    const float* x; float* out; bf16_t* A2; const float* MOD; float* SSQ2; bool dry;
    __device__ __forceinline__ void operator()(const Acc& acc, const Unit& u, int wr, int wc, int fr, int fq) const {
        const float* mp = MOD + (size_t)(u.pm >> 3) * NADA;
#pragma unroll
        for (int ai = 0; ai < 2; ++ai)
#pragma unroll
            for (int m = 0; m < 4; ++m) {
                const size_t row = (size_t)u.pm * 256 + 128 * ai + 64 * wr + 16 * m + fr; float s = 0.f;
#pragma unroll
                for (int bj = 0; bj < 2; ++bj) {
                    const int col = u.pn * 256 + 128 * bj + 32 * wc + 8 * fq; const size_t off = row * DM + col;
                    f32x4 nv[2];
#pragma unroll
                    for (int n = 0; n < 2; ++n) { const f32x4 ga = *(const f32x4*)(mp + 2 * DM + col + 4 * n), xv = *(const f32x4*)(x + off + 4 * n);
                        nv[n] = xv + ga * acc[ai][bj][m][n]; if (!dry) *(f32x4*)(out + off + 4 * n) = nv[n];
                        s += (nv[n][0] * nv[n][0] + nv[n][1] * nv[n][1]) + (nv[n][2] * nv[n][2] + nv[n][3] * nv[n][3]); }
                    const f32x4 s0 = *(const f32x4*)(mp + 4 * DM + col), s1 = *(const f32x4*)(mp + 4 * DM + col + 4);
                    { const u32x4 pk = pack8(nv[0] * (s0 + 1.f), nv[1] * (s1 + 1.f)); if (!dry) *(u32x4*)(A2 + off) = pk; else asm volatile("" :: "v"(pk)); }
                }
                s += __shfl_xor(s, 16); s += __shfl_xor(s, 32);
                if (fq == 0 && !dry) atomicAdd(SSQ2 + row, s);
            }
    }
};
struct EpiFfnIn {
    bf16_t* G; const float* SSQ2; const float* BIASF;
    __device__ __forceinline__ void operator()(const Acc& acc, const Unit& u, int wr, int wc, int fr, int fq) const {
        const float* bp = BIASF + (size_t)(u.pm >> 3) * (2 * FFH); const int hc = u.pn * 128 + 32 * wc + 8 * fq;
        f32x4 bg[2], bu[2];
#pragma unroll
        for (int n = 0; n < 2; ++n) { bg[n] = *(const f32x4*)(bp + hc + 4 * n); bu[n] = *(const f32x4*)(bp + FFH + hc + 4 * n); }
#pragma unroll
        for (int ai = 0; ai < 2; ++ai)
#pragma unroll
            for (int m = 0; m < 4; ++m) {
                const size_t row = (size_t)u.pm * 256 + 128 * ai + 64 * wr + 16 * m + fr;
                const float rstd = rsqrtf(SSQ2[row] * (1.f / DM) + EPS);
                f32x4 o[2];
#pragma unroll
                for (int n = 0; n < 2; ++n) { const f32x4 g = acc[ai][0][m][n] * rstd + bg[n], up = acc[ai][1][m][n] * rstd + bu[n];
#pragma unroll
                    for (int j = 0; j < 4; ++j) o[n][j] = silu_f(g[j]) * up[j]; }
                *(u32x4*)(G + row * FFH + hc) = pack8(o[0], o[1]);
            }
    }
};
struct EpiFfnOut {
    float* out; const float* MOD; bool dry;
    __device__ __forceinline__ void operator()(const Acc& acc, const Unit& u, int wr, int wc, int fr, int fq) const {
        const float* mp = MOD + (size_t)(u.pm >> 3) * NADA + 5 * DM;
#pragma unroll
        for (int ai = 0; ai < 2; ++ai)
#pragma unroll
            for (int m = 0; m < 4; ++m) {
                const size_t row = (size_t)u.pm * 256 + 128 * ai + 64 * wr + 16 * m + fr;
#pragma unroll
                for (int bj = 0; bj < 2; ++bj)
#pragma unroll
                    for (int n = 0; n < 2; ++n) { const int col = u.pn * 256 + 128 * bj + 32 * wc + 8 * fq + 4 * n; const size_t off = row * DM + col;
                        const f32x4 gf = *(const f32x4*)(mp + col), nl = *(const f32x4*)(out + off); const f32x4 yv = nl + gf * acc[ai][bj][m][n]; if (!dry) *(f32x4*)(out + off) = yv; else asm volatile("" :: "v"(yv)); }
            }
    }
};


namespace pg8 {
constexpr int BK = 64, HALF = 128, HTB = HALF * BK * 2, STAGE_BYTES = 8 * HTB;
__device__ __forceinline__ int lds_byte(int r, int c) { const int st = (r >> 4) * 2 + (c >> 5), rr = r & 15, cc = c & 31, ob = rr * 64 + cc * 2; return st * 1024 + (ob ^ (((ob >> 9) & 1) << 5)); }
__device__ __forceinline__ void stage_rc(int b, int& R, int& C) { const int st = b / 1024, sb = b % 1024, swz = sb ^ (((sb >> 9) & 1) << 5); R = (st >> 1) * 16 + swz / 64; C = (st & 1) * 32 + (swz % 64) / 2; }
struct Gemm { const bf16_t* A; const bf16_t* Bt; int K; };
template <class Epi, class Sched>
__device__ __forceinline__ void gemm_phase(LAS unsigned char* lds, const Gemm g, const Sched& S, const Epi& E) {
    const int tid = threadIdx.x, wid = __builtin_amdgcn_readfirstlane(tid >> 6), lane = tid & 63, wr = wid >> 2, wc = wid & 3, fr = lane & 15, fq = lane >> 4;
    const int K = g.K, nt = K / BK;
    unsigned voffA[2], voffB[2];
#pragma unroll
    for (int i = 0; i < 2; ++i) { int R, C; stage_rc(tid * 16 + i * 8192, R, C); const int Rb = (R & ~31) + perm32(R & 31);
        voffA[i] = (unsigned)(R * K + C) * 2u; voffB[i] = (unsigned)(Rb * K + C) * 2u; }
    const size_t kstep = (size_t)(BK * 2);
    const size_t hstep = (size_t)HALF * K * 2;
    const size_t tstep = 2 * hstep;
    const unsigned ldsw = (unsigned)wid * 1024u;
    const int aoff = lds_byte(wr * 64 + fr, fq * 8), boff = lds_byte(wc * 32 + fr, fq * 8);
#define PG8_SA(b, h) (((b) * 2 + (h)) * HTB)
#define PG8_SB(b, h) ((4 + (b) * 2 + (h)) * HTB)
#define PG8_STAGE(bufoff, gbase, voff) do { _Pragma("unroll") for (int _i = 0; _i < 2; ++_i) \
        __builtin_amdgcn_global_load_lds((const unsigned*)((const char*)(gbase) + (voff)[_i]), (LAS unsigned*)(lds + (bufoff) + ldsw + _i * 8192), 16, 0, 0); } while (0)
#define PG8_LDA(dst, b, h) do { _Pragma("unroll") for (int m = 0; m < 4; ++m) _Pragma("unroll") for (int k = 0; k < 2; ++k) dst[m][k] = *(const LAS bf16x8*)(lds + PG8_SA(b, h) + aoff + m * 2048 + k * 1024); } while (0)
#define PG8_LDB(dst, b, h) do { _Pragma("unroll") for (int n = 0; n < 2; ++n) _Pragma("unroll") for (int k = 0; k < 2; ++k) dst[n][k] = *(const LAS bf16x8*)(lds + PG8_SB(b, h) + boff + n * 2048 + k * 1024); } while (0)
#define PG8_MMA(ai, bj, At, Bt) do { __builtin_amdgcn_s_setprio(1); _Pragma("unroll") for (int m = 0; m < 4; ++m) _Pragma("unroll") for (int n = 0; n < 2; ++n) _Pragma("unroll") for (int k = 0; k < 2; ++k) \
        acc[ai][bj][m][n] = __builtin_amdgcn_mfma_f32_16x16x32_bf16(Bt[n][k], At[m][k], acc[ai][bj][m][n], 0, 0, 0); __builtin_amdgcn_s_setprio(0); } while (0)
#define PG8_WAIT_V(n) asm volatile("s_waitcnt vmcnt(" #n ")" ::: "memory")
#define PG8_WAIT_L(n) asm volatile("s_waitcnt lgkmcnt(" #n ")" ::: "memory")
#define PG8_BAR __builtin_amdgcn_s_barrier()
#define PG8_SCHED __builtin_amdgcn_sched_barrier(0)
    Unit cur, nxt; int ui = 0;
    if (!S.next(0, cur)) return;
    f32x4 acc[2][2][4][2];
#pragma unroll
    for (int a = 0; a < 2; ++a)
#pragma unroll
        for (int b = 0; b < 2; ++b)
#pragma unroll
            for (int m = 0; m < 4; ++m)
#pragma unroll
                for (int n = 0; n < 2; ++n) acc[a][b][m][n] = (f32x4){0.f, 0.f, 0.f, 0.f};
    bf16x8 At[4][2], B0[2][2], B1[2][2];
    const char* cA = (const char*)g.A + (size_t)cur.pm * tstep; const char* cB = (const char*)g.Bt + (size_t)cur.pn * tstep;
    PG8_STAGE(PG8_SB(0, 0), cB, voffB); PG8_STAGE(PG8_SB(0, 1), cB + hstep, voffB); PG8_STAGE(PG8_SA(0, 0), cA, voffA); PG8_STAGE(PG8_SA(0, 1), cA + hstep, voffA);
    if (wr == 1) PG8_BAR;
    PG8_WAIT_V(2); PG8_BAR;
    PG8_STAGE(PG8_SB(1, 0), cB + kstep, voffB); PG8_STAGE(PG8_SA(1, 0), cA + kstep, voffA); PG8_STAGE(PG8_SB(1, 1), cB + hstep + kstep, voffB);
    PG8_WAIT_V(6); PG8_BAR;
    for (;;) {
        const bool has_next = S.next(ui + 1, nxt);
        const char* nA = has_next ? (const char*)g.A + (size_t)nxt.pm * tstep : cA; const char* nB = has_next ? (const char*)g.Bt + (size_t)nxt.pn * tstep : cB;
        for (int t = 0; t < nt; t += 2) {
            const bool last = (t == nt - 2);
            const char* a1 = cA + (size_t)(t + 1) * kstep;
            const char* a2 = last ? nA : cA + (size_t)(t + 2) * kstep; const char* b2 = last ? nB : cB + (size_t)(t + 2) * kstep;
            const char* a3 = a2 + kstep; const char* b3 = b2 + kstep;
            PG8_LDB(B0, 0, 0); PG8_LDB(B1, 0, 1); PG8_SCHED; PG8_LDA(At, 0, 0); PG8_STAGE(PG8_SA(1, 1), a1 + hstep, voffA);
            PG8_WAIT_V(8); PG8_WAIT_L(0); PG8_BAR; PG8_MMA(0, 0, At, B0); PG8_MMA(0, 1, At, B1); PG8_BAR; PG8_SCHED;
            PG8_LDA(At, 0, 1); PG8_STAGE(PG8_SB(0, 0), b2, voffB); PG8_STAGE(PG8_SB(0, 1), b2 + hstep, voffB); PG8_STAGE(PG8_SA(0, 0), a2, voffA);
            PG8_WAIT_V(8); PG8_WAIT_L(0); PG8_BAR; PG8_MMA(1, 0, At, B0); PG8_MMA(1, 1, At, B1); PG8_BAR; PG8_SCHED;
            PG8_LDB(B0, 1, 0); PG8_LDB(B1, 1, 1); PG8_SCHED; PG8_LDA(At, 1, 0); PG8_STAGE(PG8_SA(0, 1), a2 + hstep, voffA);
            PG8_WAIT_V(8); PG8_WAIT_L(0); PG8_BAR; PG8_MMA(0, 0, At, B0); PG8_MMA(0, 1, At, B1); PG8_BAR; PG8_SCHED;
            PG8_LDA(At, 1, 1); PG8_STAGE(PG8_SB(1, 0), b3, voffB); PG8_STAGE(PG8_SB(1, 1), b3 + hstep, voffB); PG8_STAGE(PG8_SA(1, 0), a3, voffA);
            PG8_WAIT_V(8); PG8_WAIT_L(0); PG8_BAR; PG8_MMA(1, 0, At, B0); PG8_MMA(1, 1, At, B1); PG8_BAR; PG8_SCHED;
        }
        if (wr == 0) PG8_BAR;
        E(acc, cur, wr, wc, fr, fq);
        if (!has_next) break;
#pragma unroll
        for (int a = 0; a < 2; ++a)
#pragma unroll
            for (int b = 0; b < 2; ++b)
#pragma unroll
                for (int m = 0; m < 4; ++m)
#pragma unroll
                    for (int n = 0; n < 2; ++n) acc[a][b][m][n] = (f32x4){0.f, 0.f, 0.f, 0.f};
        cur = nxt; cA = nA; cB = nB; ++ui;
        if (wr == 1) PG8_BAR;
    }
    PG8_WAIT_V(0);
    PG8_BAR;
#undef PG8_SA
#undef PG8_SB
#undef PG8_STAGE
#undef PG8_LDA
#undef PG8_LDB
#undef PG8_MMA
#undef PG8_WAIT_V
#undef PG8_WAIT_L
#undef PG8_BAR
#undef PG8_SCHED
}
}

#define SBAR() __builtin_amdgcn_sched_barrier(0)
__device__ __forceinline__ int crow(int r, int hi) { return (r & 3) + 8 * (r >> 2) + 4 * hi; }
constexpr float ATT_THR = 8.f;
template <int DQK> struct AttC { static constexpr float SCALE = (DQK == 64) ? 0.125f : 0.10206207261596575f; static constexpr float C = SCALE * 1.4426950408889634f; };
template <int DQK>
__device__ __forceinline__ void partialSM(f32x16& p0, f32x16& p1, float& m_reg, float& mn, float& alpha) {
    constexpr float C = AttC<DQK>::C, SC = AttC<DQK>::SCALE;
    float pmax = p0[0];
#pragma unroll
    for (int r = 1; r < 16; ++r) pmax = fmaxf(pmax, p0[r]);
#pragma unroll
    for (int r = 0; r < 16; ++r) pmax = fmaxf(pmax, p1[r]);
    { auto rr = __builtin_amdgcn_permlane32_swap(__float_as_uint(pmax), __float_as_uint(pmax), false, false);
      pmax = fmaxf(__uint_as_float(rr[0]), __uint_as_float(rr[1])); }
    if (__builtin_expect(__all(pmax - m_reg <= ATT_THR / SC), 1)) { mn = m_reg; alpha = 1.f; }
    else { mn = fmaxf(m_reg, pmax); alpha = __builtin_amdgcn_exp2f((m_reg - mn) * C); m_reg = mn; }
    const float mnC = -mn * C;
#pragma unroll
    for (int r = 0; r < 16; ++r) p0[r] = fmaf(p0[r], C, mnC);
#pragma unroll
    for (int r = 0; r < 16; ++r) p1[r] = fmaf(p1[r], C, mnC);
#pragma unroll
    for (int r = 0; r < 16; ++r) p0[r] = __builtin_amdgcn_exp2f(p0[r]);
}
__device__ __forceinline__ void finishSM(f32x16& p0, f32x16& p1, float alpha, float& l_reg, bf16x8& pa0, bf16x8& pa1, bf16x8& pa2, bf16x8& pa3) {
#pragma unroll
    for (int r = 0; r < 16; ++r) p1[r] = __builtin_amdgcn_exp2f(p1[r]);
    float ps = 0;
#pragma unroll
    for (int r = 0; r < 16; ++r) ps += p0[r];
#pragma unroll
    for (int r = 0; r < 16; ++r) ps += p1[r];
    { auto rr = __builtin_amdgcn_permlane32_swap(__float_as_uint(ps), __float_as_uint(ps), false, false);
      ps = __uint_as_float(rr[0]) + __uint_as_float(rr[1]); }
    l_reg = l_reg * alpha + ps;
#define PK4(P, BASE, OUT) do { unsigned a0 = cvtpk(P[BASE + 0], P[BASE + 1]), a1 = cvtpk(P[BASE + 2], P[BASE + 3]);   \
    unsigned b0 = cvtpk(P[BASE + 4], P[BASE + 5]), b1 = cvtpk(P[BASE + 6], P[BASE + 7]);                              \
    auto r0 = __builtin_amdgcn_permlane32_swap(a0, b0, false, false); auto r1 = __builtin_amdgcn_permlane32_swap(a1, b1, false, false); \
    u32x4 w = {r0[0], r1[0], r0[1], r1[1]}; OUT = __builtin_bit_cast(bf16x8, w); } while (0)
    PK4(p0, 0, pa0); PK4(p0, 8, pa1); PK4(p1, 0, pa2); PK4(p1, 8, pa3);
#undef PK4
}
template <int DQK>
__device__ __forceinline__ void qkt(f32x16& p0, f32x16& p1, const char* Ks, const bf16x8* qr, int r32, int hi) {
    constexpr int KROW = 2 * DQK + 16;
    p0 = f32x16{}; p1 = f32x16{};
#pragma unroll
    for (int d0 = 0; d0 < DQK / 16; ++d0) { const int cb = (d0 * 16 + hi * 8) * 2;
        const bf16x8 b0 = *reinterpret_cast<const bf16x8*>(Ks + r32 * KROW + cb);
        const bf16x8 b1 = *reinterpret_cast<const bf16x8*>(Ks + (32 + r32) * KROW + cb);
        p0 = __builtin_amdgcn_mfma_f32_32x32x16_bf16(b0, qr[d0], p0, 0, 0, 0);
        p1 = __builtin_amdgcn_mfma_f32_32x32x16_bf16(b1, qr[d0], p1, 0, 0, 0); }
}
template <int DV> __device__ __forceinline__ int v_st(int k, int c) { const int kk = (k & ~0xC) | ((k & 4) << 1) | ((k & 8) >> 1); return ((kk >> 3) * (DV / 32) + (c >> 5)) * 512 + ((kk & 7) * 32 + (c & 31)) * 2; }
__device__ __forceinline__ int v_rd_base(int lane) { return ((lane & 3) << 3) | (((lane >> 2) & 3) << 6) | (((lane >> 4) & 1) << 5) | (((lane >> 5) & 1) << 8); }
template <int OFF> __device__ __forceinline__ s16x4 tr_read(int vb) {
    s16x4 r; asm volatile("ds_read_b64_tr_b16 %0, %1 offset:%2" : "=&v"(r) : "v"(vb), "i"(OFF) : "memory"); return r;
}
template <int DV, int D0> __device__ __forceinline__ void pv_one(f32x16& od, int vb, bf16x8 pa0, bf16x8 pa1, bf16x8 pa2, bf16x8 pa3) {
    constexpr int KS = 2 * (DV / 32) * 512, HF = (DV / 32) * 512, B0 = D0 * 512;
    const s16x4 l0 = tr_read<B0>(vb), h0 = tr_read<B0 + HF>(vb), l1 = tr_read<B0 + KS>(vb), h1 = tr_read<B0 + KS + HF>(vb);
    const s16x4 l2 = tr_read<B0 + 2 * KS>(vb), h2 = tr_read<B0 + 2 * KS + HF>(vb), l3 = tr_read<B0 + 3 * KS>(vb), h3 = tr_read<B0 + 3 * KS + HF>(vb);
    asm volatile("s_waitcnt lgkmcnt(0)" ::: "memory"); SBAR();
#define PK(L, H) (bf16x8){L[0], L[1], L[2], L[3], H[0], H[1], H[2], H[3]}
    od = __builtin_amdgcn_mfma_f32_32x32x16_bf16(pa0, PK(l0, h0), od, 0, 0, 0);
    od = __builtin_amdgcn_mfma_f32_32x32x16_bf16(pa1, PK(l1, h1), od, 0, 0, 0);
    od = __builtin_amdgcn_mfma_f32_32x32x16_bf16(pa2, PK(l2, h2), od, 0, 0, 0);
    od = __builtin_amdgcn_mfma_f32_32x32x16_bf16(pa3, PK(l3, h3), od, 0, 0, 0);
#undef PK
}
template <int DV> __device__ __forceinline__ void pv_all(f32x16* o, int vb, bf16x8 pa0, bf16x8 pa1, bf16x8 pa2, bf16x8 pa3) {
    pv_one<DV, 0>(o[0], vb, pa0, pa1, pa2, pa3); pv_one<DV, 1>(o[1], vb, pa0, pa1, pa2, pa3);
    if constexpr (DV == 128) { pv_one<DV, 2>(o[2], vb, pa0, pa1, pa2, pa3); pv_one<DV, 3>(o[3], vb, pa0, pa1, pa2, pa3); }
}
template <int DQK, int DV>
__device__ __forceinline__ void attn_pass(const bf16_t* __restrict__ Qb, int ldq, const bf16_t* __restrict__ Kh, int ldk, const bf16_t* __restrict__ Vh, int ldv, int seq, char* lds, f32x16* o) {
    constexpr int KROW = 2 * DQK + 16, SHM_K = 64 * KROW, SHM_V = 64 * DV * 2, KCH = DQK / 8, VCH = DV / 8, KP = 64 * KCH, VP = 64 * VCH, KN = (KP + 511) / 512, VN = (VP + 511) / 512, ND = DV / 32;
    const int tid = threadIdx.x, wid = tid >> 6, lane = tid & 63, r32 = lane & 31, hi = lane >> 5;
    char* V_lds = lds; char* K_lds = lds + 2 * SHM_V;
    float* wsf = (float*)(lds + 2 * SHM_V + 2 * SHM_K) + wid * 64; float* li_l = wsf; float* al_l = wsf + 32;
    float m_reg = -1e30f, l_reg = 0; bf16x8 qr[DQK / 16];
#pragma unroll
    for (int d = 0; d < ND; ++d) o[d] = f32x16{};
    const bf16_t* Qw = Qb + (size_t)(wid * 32 + r32) * ldq + hi * 8;
#pragma unroll
    for (int d0 = 0; d0 < DQK / 16; ++d0) qr[d0] = *reinterpret_cast<const bf16x8*>(Qw + d0 * 16);
    unsigned koff[KN], voff[VN]; int kdst[KN], vdst[VN]; bool kval[KN], vval[VN];
#pragma unroll
    for (int i = 0; i < KN; ++i) { const int p = tid + 512 * i, row = p / KCH, ch = p % KCH; kval[i] = p < KP; koff[i] = (unsigned)(row * ldk + ch * 8) * 2u; kdst[i] = row * KROW + ch * 16; }
#pragma unroll
    for (int i = 0; i < VN; ++i) { const int p = tid + 512 * i, row = p / VCH, ch = p % VCH; vval[i] = p < VP; voff[i] = (unsigned)(row * ldv + ch * 8) * 2u; vdst[i] = v_st<DV>(row, ch * 8); }
    const int vb0 = (int)(uintptr_t)V_lds + v_rd_base(lane);
    bf16x8 sk[2][KN], sv[2][VN];
#define KOK(q_) (512 * (q_) + 511 < KP || kval[q_])
#define VOK(q_) (512 * (q_) + 511 < VP || vval[q_])
#define SLOAD(i, k0) do { const char* vb_ = (const char*)Vh + (size_t)(k0) * ldv * 2; const char* kb_ = (const char*)Kh + (size_t)(k0) * ldk * 2; \
    _Pragma("unroll") for (int q_ = 0; q_ < VN; ++q_) if (VOK(q_)) sv[i][q_] = *reinterpret_cast<const bf16x8*>(vb_ + voff[q_]); \
    _Pragma("unroll") for (int q_ = 0; q_ < KN; ++q_) if (KOK(q_)) sk[i][q_] = *reinterpret_cast<const bf16x8*>(kb_ + koff[q_]); } while (0)
#define SWRITE(b, i) do { _Pragma("unroll") for (int q_ = 0; q_ < VN; ++q_) if (VOK(q_)) *(bf16x8*)(V_lds + (b) * SHM_V + vdst[q_]) = sv[i][q_]; \
    _Pragma("unroll") for (int q_ = 0; q_ < KN; ++q_) if (KOK(q_)) *(bf16x8*)(K_lds + (b) * SHM_K + kdst[q_]) = sk[i][q_]; } while (0)
#define RESC(a) do { if (__any((a) < 1.f)) { if (hi == 0) al_l[r32] = (a); asm volatile("s_waitcnt lgkmcnt(0)" ::: "memory"); \
    _Pragma("unroll") for (int d = 0; d < ND; ++d) _Pragma("unroll") for (int r = 0; r < 16; ++r) o[d][r] *= al_l[crow(r, hi)]; } } while (0)
    f32x16 pA0, pA1, pB0, pB1; float mnA, mnB, alA, alB; bf16x8 pa0, pa1, pa2, pa3; const int NT = seq / 64;
    SLOAD(0, 0); SWRITE(0, 0); __syncthreads();
    qkt<DQK>(pA0, pA1, K_lds, qr, r32, hi); partialSM<DQK>(pA0, pA1, m_reg, mnA, alA);
    SLOAD(1, 64); if (2 < NT) SLOAD(0, 128);
    SWRITE(1, 1); __syncthreads();
    for (int j = 1; j + 1 < NT; j += 2) {
        SBAR(); qkt<DQK>(pB0, pB1, K_lds + SHM_K, qr, r32, hi);
        finishSM(pA0, pA1, alA, l_reg, pa0, pa1, pa2, pa3); SBAR();
        SLOAD(1, (j + 2) * 64); SBAR();
        pv_all<DV>(o, vb0, pa0, pa1, pa2, pa3); partialSM<DQK>(pB0, pB1, m_reg, mnB, alB);
        __syncthreads(); SWRITE(0, 0);
        RESC(alB); __syncthreads();
        SBAR(); qkt<DQK>(pA0, pA1, K_lds, qr, r32, hi);
        finishSM(pB0, pB1, alB, l_reg, pa0, pa1, pa2, pa3); SBAR();
        if (j + 3 < NT) SLOAD(0, (j + 3) * 64); SBAR();
        pv_all<DV>(o, vb0 + SHM_V, pa0, pa1, pa2, pa3); partialSM<DQK>(pA0, pA1, m_reg, mnA, alA);
        __syncthreads(); SWRITE(1, 1);
        RESC(alA); __syncthreads();
    }
    SBAR(); qkt<DQK>(pB0, pB1, K_lds + SHM_K, qr, r32, hi);
    finishSM(pA0, pA1, alA, l_reg, pa0, pa1, pa2, pa3); SBAR();
    pv_all<DV>(o, vb0, pa0, pa1, pa2, pa3); partialSM<DQK>(pB0, pB1, m_reg, mnB, alB);
    __syncthreads(); RESC(alB);
    finishSM(pB0, pB1, alB, l_reg, pa0, pa1, pa2, pa3); SBAR();
    pv_all<DV>(o, vb0 + SHM_V, pa0, pa1, pa2, pa3);
    if (hi == 0) li_l[r32] = l_reg; asm volatile("s_waitcnt lgkmcnt(0)" ::: "memory");
#pragma unroll
    for (int r = 0; r < 16; ++r) { const float rl = __builtin_amdgcn_rcpf(li_l[crow(r, hi)]);
#pragma unroll
        for (int d = 0; d < ND; ++d) o[d][r] *= rl; }
    __syncthreads();
#undef SLOAD
#undef SWRITE
#undef RESC
#undef KOK
#undef VOK
}

constexpr int OT_STRIDE = 132;
template <int ND> __device__ __forceinline__ void o_to_lds(const f32x16* o, LAS float* T, int r32, int hi) {
#pragma unroll
    for (int d = 0; d < ND; ++d)
#pragma unroll
        for (int r = 0; r < 16; ++r) T[crow(r, hi) * OT_STRIDE + d * 32 + r32] = o[d][r];
    asm volatile("s_waitcnt lgkmcnt(0)" ::: "memory");
}
__device__ __forceinline__ void attn_phase(const Params& P, const Frame& F) {
    const bf16_t* QA = (const bf16_t*)(P.ws + WS_QA); const bf16_t* KA = (const bf16_t*)(P.ws + WS_KA); const bf16_t* VA = (const bf16_t*)(P.ws + WS_VA);
    const bf16_t* QB = (const bf16_t*)(P.ws + WS_QB); const bf16_t* KB = (const bf16_t*)(P.ws + WS_KB); const bf16_t* VB = (const bf16_t*)(P.ws + WS_VB);
    bf16_t* CAT = (bf16_t*)(P.ws + WS_CAT);
    float* SCR = (float*)(P.ws + WS_SCR) + ((size_t)F.bid * NWAVES + F.wave) * 4096;
    const float lam = *(const float*)(P.ws + WS_LAM);
    const int vcu = (F.G % 8 == 0) ? (F.bid % 8) * (F.G / 8) + F.bid / 8 : F.bid;
    const int r32 = F.lane & 31, hi = F.lane >> 5, erow = F.lane >> 1, ehalf = F.lane & 1;
    char* lds = (char*)F.lds;
    LAS float* T = (LAS float*)(F.lds + F.wave * (32 * OT_STRIDE * 4));
    int u = vcu;
    for (; u < 512; u += F.G) {
        {
            const int b = u >> 5, h = (u >> 3) & 3, qb = u & 7;
            const size_t krow0 = (size_t)b * TPB, qrow0 = krow0 + CTXL + qb * 256;
            { f32x16 o[4];
              attn_pass<64, 128>(QA + qrow0 * 512 + h * 128, 512, KA + krow0 * 512 + h * 128, 512, VA + krow0 * 512 + h * 128, 512, TPB, lds, o);
              o_to_lds<4>(o, T, r32, hi); }
#pragma unroll 4
            for (int q = 0; q < 16; ++q) *(f32x4*)(SCR + erow * 128 + ehalf * 64 + 4 * q) = *(const LAS f32x4*)(T + erow * OT_STRIDE + ehalf * 64 + 4 * q);
            __syncthreads();
            { f32x16 o[4];
              attn_pass<64, 128>(QA + qrow0 * 512 + h * 128 + 64, 512, KA + krow0 * 512 + h * 128 + 64, 512, VA + krow0 * 512 + h * 128, 512, TPB, lds, o);
              o_to_lds<4>(o, T, r32, hi); }
            float ss = 0.f;
#pragma unroll 4
            for (int q = 0; q < 16; ++q) { LAS f32x4* tp = (LAS f32x4*)(T + erow * OT_STRIDE + ehalf * 64 + 4 * q);
                const f32x4 cv = *(const f32x4*)(SCR + erow * 128 + ehalf * 64 + 4 * q) - *tp * lam; *tp = cv;
                ss += (cv[0] * cv[0] + cv[1] * cv[1]) + (cv[2] * cv[2] + cv[3] * cv[3]); }
            ss += __shfl_xor(ss, 1);
            const float rstd = rsqrtf(ss * (1.f / 128.f) + EPS) * 0.8f;
            asm volatile("s_waitcnt lgkmcnt(0)" ::: "memory");
            bf16_t* dst = CAT + ((size_t)b * SEQ + qb * 256 + F.wave * 32 + erow) * DM + h * 128 + ehalf * 64;
#pragma unroll 2
            for (int q = 0; q < 8; ++q) { const LAS f32x4* tp = (const LAS f32x4*)(T + erow * OT_STRIDE + ehalf * 64 + 8 * q);
                const f32x4 g0 = *(const f32x4*)(P.diff_subln + ehalf * 64 + 8 * q), g1 = *(const f32x4*)(P.diff_subln + ehalf * 64 + 8 * q + 4);
                *(u32x4*)(dst + 8 * q) = pack8(tp[0] * g0 * rstd, tp[1] * g1 * rstd); }
            __syncthreads();
        }
    }
    for (; u < 1536; u += F.G) {
        {
            const int v = u - 512, b = v >> 6, h = (v >> 3) & 7, qb = v & 7;
            const size_t krow0 = (size_t)b * TPB, qrow0 = krow0 + CTXL + qb * 256;
            { f32x16 o[2];
              attn_pass<96, 64>(QB + qrow0 * 768 + h * 96, 768, KB + krow0 * 768 + h * 96, 768, VB + krow0 * 512 + h * 64, 512, TPB, lds, o);
              o_to_lds<2>(o, T, r32, hi); }
            bf16_t* dst = CAT + ((size_t)b * SEQ + qb * 256 + F.wave * 32 + erow) * DM + 512 + h * 64 + ehalf * 32;
#pragma unroll
            for (int q = 0; q < 4; ++q) { const LAS f32x4* tp = (const LAS f32x4*)(T + erow * OT_STRIDE + ehalf * 32 + 8 * q); *(u32x4*)(dst + 8 * q) = pack8(tp[0], tp[1]); }
            __syncthreads();
        }
    }
}

__device__ __forceinline__ void p8_phase(const Params& P, const Frame& F) {
    float chk = 1.f;
#if MK_CHECK
    { const unsigned* BAD = (const unsigned*)(P.ws + WS_LAM) + 16; chk = 1.f + 0.1f * (float)((BAD[0] ? 1 : 0) + (BAD[1] ? 2 : 0)); }
#endif
    for (int r = F.gwi; r < MLAT; r += F.ngw) {
        float* row = P.out + (size_t)r * DM; f32x4 v[4]; float s = 0.f;
#pragma unroll
        for (int j = 0; j < 4; ++j) { v[j] = *(const f32x4*)(row + 4 * F.lane + 256 * j); s += (v[j].x * v[j].x + v[j].y * v[j].y) + (v[j].z * v[j].z + v[j].w * v[j].w); }
        const float rstd = rsqrtf(wave_sum(s) * (1.f / DM) + EPS);
#pragma unroll
        for (int j = 0; j < 4; ++j) { const f32x4 g = *(const f32x4*)(P.final_norm + 4 * F.lane + 256 * j); const f32x4 ov = v[j] * (rstd * chk) * g; if (!F.dry) *(f32x4*)(row + 4 * F.lane + 256 * j) = ov; else asm volatile("" :: "v"(ov)); }
    }
}


#define XB_TMO      128
#define XB_XCNT(j)  (256  + 64 * (j))
#define XB_XSUB(j)  (1280 + 64 * (j))
#define XB_XGEN(j)  (2304 + 64 * (j))
#define XB_TOP      3328
#define XB_TOPGEN   3392
#define XCD_BAR_WORDS 3456
#define XB_SPIN_CAP (1u << 20)
__device__ __forceinline__ unsigned xb_ld(unsigned* p)              { return __hip_atomic_load(p, __ATOMIC_RELAXED, __HIP_MEMORY_SCOPE_AGENT); }
__device__ __forceinline__ unsigned xb_add(unsigned* p, unsigned v) { return __hip_atomic_fetch_add(p, v, __ATOMIC_RELAXED, __HIP_MEMORY_SCOPE_AGENT); }
__device__ __forceinline__ unsigned xb_xcc_id() { return (unsigned)__builtin_amdgcn_s_getreg((3 << 11) | 20) & 0xFu; }
#define XB_SPIN(cond, bar) do { unsigned _sp = 0; while (cond) { __builtin_amdgcn_s_sleep(1); \
    if ((++_sp & 255u) == 0u) { if (xb_ld(&(bar)[XB_TMO])) break; if (_sp > XB_SPIN_CAP) { atomicAdd(&(bar)[XB_TMO], 1u); break; } } } } while (0)
struct XcdBarrier { unsigned* bar; unsigned x; volatile LAS unsigned* st; };
__device__ __forceinline__ XcdBarrier xcd_barrier_post(unsigned* bar, volatile LAS unsigned* st) {
    XcdBarrier b; b.bar = bar; b.x = xb_xcc_id(); b.st = st;
    if (threadIdx.x == 0) (void)xb_add(&bar[XB_XCNT(b.x)], 1u);
    return b;
}
__device__ __forceinline__ void xcd_barrier_complete(unsigned* bar, unsigned x, unsigned& nloc, unsigned& nx) {
    const unsigned G = gridDim.x * gridDim.y * gridDim.z;
    unsigned sum, cnt, mine, sp = 0u;
    for (;;) {
        sum = 0u; cnt = 0u; mine = 0u;
#pragma unroll
        for (unsigned j = 0; j < 16; ++j) { const unsigned c = xb_ld(&bar[XB_XCNT(j)]); sum += c; cnt += (c > 0u) ? 1u : 0u; mine = (j == x) ? c : mine; }
        if (sum == G) break;
        __builtin_amdgcn_s_sleep(1);
        if ((++sp & 255u) == 0u) { if (xb_ld(&bar[XB_TMO])) break; if (sp > XB_SPIN_CAP) { atomicAdd(&bar[XB_TMO], 1u); break; } }
    }
    nloc = mine > 0u ? mine : 1u; nx = cnt > 0u ? cnt : 1u;
}
__device__ __forceinline__ void xcd_barrier(const XcdBarrier& b) {
    asm volatile("s_waitcnt vmcnt(0)" ::: "memory");
    __syncthreads();
    if (threadIdx.x == 0) {
        unsigned* bar = b.bar;
        __builtin_amdgcn_s_waitcnt(0);
        unsigned nloc = b.st[0], nx = b.st[1];
        if (nloc == 0u) { xcd_barrier_complete(bar, b.x, nloc, nx); b.st[0] = nloc; b.st[1] = nx; }
        const unsigned old = xb_add(&bar[XB_XSUB(b.x)], 1u);
        const unsigned gen = old / nloc;
        if (old + 1u == (gen + 1u) * nloc) {
            __builtin_amdgcn_fence(__ATOMIC_RELEASE, "agent");
            asm volatile("s_waitcnt vmcnt(0)" ::: "memory");
            const unsigned og = xb_add(&bar[XB_TOP], 1u);
            const unsigned tg = og / nx;
            if (og + 1u == (tg + 1u) * nx) xb_add(&bar[XB_TOPGEN], 1u);
            else XB_SPIN(xb_ld(&bar[XB_TOPGEN]) == tg, bar);
            __builtin_amdgcn_fence(__ATOMIC_ACQUIRE, "agent");
            xb_add(&bar[XB_XGEN(b.x)], 1u);
            asm volatile("s_waitcnt vmcnt(0)" ::: "memory");
        } else {
            XB_SPIN(xb_ld(&bar[XB_XGEN(b.x)]) == gen, bar);
            __builtin_amdgcn_fence(__ATOMIC_ACQUIRE, "agent");
            asm volatile("s_waitcnt vmcnt(0)" ::: "memory");
        }
    }
    __syncthreads();
}

#ifndef MK_FUSED
#define MK_FUSED 1
#endif
#ifndef MK_REP_MASK
#define MK_REP_MASK 0
#endif
#ifndef MK_CHECK
#define MK_CHECK 0
#endif
#ifndef MK_P3_SIMPLE
#define MK_P3_SIMPLE 0
#endif
#ifndef MK_SYNC
#define MK_SYNC 1
#endif
constexpr int LDS_BYTES = 147456;
constexpr int NPHASE = 9;
__global__ void __launch_bounds__(NTHREADS, 2) mk_kernel(Params P, int lo, int hi, int dry) {
    extern __shared__ __attribute__((aligned(16))) unsigned char lds_raw[];
    Frame F; F.tid = threadIdx.x; F.lane = F.tid & 63; F.wave = __builtin_amdgcn_readfirstlane(F.tid >> 6); F.G = gridDim.x; F.bid = blockIdx.x;
    F.gwi = F.wave * F.G + F.bid; F.ngw = F.G * NWAVES; F.lds = (LAS unsigned char*)lds_raw; F.dry = (MK_REP_MASK != 0) && (dry != 0);
#if MK_SYNC == 0
    cg::grid_group grid = cg::this_grid();
#define GRID_BAR() grid.sync()
#else
    volatile LAS unsigned* MISC = (volatile LAS unsigned*)(F.lds + LDS_BYTES - 256);
    if (F.tid < 64) MISC[F.tid] = 0u;
    __syncthreads();
    XcdBarrier xbar; xbar.bar = (unsigned*)(P.ws + WS_BAR); xbar.x = 0; xbar.st = nullptr;
    if (hi - lo > 1) xbar = xcd_barrier_post((unsigned*)(P.ws + WS_BAR), MISC);
#define GRID_BAR() xcd_barrier(xbar)
#endif
#define IN(k) (lo <= (k) && (k) < hi)
#define SEAM(k) do { if (IN(k) && IN((k) + 1)) GRID_BAR(); } while (0)
#define RUN(k, ...) do { if (IN(k)) { __VA_ARGS__ } } while (0)
    RUN(0, p0_phase(P, F););
    SEAM(0);
    RUN(1, p1_phase(P, F););
    SEAM(1);
    RUN(2, {
        TileOrder S; S.init(MROWS / 256, NIN / 256, F.G, F.bid);
        EpiQKV E{(bf16_t*)(P.ws + WS_QA), (bf16_t*)(P.ws + WS_KA), (bf16_t*)(P.ws + WS_VA), (bf16_t*)(P.ws + WS_CQ), (bf16_t*)(P.ws + WS_CKV), (bf16_t*)(P.ws + WS_KB),
                 (float*)(P.ws + WS_SSQQ), (float*)(P.ws + WS_SSQKV), rope_tab(P), F.dry};
        pg8::gemm_phase(F.lds, pg8::Gemm{(const bf16_t*)(P.ws + WS_H), (const bf16_t*)(P.ws + WS_WIN), 1024}, S, E);
    });
    SEAM(2);
    RUN(3, {
#if MK_P3_SIMPLE
        { TileOrder S; S.init(MLAT / 256, 3, F.G, F.bid, true); EpiQup E{(bf16_t*)(P.ws + WS_QB), (const float*)(P.ws + WS_SSQQ), rope_tab(P)};
          Unit u; for (int i = 0; S.next(i, u); ++i) gemm_unit_simple(F, (const bf16_t*)(P.ws + WS_CQ), (const bf16_t*)(P.ws + WS_WQUP), 256, u, E); }
        { TileOrder S; S.init(MROWS / 256, 4, F.G, F.bid); EpiKVup E{(bf16_t*)(P.ws + WS_KB), (bf16_t*)(P.ws + WS_VB), (const float*)(P.ws + WS_SSQKV)};
          Unit u; for (int i = 0; S.next(i, u); ++i) gemm_unit_simple(F, (const bf16_t*)(P.ws + WS_CKV), (const bf16_t*)(P.ws + WS_WKVUP), 128, u, E); }
#else
        { TileOrder S; S.init(MLAT / 256, 3, F.G, F.bid, true); EpiQup E{(bf16_t*)(P.ws + WS_QB), (const float*)(P.ws + WS_SSQQ), rope_tab(P)};
          int kq = 256; asm volatile("" : "+s"(kq)); pg8::gemm_phase(F.lds, pg8::Gemm{(const bf16_t*)(P.ws + WS_CQ), (const bf16_t*)(P.ws + WS_WQUP), kq}, S, E); }
        { TileOrder S; S.init(MROWS / 256, 4, F.G, F.bid); EpiKVup E{(bf16_t*)(P.ws + WS_KB), (bf16_t*)(P.ws + WS_VB), (const float*)(P.ws + WS_SSQKV)};
          int kk = 128; asm volatile("" : "+s"(kk)); pg8::gemm_phase(F.lds, pg8::Gemm{(const bf16_t*)(P.ws + WS_CKV), (const bf16_t*)(P.ws + WS_WKVUP), kk}, S, E); }
#endif
#if MK_CHECK == 3
        GRID_BAR();
        { TileOrder S; S.init(MLAT / 256, 3, F.G, F.bid, true); EpiQup E{(bf16_t*)(P.ws + WS_A2), (const float*)(P.ws + WS_SSQQ), rope_tab(P)};
          Unit u; for (int i = 0; S.next(i, u); ++i) gemm_unit_simple(F, (const bf16_t*)(P.ws + WS_CQ), (const bf16_t*)(P.ws + WS_WQUP), 256, u, E); }
        { TileOrder S; S.init(MROWS / 256, 4, F.G, F.bid); EpiKVup E{(bf16_t*)(P.ws + WS_CAT), (bf16_t*)(P.ws + WS_SCR), (const float*)(P.ws + WS_SSQKV)};
          Unit u; for (int i = 0; S.next(i, u); ++i) if (u.pn < 2) gemm_unit_simple(F, (const bf16_t*)(P.ws + WS_CKV), (const bf16_t*)(P.ws + WS_WKVUP), 128, u, E); }
        GRID_BAR();
        { unsigned* BAD = (unsigned*)(P.ws + WS_LAM) + 16; const bf16_t* q0 = (const bf16_t*)(P.ws + WS_QB); const bf16_t* q1 = (const bf16_t*)(P.ws + WS_A2);
          const bf16_t* k0 = (const bf16_t*)(P.ws + WS_KB); const bf16_t* k1 = (const bf16_t*)(P.ws + WS_CAT); unsigned badq = 0, badk = 0;
          for (size_t i = (size_t)F.bid * NTHREADS + F.tid; i < (size_t)MROWS * 768; i += (size_t)F.G * NTHREADS) {
              const int row = (int)(i / 768), col = (int)(i % 768); const bool latrow = (row % TPB) >= CTXL;
              const float a = __uint_as_float((unsigned)q0[i] << 16), b = __uint_as_float((unsigned)q1[i] << 16);
              if (latrow && !(fabsf(a - b) <= 1e-3f + 1e-2f * fabsf(b))) ++badq;
              const float c = __uint_as_float((unsigned)k0[i] << 16), d = __uint_as_float((unsigned)k1[i] << 16);
              if ((col % 96) < 64 && !(fabsf(c - d) <= 1e-3f + 1e-2f * fabsf(d))) ++badk; }
          if (badq) atomicAdd(BAD, 1u); if (badk) atomicAdd(BAD + 1, 1u); }
#endif
    });
    SEAM(3);
    RUN(4, attn_phase(P, F););
    SEAM(4);
    RUN(5, {
        TileOrder S; S.init(MLAT / 256, 4, F.G, F.bid); EpiOut E{P.x, P.out, (bf16_t*)(P.ws + WS_A2), (const float*)(P.ws + WS_MOD), (float*)(P.ws + WS_SSQ2), F.dry};
        pg8::gemm_phase(F.lds, pg8::Gemm{(const bf16_t*)(P.ws + WS_CAT), (const bf16_t*)(P.ws + WS_WOUT), 1024}, S, E);
    });
    SEAM(5);
    RUN(6, {
        TileOrder S; S.init(MLAT / 256, 22, F.G, F.bid); EpiFfnIn E{(bf16_t*)(P.ws + WS_G), (const float*)(P.ws + WS_SSQ2), (const float*)(P.ws + WS_BIASF)};
        pg8::gemm_phase(F.lds, pg8::Gemm{(const bf16_t*)(P.ws + WS_A2), (const bf16_t*)(P.ws + WS_WFFI), 1024}, S, E);
    });
    SEAM(6);
    RUN(7, {
        TileOrder S; S.init(MLAT / 256, 4, F.G, F.bid); EpiFfnOut E{P.out, (const float*)(P.ws + WS_MOD), F.dry};
        pg8::gemm_phase(F.lds, pg8::Gemm{(const bf16_t*)(P.ws + WS_G), (const bf16_t*)(P.ws + WS_WFFO), FFH}, S, E);
    });
    SEAM(7);
    RUN(8, p8_phase(P, F););
#undef RUN
#undef IN
#undef SEAM
#undef GRID_BAR
}

extern "C" void kernel_launch(void* const* d_in, const int* in_sizes, int n_in, void* d_out, int out_size, void* d_ws, size_t ws_size, hipStream_t stream) {
    static int grid = 0;
    if (grid == 0) {
        if (n_in != 17 || in_sizes[0] != MLAT * DM || out_size != MLAT * DM || ws_size < WS_END) {
            fprintf(stderr, "kernel_launch: unexpected shapes: n_in %d in0 %d out %d ws %zu (need %zu)\n", n_in, n_in > 0 ? in_sizes[0] : -1, out_size, ws_size, (size_t)WS_END); grid = -1; return; }
        if (hipFuncSetAttribute((const void*)mk_kernel, hipFuncAttributeMaxDynamicSharedMemorySize, LDS_BYTES) != hipSuccess) { fprintf(stderr, "kernel_launch: hipFuncSetAttribute failed\n"); grid = -1; return; }
        int dev = 0, cus = 0, per_cu = 0;
        (void)hipGetDevice(&dev); (void)hipDeviceGetAttribute(&cus, hipDeviceAttributeMultiprocessorCount, dev);
        if (hipOccupancyMaxActiveBlocksPerMultiprocessor(&per_cu, (const void*)mk_kernel, NTHREADS, LDS_BYTES) != hipSuccess || per_cu < 1) { fprintf(stderr, "kernel_launch: occupancy query says %d blocks/CU\n", per_cu); per_cu = 1; }
        (void)hipGetLastError();
        grid = cus;
        if (grid <= 0) grid = 256;
    }
    if (grid < 0) return;
    (void)hipMemsetAsync(d_ws, 0, CTL_BYTES, stream);
    Params p{};
    p.x = (const float*)d_in[0]; p.c = (const float*)d_in[1]; p.ctx = (const float*)d_in[2]; p.c_ctx = (const float*)d_in[3]; p.w_ada = (const float*)d_in[4]; p.b_ada = (const float*)d_in[5];
    p.w_in = (const float*)d_in[6]; p.q_a_norm = (const float*)d_in[7]; p.kv_a_norm = (const float*)d_in[8]; p.w_q_up = (const float*)d_in[9]; p.w_kv_up = (const float*)d_in[10];
    p.diff_lambda = (const float*)d_in[11]; p.diff_subln = (const float*)d_in[12]; p.w_out = (const float*)d_in[13]; p.w_ffn_in = (const float*)d_in[14]; p.w_ffn_out = (const float*)d_in[15];
    p.final_norm = (const float*)d_in[16]; p.out = (float*)d_out; p.ws = (unsigned char*)d_ws;
#if MK_FUSED
#if MK_SYNC == 0
    int lo = 0, hi = NPHASE, dry = 0; void* args[] = {&p, &lo, &hi, &dry};
    hipError_t e = hipLaunchCooperativeKernel((const void*)mk_kernel, dim3(grid), dim3(NTHREADS), args, LDS_BYTES, stream);
    if (e != hipSuccess) fprintf(stderr, "kernel_launch: cooperative launch failed: %s (grid %d)\n", hipGetErrorString(e), grid);
#else
    hipLaunchKernelGGL(mk_kernel, dim3(grid), dim3(NTHREADS), LDS_BYTES, stream, p, 0, NPHASE, 0);
    for (int k = 0; k < NPHASE; ++k) if ((MK_REP_MASK >> k) & 1) hipLaunchKernelGGL(mk_kernel, dim3(grid), dim3(NTHREADS), LDS_BYTES, stream, p, k, k + 1, 1);
    { const hipError_t le = hipPeekAtLastError(); if (le != hipSuccess) fprintf(stderr, "kernel_launch: launch failed: %s\n", hipGetErrorName(le)); }
#endif
#else
    for (int ph = 0; ph < NPHASE; ++ph) {
        hipLaunchKernelGGL(mk_kernel, dim3(grid), dim3(NTHREADS), LDS_BYTES, stream, p, ph, ph + 1, 0);
        const hipError_t le = hipPeekAtLastError();
        if (le != hipSuccess) { fprintf(stderr, "kernel_launch: launch %d failed: %s\n", ph, hipGetErrorName(le)); break; }
    }
#endif
}
```

```cpp
#include <hip/hip_runtime.h>
#include <hip/hip_cooperative_groups.h>
#include <cstdint>
#include <cstdio>
namespace cg = cooperative_groups;

#define LAS __attribute__((address_space(3)))
typedef unsigned short bf16_t;
typedef short bf16x8 __attribute__((ext_vector_type(8)));
typedef short s16x4 __attribute__((ext_vector_type(4)));
typedef float f32x2 __attribute__((ext_vector_type(2)));
typedef float f32x4 __attribute__((ext_vector_type(4)));
typedef float f32x16 __attribute__((ext_vector_type(16)));
typedef unsigned u32x2 __attribute__((ext_vector_type(2)));
typedef unsigned u32x4 __attribute__((ext_vector_type(4)));
typedef __bf16 bf16x2_t __attribute__((ext_vector_type(2)));

constexpr int DM = 1024, NB = 16, SEQ = 2048, CTXL = 256, TPB = SEQ + CTXL;
constexpr int MROWS = NB * TPB, MLAT = NB * SEQ;
constexpr int FFH = 2816, NIN = 2048, NADA = 6 * DM;
constexpr float EPS = 1e-6f;
constexpr int NWAVES = 8, NTHREADS = 512;

constexpr size_t KiB = 1024, MiB = 1024 * 1024;
constexpr size_t WS_MOD = 0, WS_BIASF = 512 * KiB, WS_SSQQ = 1024 * KiB, WS_SSQKV = 1184 * KiB, WS_SSQ2 = 1344 * KiB, WS_LAM = 1536 * KiB, WS_BAR = 1792 * KiB;
constexpr size_t CTL_BYTES = 2 * MiB;
constexpr size_t WS_TAB = 2 * MiB;
constexpr size_t WS_WIN = 3 * MiB, WS_WQUP = 7 * MiB, WS_WKVUP = 7 * MiB + 512 * KiB, WS_WOUT = 8 * MiB, WS_WFFI = 10 * MiB, WS_WFFO = 21 * MiB;
constexpr size_t WS_A2 = 27 * MiB, WS_CAT = 91 * MiB;
constexpr size_t WS_H = 155 * MiB, WS_QB = 155 * MiB, WS_QA = 227 * MiB, WS_KA = 263 * MiB, WS_VA = 299 * MiB, WS_CQ = 335 * MiB, WS_CKV = 353 * MiB;
constexpr size_t WS_KB = 362 * MiB, WS_VB = 416 * MiB, WS_SCR = 452 * MiB, WS_G = 155 * MiB, WS_END = 484 * MiB;
static_assert(WS_G + (size_t)MLAT * FFH * 2 <= WS_CQ, "G overlay");
static_assert(WS_WFFO + (size_t)DM * FFH * 2 <= WS_A2, "wffo");

struct Params {
    const float *x, *c, *ctx, *c_ctx, *w_ada, *b_ada, *w_in, *q_a_norm, *kv_a_norm, *w_q_up, *w_kv_up, *diff_lambda, *diff_subln, *w_out, *w_ffn_in, *w_ffn_out, *final_norm;
    float* out; unsigned char* ws;
};

__device__ __forceinline__ unsigned cvtpk(float lo, float hi) { f32x2 v = {lo, hi}; bf16x2_t b = __builtin_convertvector(v, bf16x2_t); return __builtin_bit_cast(unsigned, b); }
__device__ __forceinline__ float wave_sum(float v) {
#pragma unroll
    for (int o = 1; o < 64; o <<= 1) v += __shfl_xor(v, o);
    return v;
}
__device__ __forceinline__ float silu_f(float v) { return v / (1.f + __expf(-v)); }
__device__ __forceinline__ u32x4 pack8(f32x4 a, f32x4 b) { u32x4 w; w.x = cvtpk(a[0], a[1]); w.y = cvtpk(a[2], a[3]); w.z = cvtpk(b[0], b[1]); w.w = cvtpk(b[2], b[3]); return w; }
__device__ __forceinline__ int ropeA_L(int q) { return 4 * ((q >> 3) & 3) + (q & 3) + 16 * ((q >> 2) & 1); }
__device__ __forceinline__ int ropeB_L(int q) { const int a = q >> 3, n = (q >> 2) & 1, j = q & 3; return (a >> 1) * 16 + (a & 1) * 4 + j + 8 * n; }

struct Frame { int tid, lane, wave, G, bid, gwi, ngw; bool dry; LAS unsigned char* lds; };

__device__ __forceinline__ void p0_ada_task(const Params& P, float* MOD, int t, int lane, bool dry) {
    const int cgp = t % 24, kc = t / 24, k0 = kc * 32, n = cgp * 256 + lane * 4, k = k0 + (lane & 31);
    float sv[17];
#pragma unroll
    for (int b = 0; b < 16; ++b) sv[b] = silu_f(P.c[b * DM + k]);
    sv[16] = silu_f(P.c_ctx[k]);
    f32x4 acc[17];
    const f32x4 binit = (kc == 0) ? *(const f32x4*)(P.b_ada + n) : (f32x4){0.f, 0.f, 0.f, 0.f};
#pragma unroll
    for (int b = 0; b < 17; ++b) acc[b] = binit;
#pragma unroll 2
    for (int kk = 0; kk < 32; ++kk) {
        const f32x4 w = *(const f32x4*)(P.w_ada + (size_t)(k0 + kk) * NADA + n);
#pragma unroll
        for (int b = 0; b < 17; ++b) { const float s = __shfl(sv[b], kk); acc[b] += w * s; }
    }
#pragma unroll
    for (int b = 0; b < 17; ++b)
#pragma unroll
        for (int j = 0; j < 4; ++j) { if (!dry) atomicAdd(&MOD[b * NADA + n + j], acc[b][j]); else asm volatile("" :: "v"(acc[b][j])); }
}
__device__ __forceinline__ int src_col(int mat, int p) {
    switch (mat) {
    case 0: if (p < 1024) return (p & ~31) + ropeA_L(p & 31); if (p < 1920) return p; if (p < 1952) return 1920 + ropeB_L(p - 1920); return -1;
    case 1: if (p < 512) return (p >> 6) * 96 + (p & 63); { const int q = p - 512; return (q >> 5) * 96 + 64 + ropeB_L(q & 31); }
    case 2: if (p < 512) return (p >> 6) * 128 + (p & 63); { const int q = p - 512; return (q >> 6) * 128 + 64 + (q & 63); }
    case 4: { const int t = p >> 8, q = p & 255; return q < 128 ? 128 * t + q : FFH + 128 * t + (q - 128); }
    default: return p;
    }
}
__device__ __forceinline__ void p0_transpose_item(const float* W, int K, int N, const float* gain, bf16_t* WT, int mat, int npb, LAS float* scr, int item, int lane) {
    const int kb = item / npb, pb = item % npb, k0 = 64 * kb, p0 = 32 * pb;
    const int sc = src_col(mat, p0 + (lane & 31));
#pragma unroll 8
    for (int i = 0; i < 32; ++i) { const int kk = 2 * i + (lane >> 5);
        float v = 0.f; if (sc >= 0) { v = W[(size_t)(k0 + kk) * N + sc]; if (gain) v *= gain[k0 + kk]; }
        scr[kk * 33 + (lane & 31)] = v; }
    asm volatile("s_waitcnt lgkmcnt(0)" ::: "memory");
    const int c = lane & 7;
#pragma unroll
    for (int j = 0; j < 4; ++j) { const int n = (lane >> 3) + 8 * j; const LAS float* s = scr + (8 * c) * 33 + n;
        u32x4 o; o.x = cvtpk(s[0 * 33], s[1 * 33]); o.y = cvtpk(s[2 * 33], s[3 * 33]); o.z = cvtpk(s[4 * 33], s[5 * 33]); o.w = cvtpk(s[6 * 33], s[7 * 33]);
        *(u32x4*)(WT + (size_t)(p0 + n) * K + k0 + 8 * c) = o; }
    asm volatile("s_waitcnt lgkmcnt(0)" ::: "memory");
}
__device__ __forceinline__ void sincos_d(double a, float& s, float& c) {
    const double k = __builtin_rint(a * 0.15915494309189535);
    double r = __builtin_fma(-k, 6.283185307179586, a); r = __builtin_fma(-k, 2.4492935982947064e-16, r);
    const double r2 = r * r; double ts = r, tc = 1.0, ss = r, cc = 1.0;
    for (int n = 0; n < 14; ++n) { tc = -tc * r2 / (double)((2 * n + 1) * (2 * n + 2)); cc += tc; ts = -ts * r2 / (double)((2 * n + 2) * (2 * n + 3)); ss += ts; }
    s = (float)ss; c = (float)cc;
}
__device__ __forceinline__ void p0_phase(const Params& P, const Frame& F) {
    float* MOD = (float*)(P.ws + WS_MOD);
    LAS float* scr = (LAS float*)(F.lds + F.wave * 8448);
    constexpr int NADA_T = 24 * 32;
    constexpr int I0 = 16 * 64, I1 = 4 * 24, I2 = 2 * 32, I3 = 16 * 32, I4 = 16 * 176, I5 = 44 * 32;
    constexpr int NT = NADA_T + I0 + I1 + I2 + I3 + I4 + I5;
    for (int t = F.gwi; t < NT; t += F.ngw) {
        int r = t;
        if (r < NADA_T) { p0_ada_task(P, MOD, r, F.lane, F.dry); continue; } r -= NADA_T;
        if (r < I0) { p0_transpose_item(P.w_in, 1024, 1952, nullptr, (bf16_t*)(P.ws + WS_WIN), 0, 64, scr, r, F.lane); continue; } r -= I0;
        if (r < I1) { p0_transpose_item(P.w_q_up, 256, 768, P.q_a_norm, (bf16_t*)(P.ws + WS_WQUP), 1, 24, scr, r, F.lane); continue; } r -= I1;
        if (r < I2) { p0_transpose_item(P.w_kv_up, 128, 1024, P.kv_a_norm, (bf16_t*)(P.ws + WS_WKVUP), 2, 32, scr, r, F.lane); continue; } r -= I2;
        if (r < I3) { p0_transpose_item(P.w_out, 1024, 1024, nullptr, (bf16_t*)(P.ws + WS_WOUT), 3, 32, scr, r, F.lane); continue; } r -= I3;
        if (r < I4) { p0_transpose_item(P.w_ffn_in, 1024, 2 * FFH, nullptr, (bf16_t*)(P.ws + WS_WFFI), 4, 176, scr, r, F.lane); continue; } r -= I4;
        p0_transpose_item(P.w_ffn_out, FFH, 1024, nullptr, (bf16_t*)(P.ws + WS_WFFO), 5, 32, scr, r, F.lane);
    }
    if (F.bid == F.G - 1) {
        float* TAB = (float*)(P.ws + WS_TAB);
        for (int i = F.tid; i < 1536; i += NTHREADS) {
            float s, c;
            if (i < 1024) { const int pos = i >> 4, f = i & 15; double inv = 1.0; for (int q = 0; q < f; ++q) inv *= 0.5623413251903491; sincos_d((double)pos * inv, s, c); TAB[i] = c; TAB[1024 + i] = s; }
            else { const int e = i - 1024, pos = e >> 3, f = e & 7; double inv = 1.0; for (int q = 0; q < f; ++q) inv *= 0.31622776601683794; sincos_d((double)pos * inv, s, c); TAB[2048 + e] = c; TAB[2560 + e] = s; }
        }
        if (F.wave == 0) {
            const float* lp = P.diff_lambda; const float a = wave_sum(lp[F.lane] * lp[64 + F.lane]), b = wave_sum(lp[128 + F.lane] * lp[192 + F.lane]);
            if (F.lane == 0) *(float*)(P.ws + WS_LAM) = __expf(a) - __expf(b) + 0.2f;
        }
    }
}

__device__ __forceinline__ void p1_row_load(const Params& P, int r, int lane, f32x4 (&v)[4], const float*& mp) {
    const int b = r / TPB, t = r - b * TPB;
    const float* src = (t < CTXL) ? P.ctx + ((size_t)b * CTXL + t) * DM : P.x + ((size_t)b * SEQ + (t - CTXL)) * DM;
    mp = (const float*)(P.ws + WS_MOD) + (size_t)((t < CTXL) ? 16 : b) * NADA;
#pragma unroll
    for (int j = 0; j < 4; ++j) v[j] = *(const f32x4*)(src + 4 * lane + 256 * j);
}
__device__ __forceinline__ void p1_row_finish(bf16_t* H, int r, int lane, const f32x4 (&v)[4], const float* mp) {
    float s = 0.f;
#pragma unroll
    for (int j = 0; j < 4; ++j) s += (v[j].x * v[j].x + v[j].y * v[j].y) + (v[j].z * v[j].z + v[j].w * v[j].w);
    const float rstd = rsqrtf(wave_sum(s) * (1.f / DM) + EPS);
#pragma unroll
    for (int j = 0; j < 4; ++j) { const int col = 4 * lane + 256 * j; const f32x4 sh = *(const f32x4*)(mp + col), sc = *(const f32x4*)(mp + DM + col);
        const f32x4 h = v[j] * rstd * (sc + 1.f) + sh; u32x2 w; w.x = cvtpk(h[0], h[1]); w.y = cvtpk(h[2], h[3]);
        *(u32x2*)(H + (size_t)r * DM + col) = w; }
}
__device__ __forceinline__ void p1_phase(const Params& P, const Frame& F) {
    bf16_t* H = (bf16_t*)(P.ws + WS_H);
    for (int r = F.gwi; r < MROWS; r += 3 * F.ngw) {
        f32x4 va[4], vb[4], vc[4]; const float *ma, *mb, *mc; const int r1 = r + F.ngw, r2 = r + 2 * F.ngw;
        p1_row_load(P, r, F.lane, va, ma);
        if (r1 < MROWS) p1_row_load(P, r1, F.lane, vb, mb);
        if (r2 < MROWS) p1_row_load(P, r2, F.lane, vc, mc);
        p1_row_finish(H, r, F.lane, va, ma);
        if (r1 < MROWS) p1_row_finish(H, r1, F.lane, vb, mb);
        if (r2 < MROWS) p1_row_finish(H, r2, F.lane, vc, mc);
    }
}
__device__ __forceinline__ void biasf_task(const Params& P, const Frame& F) {
    if (F.gwi < 22 * 16) {
        const float* MOD = (const float*)(P.ws + WS_MOD);
        float* BIASF = (float*)(P.ws + WS_BIASF);
        const int cgp = F.gwi % 22, kc = F.gwi / 22, k0 = kc * 64, n = cgp * 256 + F.lane * 4;
        float sv[16];
#pragma unroll
        for (int b = 0; b < 16; ++b) sv[b] = MOD[(size_t)b * NADA + 3 * DM + k0 + F.lane];
        f32x4 acc[16];
#pragma unroll
        for (int b = 0; b < 16; ++b) acc[b] = (f32x4){0.f, 0.f, 0.f, 0.f};
#pragma unroll 1
        for (int k1 = 0; k1 < 64; k1 += 8) {
            f32x4 w[8];
#pragma unroll
            for (int kk = 0; kk < 8; ++kk) w[kk] = *(const f32x4*)(P.w_ffn_in + (size_t)(k0 + k1 + kk) * (2 * FFH) + n);
#pragma unroll
            for (int kk = 0; kk < 8; ++kk)
#pragma unroll
                for (int b = 0; b < 16; ++b) { const float s = __shfl(sv[b], k1 + kk); acc[b] += w[kk] * s; }
        }
#pragma unroll
        for (int b = 0; b < 16; ++b)
#pragma unroll
            for (int j = 0; j < 4; ++j) { if (!F.dry) atomicAdd(&BIASF[b * (2 * FFH) + n + j], acc[b][j]); else asm volatile("" :: "v"(acc[b][j])); }
    }
}

struct Unit { int pm, pn; };
__device__ __forceinline__ int perm32(int rho) { const int n = rho >> 4, i = rho & 15; return 8 * (i >> 2) + 4 * n + (i & 3); }
struct TileOrder {
    int nM, nN, nwg, G, c; bool skipctx;
    __device__ __forceinline__ void init(int nM_, int nN_, int G_, int c_, bool skip_ = false) { nM = nM_; nN = nN_; nwg = nM * nN; G = G_; c = c_; skipctx = skip_; }
    __device__ __forceinline__ bool next(int i, Unit& u) const {
        const long L = (long)i * G + c; if (L >= nwg) return false;
        int wgid = (int)L; { const int q = nwg / 8, r = nwg % 8, xcd = wgid % 8, off = wgid / 8; wgid = (xcd < r ? xcd * (q + 1) : r * (q + 1) + (xcd - r) * q) + off; }
        const int nig = 8 * nN, gid = wgid / nig, fm = gid * 8, gsz = (nM - fm) < 8 ? (nM - fm) : 8;
        u.pm = fm + ((wgid % nig) % gsz); u.pn = (wgid % nig) / gsz; if (skipctx) u.pm += (u.pm >> 3) + 1; return true;
    }
};
typedef f32x4 Acc[2][2][4][2];
constexpr int SG_STRIDE = 144;
template <class Epi>
__device__ __forceinline__ void gemm_unit_simple(const Frame& F, const bf16_t* A, const bf16_t* Bt, int K, const Unit u, const Epi& E) {
    const int wr = F.wave >> 2, wc = F.wave & 3, fr = F.lane & 15, fq = F.lane >> 4;
    LAS unsigned char* As = F.lds; LAS unsigned char* Bs = F.lds + 256 * SG_STRIDE;
    Acc acc;
#pragma unroll
    for (int a = 0; a < 2; ++a)
#pragma unroll
        for (int b = 0; b < 2; ++b)
#pragma unroll
            for (int m = 0; m < 4; ++m)
#pragma unroll
                for (int n = 0; n < 2; ++n) acc[a][b][m][n] = (f32x4){0.f, 0.f, 0.f, 0.f};
    const bf16_t* Ag = A + (size_t)u.pm * 256 * K; const bf16_t* Bg = Bt + (size_t)u.pn * 256 * K;
#pragma unroll 1
    for (int kt = 0; kt < K; kt += 64) {
        __syncthreads();
#pragma unroll
        for (int i = 0; i < 4; ++i) { const int p = F.tid + 512 * i, row = p >> 3, ch = p & 7;
            const u32x4 va = *(const u32x4*)(Ag + (size_t)row * K + kt + ch * 8), vb = *(const u32x4*)(Bg + (size_t)row * K + kt + ch * 8);
            *(LAS u32x4*)(As + row * SG_STRIDE + ch * 16) = va; *(LAS u32x4*)(Bs + row * SG_STRIDE + ch * 16) = vb; if (i & 1) asm volatile("" ::: "memory"); }
        __syncthreads();
#pragma unroll
        for (int k2 = 0; k2 < 2; ++k2) {
#pragma unroll
            for (int ai = 0; ai < 2; ++ai) {
                bf16x8 At[4];
#pragma unroll
                for (int m = 0; m < 4; ++m) At[m] = *(const LAS bf16x8*)(As + (128 * ai + 64 * wr + 16 * m + fr) * SG_STRIDE + (32 * k2 + 8 * fq) * 2);
#pragma unroll
                for (int bj = 0; bj < 2; ++bj) {
                    bf16x8 Bf[2];
#pragma unroll
                    for (int n = 0; n < 2; ++n) Bf[n] = *(const LAS bf16x8*)(Bs + (128 * bj + 32 * wc + perm32(16 * n + fr)) * SG_STRIDE + (32 * k2 + 8 * fq) * 2);
#pragma unroll
                    for (int m = 0; m < 4; ++m)
#pragma unroll
                        for (int n = 0; n < 2; ++n) acc[ai][bj][m][n] = __builtin_amdgcn_mfma_f32_16x16x32_bf16(Bf[n], At[m], acc[ai][bj][m][n], 0, 0, 0);
                }
            }
        }
    }
    E(acc, u, wr, wc, fr, fq);
}

struct RopeTab { const float *Ac, *As, *Bc, *Bs; };
__device__ __forceinline__ RopeTab rope_tab(const Params& P) { const float* T = (const float*)(P.ws + WS_TAB); return RopeTab{T, T + 1024, T + 2048, T + 2560}; }
__device__ __forceinline__ void rope_pair(f32x4& v0, f32x4& v1, const f32x4 cs, const f32x4 sn) { const f32x4 a = v0 * cs - v1 * sn, b = v1 * cs + v0 * sn; v0 = a; v1 = b; }

struct EpiQKV {
    bf16_t *QA, *KA, *VA, *CQ, *CKV, *KB; float *SSQQ, *SSQKV; RopeTab T; bool dry;
    __device__ __forceinline__ void operator()(const Acc& acc, const Unit& u, int wr, int wc, int fr, int fq) const {
        const int jb = u.pm % 9; const bool lat = jb != 0; const int pn = u.pn;
        if (!lat && (pn < 2 || pn == 6)) return;
#pragma unroll
        for (int ai = 0; ai < 2; ++ai) {
            const int prow = (jb - 1) * 4 + 2 * ai + wr;
#pragma unroll
            for (int m = 0; m < 4; ++m) {
                const int pcol = 16 * m + fr; const size_t grow = (size_t)u.pm * 256 + 128 * ai + 64 * wr + 16 * m + fr;
                if (pn < 4) {
                    bf16_t* dst = (pn < 2 ? QA : KA) + grow * 512 + (pn & 1) * 256 + 32 * wc + 8 * fq;
                    const int pos = (wc & 1) ? pcol : prow;
                    f32x4 cs = {1.f, 1.f, 1.f, 1.f}, sn = {0.f, 0.f, 0.f, 0.f};
                    if (lat) { cs = *(const f32x4*)(T.Ac + pos * 16 + 4 * fq); sn = *(const f32x4*)(T.As + pos * 16 + 4 * fq); }
#pragma unroll
                    for (int bj = 0; bj < 2; ++bj) { f32x4 v0 = acc[ai][bj][m][0], v1 = acc[ai][bj][m][1]; rope_pair(v0, v1, cs, sn); *(u32x4*)(dst + 128 * bj) = pack8(v0, v1); }
                } else if (pn < 6) {
#pragma unroll
                    for (int bj = 0; bj < 2; ++bj) *(u32x4*)(VA + grow * 512 + (pn - 4) * 256 + 128 * bj + 32 * wc + 8 * fq) = pack8(acc[ai][bj][m][0], acc[ai][bj][m][1]);
                } else if (pn == 6) {
                    float s = 0.f;
#pragma unroll
                    for (int bj = 0; bj < 2; ++bj) { const f32x4 v0 = acc[ai][bj][m][0], v1 = acc[ai][bj][m][1];
                        s += (v0[0] * v0[0] + v0[1] * v0[1]) + (v0[2] * v0[2] + v0[3] * v0[3]) + (v1[0] * v1[0] + v1[1] * v1[1]) + (v1[2] * v1[2] + v1[3] * v1[3]);
                        *(u32x4*)(CQ + grow * 256 + 128 * bj + 32 * wc + 8 * fq) = pack8(v0, v1); }
                    s += __shfl_xor(s, 16); s += __shfl_xor(s, 32);
                    if (fq == 0 && !dry) atomicAdd(SSQQ + grow, s);
                } else {
                    { const f32x4 v0 = acc[ai][0][m][0], v1 = acc[ai][0][m][1];
                      float s = (v0[0] * v0[0] + v0[1] * v0[1]) + (v0[2] * v0[2] + v0[3] * v0[3]) + (v1[0] * v1[0] + v1[1] * v1[1]) + (v1[2] * v1[2] + v1[3] * v1[3]);
                      *(u32x4*)(CKV + grow * 128 + 32 * wc + 8 * fq) = pack8(v0, v1);
                      s += __shfl_xor(s, 16); s += __shfl_xor(s, 32);
                      if (fq == 0 && !dry) atomicAdd(SSQKV + grow, s); }
                    if (wc == 0) {
                        f32x4 v0 = acc[ai][1][m][0], v1 = acc[ai][1][m][1];
                        if (lat) { const int pos = (fq < 2) ? prow : pcol; const f32x4 cs = *(const f32x4*)(T.Bc + pos * 8 + 4 * (fq & 1)), sn = *(const f32x4*)(T.Bs + pos * 8 + 4 * (fq & 1)); rope_pair(v0, v1, cs, sn); }
                        const u32x4 w = pack8(v0, v1);
#pragma unroll
                        for (int h = 0; h < 8; ++h) *(u32x4*)(KB + grow * 768 + h * 96 + 64 + 8 * fq) = w;
                    }
                }
            }
        }
    }
};
struct EpiQup {
    bf16_t* QB; const float* SSQQ; RopeTab T;
    __device__ __forceinline__ void operator()(const Acc& acc, const Unit& u, int wr, int wc, int fr, int fq) const {
        const int jb = u.pm % 9, pn = u.pn;
#pragma unroll
        for (int ai = 0; ai < 2; ++ai) {
            const int prow = (jb - 1) * 4 + 2 * ai + wr;
#pragma unroll
            for (int m = 0; m < 4; ++m) {
                const int pcol = 16 * m + fr; const size_t grow = (size_t)u.pm * 256 + 128 * ai + 64 * wr + 16 * m + fr;
                const float rstd = rsqrtf(SSQQ[grow] * (1.f / 256.f) + EPS);
#pragma unroll
                for (int bj = 0; bj < 2; ++bj) {
                    f32x4 v0 = acc[ai][bj][m][0] * rstd, v1 = acc[ai][bj][m][1] * rstd;
                    if (pn < 2) { const int c = pn * 256 + 128 * bj + 32 * wc + 8 * fq; *(u32x4*)(QB + grow * 768 + (c >> 6) * 96 + (c & 63)) = pack8(v0, v1); }
                    else { const int h = 4 * bj + wc, pos = (fq < 2) ? prow : pcol;
                        const f32x4 cs = *(const f32x4*)(T.Bc + pos * 8 + 4 * (fq & 1)), sn = *(const f32x4*)(T.Bs + pos * 8 + 4 * (fq & 1)); rope_pair(v0, v1, cs, sn);
                        *(u32x4*)(QB + grow * 768 + h * 96 + 64 + 8 * fq) = pack8(v0, v1); }
                }
                asm volatile("" ::: "memory");
            }
        }
    }
};
struct EpiKVup {
    bf16_t *KB, *VB; const float* SSQKV;
    __device__ __forceinline__ void operator()(const Acc& acc, const Unit& u, int wr, int wc, int fr, int fq) const {
        const int pn = u.pn;
#pragma unroll
        for (int ai = 0; ai < 2; ++ai)
#pragma unroll
            for (int m = 0; m < 4; ++m) {
                const size_t grow = (size_t)u.pm * 256 + 128 * ai + 64 * wr + 16 * m + fr;
                const float rstd = rsqrtf(SSQKV[grow] * (1.f / 128.f) + EPS);
#pragma unroll
                for (int bj = 0; bj < 2; ++bj) {
                    const f32x4 v0 = acc[ai][bj][m][0] * rstd, v1 = acc[ai][bj][m][1] * rstd;
                    if (pn < 2) { const int c = pn * 256 + 128 * bj + 32 * wc + 8 * fq; *(u32x4*)(KB + grow * 768 + (c >> 6) * 96 + (c & 63)) = pack8(v0, v1); }
                    else *(u32x4*)(VB + grow * 512 + (pn - 2) * 256 + 128 * bj + 32 * wc + 8 * fq) = pack8(v0, v1);
                }
                asm volatile("" ::: "memory");
            }
    }
};
struct EpiOut {
    const float* x; float* out; bf16_t* A2; const float* MOD; float* SSQ2; bool dry;
    __device__ __forceinline__ void operator()(const Acc& acc, const Unit& u, int wr, int wc, int fr, int fq) const {
        const float* mp = MOD + (size_t)(u.pm >> 3) * NADA;
#pragma unroll
        for (int ai = 0; ai < 2; ++ai)
#pragma unroll
            for (int m = 0; m < 4; ++m) {
                const size_t row = (size_t)u.pm * 256 + 128 * ai + 64 * wr + 16 * m + fr; float s = 0.f;
#pragma unroll
                for (int bj = 0; bj < 2; ++bj) {
                    const int col = u.pn * 256 + 128 * bj + 32 * wc + 8 * fq; const size_t off = row * DM + col;
                    f32x4 nv[2];
#pragma unroll
                    for (int n = 0; n < 2; ++n) { const f32x4 ga = *(const f32x4*)(mp + 2 * DM + col + 4 * n), xv = *(const f32x4*)(x + off + 4 * n);
                        nv[n] = xv + ga * acc[ai][bj][m][n]; if (!dry) *(f32x4*)(out + off + 4 * n) = nv[n];
                        s += (nv[n][0] * nv[n][0] + nv[n][1] * nv[n][1]) + (nv[n][2] * nv[n][2] + nv[n][3] * nv[n][3]); }
                    const f32x4 s0 = *(const f32x4*)(mp + 4 * DM + col), s1 = *(const f32x4*)(mp + 4 * DM + col + 4);
                    { const u32x4 pk = pack8(nv[0] * (s0 + 1.f), nv[1] * (s1 + 1.f)); if (!dry) *(u32x4*)(A2 + off) = pk; else asm volatile("" :: "v"(pk)); }
                }
                s += __shfl_xor(s, 16); s += __shfl_xor(s, 32);
                if (fq == 0 && !dry) atomicAdd(SSQ2 + row, s);
            }
    }
};
struct EpiFfnIn {
    bf16_t* G; const float* SSQ2; const float* BIASF;
    __device__ __forceinline__ void operator()(const Acc& acc, const Unit& u, int wr, int wc, int fr, int fq) const {
        const float* bp = BIASF + (size_t)(u.pm >> 3) * (2 * FFH); const int hc = u.pn * 128 + 32 * wc + 8 * fq;
        f32x4 bg[2], bu[2];
#pragma unroll
        for (int n = 0; n < 2; ++n) { bg[n] = *(const f32x4*)(bp + hc + 4 * n); bu[n] = *(const f32x4*)(bp + FFH + hc + 4 * n); }
#pragma unroll
        for (int ai = 0; ai < 2; ++ai)
#pragma unroll
            for (int m = 0; m < 4; ++m) {
                const size_t row = (size_t)u.pm * 256 + 128 * ai + 64 * wr + 16 * m + fr;
                const float rstd = rsqrtf(SSQ2[row] * (1.f / DM) + EPS);
                f32x4 o[2];
#pragma unroll
                for (int n = 0; n < 2; ++n) { const f32x4 g = acc[ai][0][m][n] * rstd + bg[n], up = acc[ai][1][m][n] * rstd + bu[n];
#pragma unroll
                    for (int j = 0; j < 4; ++j) o[n][j] = silu_f(g[j]) * up[j]; }
                *(u32x4*)(G + row * FFH + hc) = pack8(o[0], o[1]);
            }
    }
};
struct EpiFfnOut {
    float* out; const float* MOD; bool dry;
    __device__ __forceinline__ void operator()(const Acc& acc, const Unit& u, int wr, int wc, int fr, int fq) const {
        const float* mp = MOD + (size_t)(u.pm >> 3) * NADA + 5 * DM;
#pragma unroll
        for (int ai = 0; ai < 2; ++ai)
#pragma unroll
            for (int m = 0; m < 4; ++m) {
                const size_t row = (size_t)u.pm * 256 + 128 * ai + 64 * wr + 16 * m + fr;
#pragma unroll
                for (int bj = 0; bj < 2; ++bj)
#pragma unroll
                    for (int n = 0; n < 2; ++n) { const int col = u.pn * 256 + 128 * bj + 32 * wc + 8 * fq + 4 * n; const size_t off = row * DM + col;
                        const f32x4 gf = *(const f32x4*)(mp + col), nl = *(const f32x4*)(out + off); const f32x4 yv = nl + gf * acc[ai][bj][m][n]; if (!dry) *(f32x4*)(out + off) = yv; else asm volatile("" :: "v"(yv)); }
            }
    }
};


namespace pg8 {
constexpr int BK = 64, HALF = 128, HTB = HALF * BK * 2, STAGE_BYTES = 8 * HTB;
__device__ __forceinline__ int lds_byte(int r, int c) { const int st = (r >> 4) * 2 + (c >> 5), rr = r & 15, cc = c & 31, ob = rr * 64 + cc * 2; return st * 1024 + (ob ^ (((ob >> 9) & 1) << 5)); }
__device__ __forceinline__ void stage_rc(int b, int& R, int& C) { const int st = b / 1024, sb = b % 1024, swz = sb ^ (((sb >> 9) & 1) << 5); R = (st >> 1) * 16 + swz / 64; C = (st & 1) * 32 + (swz % 64) / 2; }
struct Gemm { const bf16_t* A; const bf16_t* Bt; int K; };
template <class Epi, class Sched>
__device__ __forceinline__ void gemm_phase(LAS unsigned char* lds, const Gemm g, const Sched& S, const Epi& E) {
    const int tid = threadIdx.x, wid = __builtin_amdgcn_readfirstlane(tid >> 6), lane = tid & 63, wr = wid >> 2, wc = wid & 3, fr = lane & 15, fq = lane >> 4;
    const int K = g.K, nt = K / BK;
    unsigned voffA[2], voffB[2];
#pragma unroll
    for (int i = 0; i < 2; ++i) { int R, C; stage_rc(tid * 16 + i * 8192, R, C); const int Rb = (R & ~31) + perm32(R & 31);
        voffA[i] = (unsigned)(R * K + C) * 2u; voffB[i] = (unsigned)(Rb * K + C) * 2u; }
    const size_t kstep = (size_t)(BK * 2);
    const size_t hstep = (size_t)HALF * K * 2;
    const size_t tstep = 2 * hstep;
    const unsigned ldsw = (unsigned)wid * 1024u;
    const int aoff = lds_byte(wr * 64 + fr, fq * 8), boff = lds_byte(wc * 32 + fr, fq * 8);
#define PG8_SA(b, h) (((b) * 2 + (h)) * HTB)
#define PG8_SB(b, h) ((4 + (b) * 2 + (h)) * HTB)
#define PG8_STAGE(bufoff, gbase, voff) do { _Pragma("unroll") for (int _i = 0; _i < 2; ++_i) \
        __builtin_amdgcn_global_load_lds((const unsigned*)((const char*)(gbase) + (voff)[_i]), (LAS unsigned*)(lds + (bufoff) + ldsw + _i * 8192), 16, 0, 0); } while (0)
#define PG8_LDA(dst, b, h) do { _Pragma("unroll") for (int m = 0; m < 4; ++m) _Pragma("unroll") for (int k = 0; k < 2; ++k) dst[m][k] = *(const LAS bf16x8*)(lds + PG8_SA(b, h) + aoff + m * 2048 + k * 1024); } while (0)
#define PG8_LDB(dst, b, h) do { _Pragma("unroll") for (int n = 0; n < 2; ++n) _Pragma("unroll") for (int k = 0; k < 2; ++k) dst[n][k] = *(const LAS bf16x8*)(lds + PG8_SB(b, h) + boff + n * 2048 + k * 1024); } while (0)
#define PG8_MMA(ai, bj, At, Bt) do { __builtin_amdgcn_s_setprio(1); _Pragma("unroll") for (int m = 0; m < 4; ++m) _Pragma("unroll") for (int n = 0; n < 2; ++n) _Pragma("unroll") for (int k = 0; k < 2; ++k) \
        acc[ai][bj][m][n] = __builtin_amdgcn_mfma_f32_16x16x32_bf16(Bt[n][k], At[m][k], acc[ai][bj][m][n], 0, 0, 0); __builtin_amdgcn_s_setprio(0); } while (0)
#define PG8_WAIT_V(n) asm volatile("s_waitcnt vmcnt(" #n ")" ::: "memory")
#define PG8_WAIT_L(n) asm volatile("s_waitcnt lgkmcnt(" #n ")" ::: "memory")
#define PG8_BAR __builtin_amdgcn_s_barrier()
#define PG8_SCHED __builtin_amdgcn_sched_barrier(0)
    Unit cur, nxt; int ui = 0;
    if (!S.next(0, cur)) return;
    f32x4 acc[2][2][4][2];
#pragma unroll
    for (int a = 0; a < 2; ++a)
#pragma unroll
        for (int b = 0; b < 2; ++b)
#pragma unroll
            for (int m = 0; m < 4; ++m)
#pragma unroll
                for (int n = 0; n < 2; ++n) acc[a][b][m][n] = (f32x4){0.f, 0.f, 0.f, 0.f};
    bf16x8 At[4][2], B0[2][2], B1[2][2];
    const char* cA = (const char*)g.A + (size_t)cur.pm * tstep; const char* cB = (const char*)g.Bt + (size_t)cur.pn * tstep;
    PG8_STAGE(PG8_SB(0, 0), cB, voffB); PG8_STAGE(PG8_SB(0, 1), cB + hstep, voffB); PG8_STAGE(PG8_SA(0, 0), cA, voffA); PG8_STAGE(PG8_SA(0, 1), cA + hstep, voffA);
    if (wr == 1) PG8_BAR;
    PG8_WAIT_V(2); PG8_BAR;
    PG8_STAGE(PG8_SB(1, 0), cB + kstep, voffB); PG8_STAGE(PG8_SA(1, 0), cA + kstep, voffA); PG8_STAGE(PG8_SB(1, 1), cB + hstep + kstep, voffB);
    PG8_WAIT_V(6); PG8_BAR;
    for (;;) {
        const bool has_next = S.next(ui + 1, nxt);
        const char* nA = has_next ? (const char*)g.A + (size_t)nxt.pm * tstep : cA; const char* nB = has_next ? (const char*)g.Bt + (size_t)nxt.pn * tstep : cB;
        for (int t = 0; t < nt; t += 2) {
            const bool last = (t == nt - 2);
            const char* a1 = cA + (size_t)(t + 1) * kstep;
            const char* a2 = last ? nA : cA + (size_t)(t + 2) * kstep; const char* b2 = last ? nB : cB + (size_t)(t + 2) * kstep;
            const char* a3 = a2 + kstep; const char* b3 = b2 + kstep;
            PG8_LDB(B0, 0, 0); PG8_LDB(B1, 0, 1); PG8_SCHED; PG8_LDA(At, 0, 0); PG8_STAGE(PG8_SA(1, 1), a1 + hstep, voffA);
            PG8_WAIT_V(8); PG8_WAIT_L(0); PG8_BAR; PG8_MMA(0, 0, At, B0); PG8_MMA(0, 1, At, B1); PG8_BAR; PG8_SCHED;
            PG8_LDA(At, 0, 1); PG8_STAGE(PG8_SB(0, 0), b2, voffB); PG8_STAGE(PG8_SB(0, 1), b2 + hstep, voffB); PG8_STAGE(PG8_SA(0, 0), a2, voffA);
            PG8_WAIT_V(8); PG8_WAIT_L(0); PG8_BAR; PG8_MMA(1, 0, At, B0); PG8_MMA(1, 1, At, B1); PG8_BAR; PG8_SCHED;
            PG8_LDB(B0, 1, 0); PG8_LDB(B1, 1, 1); PG8_SCHED; PG8_LDA(At, 1, 0); PG8_STAGE(PG8_SA(0, 1), a2 + hstep, voffA);
            PG8_WAIT_V(8); PG8_WAIT_L(0); PG8_BAR; PG8_MMA(0, 0, At, B0); PG8_MMA(0, 1, At, B1); PG8_BAR; PG8_SCHED;
            PG8_LDA(At, 1, 1); PG8_STAGE(PG8_SB(1, 0), b3, voffB); PG8_STAGE(PG8_SB(1, 1), b3 + hstep, voffB); PG8_STAGE(PG8_SA(1, 0), a3, voffA);
            PG8_WAIT_V(8); PG8_WAIT_L(0); PG8_BAR; PG8_MMA(1, 0, At, B0); PG8_MMA(1, 1, At, B1); PG8_BAR; PG8_SCHED;
        }
        if (wr == 0) PG8_BAR;
        E(acc, cur, wr, wc, fr, fq);
        if (!has_next) break;
#pragma unroll
        for (int a = 0; a < 2; ++a)
#pragma unroll
            for (int b = 0; b < 2; ++b)
#pragma unroll
                for (int m = 0; m < 4; ++m)
#pragma unroll
                    for (int n = 0; n < 2; ++n) acc[a][b][m][n] = (f32x4){0.f, 0.f, 0.f, 0.f};
        cur = nxt; cA = nA; cB = nB; ++ui;
        if (wr == 1) PG8_BAR;
    }
    PG8_WAIT_V(0);
    PG8_BAR;
#undef PG8_SA
#undef PG8_SB
#undef PG8_STAGE
#undef PG8_LDA
#undef PG8_LDB
#undef PG8_MMA
#undef PG8_WAIT_V
#undef PG8_WAIT_L
#undef PG8_BAR
#undef PG8_SCHED
}
}

#define SBAR() __builtin_amdgcn_sched_barrier(0)
__device__ __forceinline__ int crow(int r, int hi) { return (r & 3) + 8 * (r >> 2) + 4 * hi; }
constexpr float ATT_THR = 8.f;
template <int DQK> struct AttC { static constexpr float SCALE = (DQK == 64) ? 0.125f : 0.10206207261596575f; static constexpr float C = SCALE * 1.4426950408889634f; };
template <int DQK>
__device__ __forceinline__ void partialSM(f32x16& p0, f32x16& p1, float& m_reg, float& mn, float& alpha) {
    constexpr float C = AttC<DQK>::C, SC = AttC<DQK>::SCALE;
    float pmax = p0[0];
#pragma unroll
    for (int r = 1; r < 16; ++r) pmax = fmaxf(pmax, p0[r]);
#pragma unroll
    for (int r = 0; r < 16; ++r) pmax = fmaxf(pmax, p1[r]);
    { auto rr = __builtin_amdgcn_permlane32_swap(__float_as_uint(pmax), __float_as_uint(pmax), false, false);
      pmax = fmaxf(__uint_as_float(rr[0]), __uint_as_float(rr[1])); }
    if (__builtin_expect(__all(pmax - m_reg <= ATT_THR / SC), 1)) { mn = m_reg; alpha = 1.f; }
    else { mn = fmaxf(m_reg, pmax); alpha = __builtin_amdgcn_exp2f((m_reg - mn) * C); m_reg = mn; }
    const float mnC = -mn * C;
#pragma unroll
    for (int r = 0; r < 16; ++r) p0[r] = fmaf(p0[r], C, mnC);
#pragma unroll
    for (int r = 0; r < 16; ++r) p1[r] = fmaf(p1[r], C, mnC);
#pragma unroll
    for (int r = 0; r < 16; ++r) p0[r] = __builtin_amdgcn_exp2f(p0[r]);
}
__device__ __forceinline__ void finishSM(f32x16& p0, f32x16& p1, float alpha, float& l_reg, bf16x8& pa0, bf16x8& pa1, bf16x8& pa2, bf16x8& pa3) {
#pragma unroll
    for (int r = 0; r < 16; ++r) p1[r] = __builtin_amdgcn_exp2f(p1[r]);
    float ps = 0;
#pragma unroll
    for (int r = 0; r < 16; ++r) ps += p0[r];
#pragma unroll
    for (int r = 0; r < 16; ++r) ps += p1[r];
    { auto rr = __builtin_amdgcn_permlane32_swap(__float_as_uint(ps), __float_as_uint(ps), false, false);
      ps = __uint_as_float(rr[0]) + __uint_as_float(rr[1]); }
    l_reg = l_reg * alpha + ps;
#define PK4(P, BASE, OUT) do { unsigned a0 = cvtpk(P[BASE + 0], P[BASE + 1]), a1 = cvtpk(P[BASE + 2], P[BASE + 3]);   \
    unsigned b0 = cvtpk(P[BASE + 4], P[BASE + 5]), b1 = cvtpk(P[BASE + 6], P[BASE + 7]);                              \
    auto r0 = __builtin_amdgcn_permlane32_swap(a0, b0, false, false); auto r1 = __builtin_amdgcn_permlane32_swap(a1, b1, false, false); \
    u32x4 w = {r0[0], r1[0], r0[1], r1[1]}; OUT = __builtin_bit_cast(bf16x8, w); } while (0)
    PK4(p0, 0, pa0); PK4(p0, 8, pa1); PK4(p1, 0, pa2); PK4(p1, 8, pa3);
#undef PK4
}
template <int DQK>
__device__ __forceinline__ void qkt(f32x16& p0, f32x16& p1, const char* Ks, const bf16x8* qr, int r32, int hi) {
    constexpr int KROW = 2 * DQK + 16;
    p0 = f32x16{}; p1 = f32x16{};
#pragma unroll
    for (int d0 = 0; d0 < DQK / 16; ++d0) { const int cb = (d0 * 16 + hi * 8) * 2;
        const bf16x8 b0 = *reinterpret_cast<const bf16x8*>(Ks + r32 * KROW + cb);
        const bf16x8 b1 = *reinterpret_cast<const bf16x8*>(Ks + (32 + r32) * KROW + cb);
        p0 = __builtin_amdgcn_mfma_f32_32x32x16_bf16(b0, qr[d0], p0, 0, 0, 0);
        p1 = __builtin_amdgcn_mfma_f32_32x32x16_bf16(b1, qr[d0], p1, 0, 0, 0); }
}
template <int DV> __device__ __forceinline__ int v_st(int k, int c) { const int kk = (k & ~0xC) | ((k & 4) << 1) | ((k & 8) >> 1); return ((kk >> 3) * (DV / 32) + (c >> 5)) * 512 + ((kk & 7) * 32 + (c & 31)) * 2; }
__device__ __forceinline__ int v_rd_base(int lane) { return ((lane & 3) << 3) | (((lane >> 2) & 3) << 6) | (((lane >> 4) & 1) << 5) | (((lane >> 5) & 1) << 8); }
template <int OFF> __device__ __forceinline__ s16x4 tr_read(int vb) {
    s16x4 r; asm volatile("ds_read_b64_tr_b16 %0, %1 offset:%2" : "=&v"(r) : "v"(vb), "i"(OFF) : "memory"); return r;
}
template <int DV, int D0> __device__ __forceinline__ void pv_one(f32x16& od, int vb, bf16x8 pa0, bf16x8 pa1, bf16x8 pa2, bf16x8 pa3) {
    constexpr int KS = 2 * (DV / 32) * 512, HF = (DV / 32) * 512, B0 = D0 * 512;
    const s16x4 l0 = tr_read<B0>(vb), h0 = tr_read<B0 + HF>(vb), l1 = tr_read<B0 + KS>(vb), h1 = tr_read<B0 + KS + HF>(vb);
    const s16x4 l2 = tr_read<B0 + 2 * KS>(vb), h2 = tr_read<B0 + 2 * KS + HF>(vb), l3 = tr_read<B0 + 3 * KS>(vb), h3 = tr_read<B0 + 3 * KS + HF>(vb);
    asm volatile("s_waitcnt lgkmcnt(0)" ::: "memory"); SBAR();
#define PK(L, H) (bf16x8){L[0], L[1], L[2], L[3], H[0], H[1], H[2], H[3]}
    od = __builtin_amdgcn_mfma_f32_32x32x16_bf16(pa0, PK(l0, h0), od, 0, 0, 0);
    od = __builtin_amdgcn_mfma_f32_32x32x16_bf16(pa1, PK(l1, h1), od, 0, 0, 0);
    od = __builtin_amdgcn_mfma_f32_32x32x16_bf16(pa2, PK(l2, h2), od, 0, 0, 0);
    od = __builtin_amdgcn_mfma_f32_32x32x16_bf16(pa3, PK(l3, h3), od, 0, 0, 0);
#undef PK
}
template <int DV> __device__ __forceinline__ void pv_all(f32x16* o, int vb, bf16x8 pa0, bf16x8 pa1, bf16x8 pa2, bf16x8 pa3) {
    pv_one<DV, 0>(o[0], vb, pa0, pa1, pa2, pa3); pv_one<DV, 1>(o[1], vb, pa0, pa1, pa2, pa3);
    if constexpr (DV == 128) { pv_one<DV, 2>(o[2], vb, pa0, pa1, pa2, pa3); pv_one<DV, 3>(o[3], vb, pa0, pa1, pa2, pa3); }
}
template <int DQK, int DV>
__device__ __forceinline__ void attn_pass(const bf16_t* __restrict__ Qb, int ldq, const bf16_t* __restrict__ Kh, int ldk, const bf16_t* __restrict__ Vh, int ldv, int seq, char* lds, f32x16* o) {
    constexpr int KROW = 2 * DQK + 16, SHM_K = 64 * KROW, SHM_V = 64 * DV * 2, KCH = DQK / 8, VCH = DV / 8, KP = 64 * KCH, VP = 64 * VCH, KN = (KP + 511) / 512, VN = (VP + 511) / 512, ND = DV / 32;
    const int tid = threadIdx.x, wid = tid >> 6, lane = tid & 63, r32 = lane & 31, hi = lane >> 5;
    char* V_lds = lds; char* K_lds = lds + 2 * SHM_V;
    float* wsf = (float*)(lds + 2 * SHM_V + 2 * SHM_K) + wid * 64; float* li_l = wsf; float* al_l = wsf + 32;
    float m_reg = -1e30f, l_reg = 0; bf16x8 qr[DQK / 16];
#pragma unroll
    for (int d = 0; d < ND; ++d) o[d] = f32x16{};
    const bf16_t* Qw = Qb + (size_t)(wid * 32 + r32) * ldq + hi * 8;
#pragma unroll
    for (int d0 = 0; d0 < DQK / 16; ++d0) qr[d0] = *reinterpret_cast<const bf16x8*>(Qw + d0 * 16);
    unsigned koff[KN], voff[VN]; int kdst[KN], vdst[VN]; bool kval[KN], vval[VN];
#pragma unroll
    for (int i = 0; i < KN; ++i) { const int p = tid + 512 * i, row = p / KCH, ch = p % KCH; kval[i] = p < KP; koff[i] = (unsigned)(row * ldk + ch * 8) * 2u; kdst[i] = row * KROW + ch * 16; }
#pragma unroll
    for (int i = 0; i < VN; ++i) { const int p = tid + 512 * i, row = p / VCH, ch = p % VCH; vval[i] = p < VP; voff[i] = (unsigned)(row * ldv + ch * 8) * 2u; vdst[i] = v_st<DV>(row, ch * 8); }
    const int vb0 = (int)(uintptr_t)V_lds + v_rd_base(lane);
    bf16x8 sk[2][KN], sv[2][VN];
#define KOK(q_) (512 * (q_) + 511 < KP || kval[q_])
#define VOK(q_) (512 * (q_) + 511 < VP || vval[q_])
#define SLOAD(i, k0) do { const char* vb_ = (const char*)Vh + (size_t)(k0) * ldv * 2; const char* kb_ = (const char*)Kh + (size_t)(k0) * ldk * 2; \
    _Pragma("unroll") for (int q_ = 0; q_ < VN; ++q_) if (VOK(q_)) sv[i][q_] = *reinterpret_cast<const bf16x8*>(vb_ + voff[q_]); \
    _Pragma("unroll") for (int q_ = 0; q_ < KN; ++q_) if (KOK(q_)) sk[i][q_] = *reinterpret_cast<const bf16x8*>(kb_ + koff[q_]); } while (0)
#define SWRITE(b, i) do { _Pragma("unroll") for (int q_ = 0; q_ < VN; ++q_) if (VOK(q_)) *(bf16x8*)(V_lds + (b) * SHM_V + vdst[q_]) = sv[i][q_]; \
    _Pragma("unroll") for (int q_ = 0; q_ < KN; ++q_) if (KOK(q_)) *(bf16x8*)(K_lds + (b) * SHM_K + kdst[q_]) = sk[i][q_]; } while (0)
#define RESC(a) do { if (__any((a) < 1.f)) { if (hi == 0) al_l[r32] = (a); asm volatile("s_waitcnt lgkmcnt(0)" ::: "memory"); \
    _Pragma("unroll") for (int d = 0; d < ND; ++d) _Pragma("unroll") for (int r = 0; r < 16; ++r) o[d][r] *= al_l[crow(r, hi)]; } } while (0)
    f32x16 pA0, pA1, pB0, pB1; float mnA, mnB, alA, alB; bf16x8 pa0, pa1, pa2, pa3; const int NT = seq / 64;
    SLOAD(0, 0); SWRITE(0, 0); __syncthreads();
    qkt<DQK>(pA0, pA1, K_lds, qr, r32, hi); partialSM<DQK>(pA0, pA1, m_reg, mnA, alA);
    SLOAD(1, 64); if (2 < NT) SLOAD(0, 128);
    SWRITE(1, 1); __syncthreads();
    for (int j = 1; j + 1 < NT; j += 2) {
        SBAR(); qkt<DQK>(pB0, pB1, K_lds + SHM_K, qr, r32, hi);
        finishSM(pA0, pA1, alA, l_reg, pa0, pa1, pa2, pa3); SBAR();
        SLOAD(1, (j + 2) * 64); SBAR();
        pv_all<DV>(o, vb0, pa0, pa1, pa2, pa3); partialSM<DQK>(pB0, pB1, m_reg, mnB, alB);
        __syncthreads(); SWRITE(0, 0);
        RESC(alB); __syncthreads();
        SBAR(); qkt<DQK>(pA0, pA1, K_lds, qr, r32, hi);
        finishSM(pB0, pB1, alB, l_reg, pa0, pa1, pa2, pa3); SBAR();
        if (j + 3 < NT) SLOAD(0, (j + 3) * 64); SBAR();
        pv_all<DV>(o, vb0 + SHM_V, pa0, pa1, pa2, pa3); partialSM<DQK>(pA0, pA1, m_reg, mnA, alA);
        __syncthreads(); SWRITE(1, 1);
        RESC(alA); __syncthreads();
    }
    SBAR(); qkt<DQK>(pB0, pB1, K_lds + SHM_K, qr, r32, hi);
    finishSM(pA0, pA1, alA, l_reg, pa0, pa1, pa2, pa3); SBAR();
    pv_all<DV>(o, vb0, pa0, pa1, pa2, pa3); partialSM<DQK>(pB0, pB1, m_reg, mnB, alB);
    __syncthreads(); RESC(alB);
    finishSM(pB0, pB1, alB, l_reg, pa0, pa1, pa2, pa3); SBAR();
    pv_all<DV>(o, vb0 + SHM_V, pa0, pa1, pa2, pa3);
    if (hi == 0) li_l[r32] = l_reg; asm volatile("s_waitcnt lgkmcnt(0)" ::: "memory");
#pragma unroll
    for (int r = 0; r < 16; ++r) { const float rl = __builtin_amdgcn_rcpf(li_l[crow(r, hi)]);
#pragma unroll
        for (int d = 0; d < ND; ++d) o[d][r] *= rl; }
    __syncthreads();
#undef SLOAD
#undef SWRITE
#undef RESC
#undef KOK
#undef VOK
}

constexpr int OT_STRIDE = 132;
template <int ND> __device__ __forceinline__ void o_to_lds(const f32x16* o, LAS float* T, int r32, int hi) {
#pragma unroll
    for (int d = 0; d < ND; ++d)
#pragma unroll
        for (int r = 0; r < 16; ++r) T[crow(r, hi) * OT_STRIDE + d * 32 + r32] = o[d][r];
    asm volatile("s_waitcnt lgkmcnt(0)" ::: "memory");
}
__device__ __forceinline__ void attn_phase(const Params& P, const Frame& F) {
    const bf16_t* QA = (const bf16_t*)(P.ws + WS_QA); const bf16_t* KA = (const bf16_t*)(P.ws + WS_KA); const bf16_t* VA = (const bf16_t*)(P.ws + WS_VA);
    const bf16_t* QB = (const bf16_t*)(P.ws + WS_QB); const bf16_t* KB = (const bf16_t*)(P.ws + WS_KB); const bf16_t* VB = (const bf16_t*)(P.ws + WS_VB);
    bf16_t* CAT = (bf16_t*)(P.ws + WS_CAT);
    float* SCR = (float*)(P.ws + WS_SCR) + ((size_t)F.bid * NWAVES + F.wave) * 4096;
    const float lam = *(const float*)(P.ws + WS_LAM);
    const int vcu = (F.G % 8 == 0) ? (F.bid % 8) * (F.G / 8) + F.bid / 8 : F.bid;
    const int r32 = F.lane & 31, hi = F.lane >> 5, erow = F.lane >> 1, ehalf = F.lane & 1;
    char* lds = (char*)F.lds;
    LAS float* T = (LAS float*)(F.lds + F.wave * (32 * OT_STRIDE * 4));
    int u = vcu;
    for (; u < 512; u += F.G) {
        {
            const int b = u >> 5, h = (u >> 3) & 3, qb = u & 7;
            const size_t krow0 = (size_t)b * TPB, qrow0 = krow0 + CTXL + qb * 256;
            { f32x16 o[4];
              attn_pass<64, 128>(QA + qrow0 * 512 + h * 128, 512, KA + krow0 * 512 + h * 128, 512, VA + krow0 * 512 + h * 128, 512, TPB, lds, o);
              o_to_lds<4>(o, T, r32, hi); }
#pragma unroll 4
            for (int q = 0; q < 16; ++q) *(f32x4*)(SCR + erow * 128 + ehalf * 64 + 4 * q) = *(const LAS f32x4*)(T + erow * OT_STRIDE + ehalf * 64 + 4 * q);
            __syncthreads();
            { f32x16 o[4];
              attn_pass<64, 128>(QA + qrow0 * 512 + h * 128 + 64, 512, KA + krow0 * 512 + h * 128 + 64, 512, VA + krow0 * 512 + h * 128, 512, TPB, lds, o);
              o_to_lds<4>(o, T, r32, hi); }
            float ss = 0.f;
#pragma unroll 4
            for (int q = 0; q < 16; ++q) { LAS f32x4* tp = (LAS f32x4*)(T + erow * OT_STRIDE + ehalf * 64 + 4 * q);
                const f32x4 cv = *(const f32x4*)(SCR + erow * 128 + ehalf * 64 + 4 * q) - *tp * lam; *tp = cv;
                ss += (cv[0] * cv[0] + cv[1] * cv[1]) + (cv[2] * cv[2] + cv[3] * cv[3]); }
            ss += __shfl_xor(ss, 1);
            const float rstd = rsqrtf(ss * (1.f / 128.f) + EPS) * 0.8f;
            asm volatile("s_waitcnt lgkmcnt(0)" ::: "memory");
            bf16_t* dst = CAT + ((size_t)b * SEQ + qb * 256 + F.wave * 32 + erow) * DM + h * 128 + ehalf * 64;
#pragma unroll 2
            for (int q = 0; q < 8; ++q) { const LAS f32x4* tp = (const LAS f32x4*)(T + erow * OT_STRIDE + ehalf * 64 + 8 * q);
                const f32x4 g0 = *(const f32x4*)(P.diff_subln + ehalf * 64 + 8 * q), g1 = *(const f32x4*)(P.diff_subln + ehalf * 64 + 8 * q + 4);
                *(u32x4*)(dst + 8 * q) = pack8(tp[0] * g0 * rstd, tp[1] * g1 * rstd); }
            __syncthreads();
        }
    }
    for (; u < 1536; u += F.G) {
        {
            const int v = u - 512, b = v >> 6, h = (v >> 3) & 7, qb = v & 7;
            const size_t krow0 = (size_t)b * TPB, qrow0 = krow0 + CTXL + qb * 256;
            { f32x16 o[2];
              attn_pass<96, 64>(QB + qrow0 * 768 + h * 96, 768, KB + krow0 * 768 + h * 96, 768, VB + krow0 * 512 + h * 64, 512, TPB, lds, o);
              o_to_lds<2>(o, T, r32, hi); }
            bf16_t* dst = CAT + ((size_t)b * SEQ + qb * 256 + F.wave * 32 + erow) * DM + 512 + h * 64 + ehalf * 32;
#pragma unroll
            for (int q = 0; q < 4; ++q) { const LAS f32x4* tp = (const LAS f32x4*)(T + erow * OT_STRIDE + ehalf * 32 + 8 * q); *(u32x4*)(dst + 8 * q) = pack8(tp[0], tp[1]); }
            __syncthreads();
        }
    }
}

__device__ __forceinline__ void p8_phase(const Params& P, const Frame& F) {
    float chk = 1.f;
#if MK_CHECK
    { const unsigned* BAD = (const unsigned*)(P.ws + WS_LAM) + 16; chk = 1.f + 0.1f * (float)((BAD[0] ? 1 : 0) + (BAD[1] ? 2 : 0)); }
#endif
    for (int r = F.gwi; r < MLAT; r += F.ngw) {
        float* row = P.out + (size_t)r * DM; f32x4 v[4]; float s = 0.f;
#pragma unroll
        for (int j = 0; j < 4; ++j) { v[j] = *(const f32x4*)(row + 4 * F.lane + 256 * j); s += (v[j].x * v[j].x + v[j].y * v[j].y) + (v[j].z * v[j].z + v[j].w * v[j].w); }
        const float rstd = rsqrtf(wave_sum(s) * (1.f / DM) + EPS);
#pragma unroll
        for (int j = 0; j < 4; ++j) { const f32x4 g = *(const f32x4*)(P.final_norm + 4 * F.lane + 256 * j); const f32x4 ov = v[j] * (rstd * chk) * g; if (!F.dry) *(f32x4*)(row + 4 * F.lane + 256 * j) = ov; else asm volatile("" :: "v"(ov)); }
    }
}


#define XB_TMO      128
#define XB_XCNT(j)  (256  + 64 * (j))
#define XB_XSUB(j)  (1280 + 64 * (j))
#define XB_XGEN(j)  (2304 + 64 * (j))
#define XB_TOP      3328
#define XB_TOPGEN   3392
#define XCD_BAR_WORDS 3456
#define XB_SPIN_CAP (1u << 20)
__device__ __forceinline__ unsigned xb_ld(unsigned* p)              { return __hip_atomic_load(p, __ATOMIC_RELAXED, __HIP_MEMORY_SCOPE_AGENT); }
__device__ __forceinline__ unsigned xb_add(unsigned* p, unsigned v) { return __hip_atomic_fetch_add(p, v, __ATOMIC_RELAXED, __HIP_MEMORY_SCOPE_AGENT); }
__device__ __forceinline__ unsigned xb_xcc_id() { return (unsigned)__builtin_amdgcn_s_getreg((3 << 11) | 20) & 0xFu; }
#define XB_SPIN(cond, bar) do { unsigned _sp = 0; while (cond) { __builtin_amdgcn_s_sleep(1); \
    if ((++_sp & 255u) == 0u) { if (xb_ld(&(bar)[XB_TMO])) break; if (_sp > XB_SPIN_CAP) { atomicAdd(&(bar)[XB_TMO], 1u); break; } } } } while (0)
struct XcdBarrier { unsigned* bar; unsigned x; volatile LAS unsigned* st; };
__device__ __forceinline__ XcdBarrier xcd_barrier_post(unsigned* bar, volatile LAS unsigned* st) {
    XcdBarrier b; b.bar = bar; b.x = xb_xcc_id(); b.st = st;
    if (threadIdx.x == 0) (void)xb_add(&bar[XB_XCNT(b.x)], 1u);
    return b;
}
__device__ __forceinline__ void xcd_barrier_complete(unsigned* bar, unsigned x, unsigned& nloc, unsigned& nx) {
    const unsigned G = gridDim.x * gridDim.y * gridDim.z;
    unsigned sum, cnt, mine, sp = 0u;
    for (;;) {
        sum = 0u; cnt = 0u; mine = 0u;
#pragma unroll
        for (unsigned j = 0; j < 16; ++j) { const unsigned c = xb_ld(&bar[XB_XCNT(j)]); sum += c; cnt += (c > 0u) ? 1u : 0u; mine = (j == x) ? c : mine; }
        if (sum == G) break;
        __builtin_amdgcn_s_sleep(1);
        if ((++sp & 255u) == 0u) { if (xb_ld(&bar[XB_TMO])) break; if (sp > XB_SPIN_CAP) { atomicAdd(&bar[XB_TMO], 1u); break; } }
    }
    nloc = mine > 0u ? mine : 1u; nx = cnt > 0u ? cnt : 1u;
}
__device__ __forceinline__ void xcd_barrier(const XcdBarrier& b) {
    asm volatile("s_waitcnt vmcnt(0)" ::: "memory");
    __syncthreads();
    if (threadIdx.x == 0) {
        unsigned* bar = b.bar;
        __builtin_amdgcn_s_waitcnt(0);
        unsigned nloc = b.st[0], nx = b.st[1];
        if (nloc == 0u) { xcd_barrier_complete(bar, b.x, nloc, nx); b.st[0] = nloc; b.st[1] = nx; }
        const unsigned old = xb_add(&bar[XB_XSUB(b.x)], 1u);
        const unsigned gen = old / nloc;
        if (old + 1u == (gen + 1u) * nloc) {
            __builtin_amdgcn_fence(__ATOMIC_RELEASE, "agent");
            asm volatile("s_waitcnt vmcnt(0)" ::: "memory");
            const unsigned og = xb_add(&bar[XB_TOP], 1u);
            const unsigned tg = og / nx;
            if (og + 1u == (tg + 1u) * nx) xb_add(&bar[XB_TOPGEN], 1u);
            else XB_SPIN(xb_ld(&bar[XB_TOPGEN]) == tg, bar);
            __builtin_amdgcn_fence(__ATOMIC_ACQUIRE, "agent");
            xb_add(&bar[XB_XGEN(b.x)], 1u);
            asm volatile("s_waitcnt vmcnt(0)" ::: "memory");
        } else {
            XB_SPIN(xb_ld(&bar[XB_XGEN(b.x)]) == gen, bar);
            __builtin_amdgcn_fence(__ATOMIC_ACQUIRE, "agent");
            asm volatile("s_waitcnt vmcnt(0)" ::: "memory");
        }
    }
    __syncthreads();
}

#ifndef MK_FUSED
#define MK_FUSED 1
#endif
#ifndef MK_REP_MASK
#define MK_REP_MASK 0
#endif
#ifndef MK_CHECK
#define MK_CHECK 0
#endif
#ifndef MK_P3_SIMPLE
#define MK_P3_SIMPLE 0
#endif
#ifndef MK_SYNC
#define MK_SYNC 1
#endif
constexpr int LDS_BYTES = 147456;
constexpr int NPHASE = 9;
__global__ void __launch_bounds__(NTHREADS, 2) mk_kernel(Params P, int lo, int hi, int dry) {
    extern __shared__ __attribute__((aligned(16))) unsigned char lds_raw[];
    Frame F; F.tid = threadIdx.x; F.lane = F.tid & 63; F.wave = __builtin_amdgcn_readfirstlane(F.tid >> 6); F.G = gridDim.x; F.bid = blockIdx.x;
    F.gwi = F.wave * F.G + F.bid; F.ngw = F.G * NWAVES; F.lds = (LAS unsigned char*)lds_raw; F.dry = (MK_REP_MASK != 0) && (dry != 0);
#if MK_SYNC == 0
    cg::grid_group grid = cg::this_grid();
#define GRID_BAR() grid.sync()
#else
    volatile LAS unsigned* MISC = (volatile LAS unsigned*)(F.lds + LDS_BYTES - 256);
    if (F.tid < 64) MISC[F.tid] = 0u;
    __syncthreads();
    XcdBarrier xbar; xbar.bar = (unsigned*)(P.ws + WS_BAR); xbar.x = 0; xbar.st = nullptr;
    if (hi - lo > 1) xbar = xcd_barrier_post((unsigned*)(P.ws + WS_BAR), MISC);
#define GRID_BAR() xcd_barrier(xbar)
#endif
#define IN(k) (lo <= (k) && (k) < hi)
#define SEAM(k) do { if (IN(k) && IN((k) + 1)) GRID_BAR(); } while (0)
#define RUN(k, ...) do { if (IN(k)) { __VA_ARGS__ } } while (0)
    RUN(0, p0_phase(P, F););
    SEAM(0);
    RUN(1, p1_phase(P, F););
    SEAM(1);
    RUN(2, {
        TileOrder S; S.init(MROWS / 256, NIN / 256, F.G, F.bid);
        EpiQKV E{(bf16_t*)(P.ws + WS_QA), (bf16_t*)(P.ws + WS_KA), (bf16_t*)(P.ws + WS_VA), (bf16_t*)(P.ws + WS_CQ), (bf16_t*)(P.ws + WS_CKV), (bf16_t*)(P.ws + WS_KB),
                 (float*)(P.ws + WS_SSQQ), (float*)(P.ws + WS_SSQKV), rope_tab(P), F.dry};
        pg8::gemm_phase(F.lds, pg8::Gemm{(const bf16_t*)(P.ws + WS_H), (const bf16_t*)(P.ws + WS_WIN), 1024}, S, E);
    });
    SEAM(2);
    RUN(3, {
#if MK_P3_SIMPLE
        { TileOrder S; S.init(MLAT / 256, 3, F.G, F.bid, true); EpiQup E{(bf16_t*)(P.ws + WS_QB), (const float*)(P.ws + WS_SSQQ), rope_tab(P)};
          Unit u; for (int i = 0; S.next(i, u); ++i) gemm_unit_simple(F, (const bf16_t*)(P.ws + WS_CQ), (const bf16_t*)(P.ws + WS_WQUP), 256, u, E); }
        { TileOrder S; S.init(MROWS / 256, 4, F.G, F.bid); EpiKVup E{(bf16_t*)(P.ws + WS_KB), (bf16_t*)(P.ws + WS_VB), (const float*)(P.ws + WS_SSQKV)};
          Unit u; for (int i = 0; S.next(i, u); ++i) gemm_unit_simple(F, (const bf16_t*)(P.ws + WS_CKV), (const bf16_t*)(P.ws + WS_WKVUP), 128, u, E); }
#else
        { TileOrder S; S.init(MLAT / 256, 3, F.G, F.bid, true); EpiQup E{(bf16_t*)(P.ws + WS_QB), (const float*)(P.ws + WS_SSQQ), rope_tab(P)};
          int kq = 256; asm volatile("" : "+s"(kq)); pg8::gemm_phase(F.lds, pg8::Gemm{(const bf16_t*)(P.ws + WS_CQ), (const bf16_t*)(P.ws + WS_WQUP), kq}, S, E); }
        { TileOrder S; S.init(MROWS / 256, 4, F.G, F.bid); EpiKVup E{(bf16_t*)(P.ws + WS_KB), (bf16_t*)(P.ws + WS_VB), (const float*)(P.ws + WS_SSQKV)};
          int kk = 128; asm volatile("" : "+s"(kk)); pg8::gemm_phase(F.lds, pg8::Gemm{(const bf16_t*)(P.ws + WS_CKV), (const bf16_t*)(P.ws + WS_WKVUP), kk}, S, E); }
#endif
#if MK_CHECK == 3
        GRID_BAR();
        { TileOrder S; S.init(MLAT / 256, 3, F.G, F.bid, true); EpiQup E{(bf16_t*)(P.ws + WS_A2), (const float*)(P.ws + WS_SSQQ), rope_tab(P)};
          Unit u; for (int i = 0; S.next(i, u); ++i) gemm_unit_simple(F, (const bf16_t*)(P.ws + WS_CQ), (const bf16_t*)(P.ws + WS_WQUP), 256, u, E); }
        { TileOrder S; S.init(MROWS / 256, 4, F.G, F.bid); EpiKVup E{(bf16_t*)(P.ws + WS_CAT), (bf16_t*)(P.ws + WS_SCR), (const float*)(P.ws + WS_SSQKV)};
          Unit u; for (int i = 0; S.next(i, u); ++i) if (u.pn < 2) gemm_unit_simple(F, (const bf16_t*)(P.ws + WS_CKV), (const bf16_t*)(P.ws + WS_WKVUP), 128, u, E); }
        GRID_BAR();
        { unsigned* BAD = (unsigned*)(P.ws + WS_LAM) + 16; const bf16_t* q0 = (const bf16_t*)(P.ws + WS_QB); const bf16_t* q1 = (const bf16_t*)(P.ws + WS_A2);
          const bf16_t* k0 = (const bf16_t*)(P.ws + WS_KB); const bf16_t* k1 = (const bf16_t*)(P.ws + WS_CAT); unsigned badq = 0, badk = 0;
          for (size_t i = (size_t)F.bid * NTHREADS + F.tid; i < (size_t)MROWS * 768; i += (size_t)F.G * NTHREADS) {
              const int row = (int)(i / 768), col = (int)(i % 768); const bool latrow = (row % TPB) >= CTXL;
              const float a = __uint_as_float((unsigned)q0[i] << 16), b = __uint_as_float((unsigned)q1[i] << 16);
              if (latrow && !(fabsf(a - b) <= 1e-3f + 1e-2f * fabsf(b))) ++badq;
              const float c = __uint_as_float((unsigned)k0[i] << 16), d = __uint_as_float((unsigned)k1[i] << 16);
              if ((col % 96) < 64 && !(fabsf(c - d) <= 1e-3f + 1e-2f * fabsf(d))) ++badk; }
          if (badq) atomicAdd(BAD, 1u); if (badk) atomicAdd(BAD + 1, 1u); }
#endif
    });
    SEAM(3);
    RUN(4, biasf_task(P, F); attn_phase(P, F););
    SEAM(4);
    RUN(5, {
        TileOrder S; S.init(MLAT / 256, 4, F.G, F.bid); EpiOut E{P.x, P.out, (bf16_t*)(P.ws + WS_A2), (const float*)(P.ws + WS_MOD), (float*)(P.ws + WS_SSQ2), F.dry};
        pg8::gemm_phase(F.lds, pg8::Gemm{(const bf16_t*)(P.ws + WS_CAT), (const bf16_t*)(P.ws + WS_WOUT), 1024}, S, E);
    });
    SEAM(5);
    RUN(6, {
        TileOrder S; S.init(MLAT / 256, 22, F.G, F.bid); EpiFfnIn E{(bf16_t*)(P.ws + WS_G), (const float*)(P.ws + WS_SSQ2), (const float*)(P.ws + WS_BIASF)};
        pg8::gemm_phase(F.lds, pg8::Gemm{(const bf16_t*)(P.ws + WS_A2), (const bf16_t*)(P.ws + WS_WFFI), 1024}, S, E);
    });
    SEAM(6);
    RUN(7, {
        TileOrder S; S.init(MLAT / 256, 4, F.G, F.bid); EpiFfnOut E{P.out, (const float*)(P.ws + WS_MOD), F.dry};
        pg8::gemm_phase(F.lds, pg8::Gemm{(const bf16_t*)(P.ws + WS_G), (const bf16_t*)(P.ws + WS_WFFO), FFH}, S, E);
    });
    SEAM(7);
    RUN(8, p8_phase(P, F););
#undef RUN
#undef IN
#undef SEAM
#undef GRID_BAR
}

extern "C" void kernel_launch(void* const* d_in, const int* in_sizes, int n_in, void* d_out, int out_size, void* d_ws, size_t ws_size, hipStream_t stream) {
    static int grid = 0;
    if (grid == 0) {
        if (n_in != 17 || in_sizes[0] != MLAT * DM || out_size != MLAT * DM || ws_size < WS_END) {
            fprintf(stderr, "kernel_launch: unexpected shapes: n_in %d in0 %d out %d ws %zu (need %zu)\n", n_in, n_in > 0 ? in_sizes[0] : -1, out_size, ws_size, (size_t)WS_END); grid = -1; return; }
        if (hipFuncSetAttribute((const void*)mk_kernel, hipFuncAttributeMaxDynamicSharedMemorySize, LDS_BYTES) != hipSuccess) { fprintf(stderr, "kernel_launch: hipFuncSetAttribute failed\n"); grid = -1; return; }
        int dev = 0, cus = 0, per_cu = 0;
        (void)hipGetDevice(&dev); (void)hipDeviceGetAttribute(&cus, hipDeviceAttributeMultiprocessorCount, dev);
        if (hipOccupancyMaxActiveBlocksPerMultiprocessor(&per_cu, (const void*)mk_kernel, NTHREADS, LDS_BYTES) != hipSuccess || per_cu < 1) { fprintf(stderr, "kernel_launch: occupancy query says %d blocks/CU\n", per_cu); per_cu = 1; }
        (void)hipGetLastError();
        grid = cus;
        if (grid <= 0) grid = 256;
    }
    if (grid < 0) return;
    (void)hipMemsetAsync(d_ws, 0, CTL_BYTES, stream);
    Params p{};
    p.x = (const float*)d_in[0]; p.c = (const float*)d_in[1]; p.ctx = (const float*)d_in[2]; p.c_ctx = (const float*)d_in[3]; p.w_ada = (const float*)d_in[4]; p.b_ada = (const float*)d_in[5];
    p.w_in = (const float*)d_in[6]; p.q_a_norm = (const float*)d_in[7]; p.kv_a_norm = (const float*)d_in[8]; p.w_q_up = (const float*)d_in[9]; p.w_kv_up = (const float*)d_in[10];
    p.diff_lambda = (const float*)d_in[11]; p.diff_subln = (const float*)d_in[12]; p.w_out = (const float*)d_in[13]; p.w_ffn_in = (const float*)d_in[14]; p.w_ffn_out = (const float*)d_in[15];
    p.final_norm = (const float*)d_in[16]; p.out = (float*)d_out; p.ws = (unsigned char*)d_ws;
#if MK_FUSED
#if MK_SYNC == 0
    int lo = 0, hi = NPHASE, dry = 0; void* args[] = {&p, &lo, &hi, &dry};
    hipError_t e = hipLaunchCooperativeKernel((const void*)mk_kernel, dim3(grid), dim3(NTHREADS), args, LDS_BYTES, stream);
    if (e != hipSuccess) fprintf(stderr, "kernel_launch: cooperative launch failed: %s (grid %d)\n", hipGetErrorString(e), grid);
#else
    hipLaunchKernelGGL(mk_kernel, dim3(grid), dim3(NTHREADS), LDS_BYTES, stream, p, 0, NPHASE, 0);
    for (int k = 0; k < NPHASE; ++k) if ((MK_REP_MASK >> k) & 1) hipLaunchKernelGGL(mk_kernel, dim3(grid), dim3(NTHREADS), LDS_BYTES, stream, p, k, k + 1, 1);
    { const hipError_t le = hipPeekAtLastError(); if (le != hipSuccess) fprintf(stderr, "kernel_launch: launch failed: %s\n", hipGetErrorName(le)); }
#endif
#else
    for (int ph = 0; ph < NPHASE; ++ph) {
        hipLaunchKernelGGL(mk_kernel, dim3(grid), dim3(NTHREADS), LDS_BYTES, stream, p, ph, ph + 1, 0);
        const hipError_t le = hipPeekAtLastError();
        if (le != hipSuccess) { fprintf(stderr, "kernel_launch: launch %d failed: %s\n", ph, hipGetErrorName(le)); break; }
    }
#endif
}
```

```cpp
#include <hip/hip_runtime.h>
#include <hip/hip_cooperative_groups.h>
#include <cstdint>
#include <cstdio>
namespace cg = cooperative_groups;

#define LAS __attribute__((address_space(3)))
typedef unsigned short bf16_t;
typedef short bf16x8 __attribute__((ext_vector_type(8)));
typedef short s16x4 __attribute__((ext_vector_type(4)));
typedef float f32x2 __attribute__((ext_vector_type(2)));
typedef float f32x4 __attribute__((ext_vector_type(4)));
typedef float f32x16 __attribute__((ext_vector_type(16)));
typedef unsigned u32x2 __attribute__((ext_vector_type(2)));
typedef unsigned u32x4 __attribute__((ext_vector_type(4)));
typedef __bf16 bf16x2_t __attribute__((ext_vector_type(2)));

constexpr int DM = 1024, NB = 16, SEQ = 2048, CTXL = 256, TPB = SEQ + CTXL;
constexpr int MROWS = NB * TPB, MLAT = NB * SEQ;
constexpr int FFH = 2816, NIN = 2048, NADA = 6 * DM;
constexpr float EPS = 1e-6f;
constexpr float QSCALE_A = 0.125f * 1.4426950408889634f, QSCALE_B = 0.10206207261596575f * 1.4426950408889634f;
constexpr int NWAVES = 8, NTHREADS = 512;

constexpr size_t KiB = 1024, MiB = 1024 * 1024;
constexpr size_t WS_MOD = 0, WS_BIASF = 512 * KiB, WS_SSQQ = 1024 * KiB, WS_SSQKV = 1184 * KiB, WS_SSQ2 = 1344 * KiB, WS_LAM = 1536 * KiB, WS_BAR = 1792 * KiB;
constexpr size_t CTL_BYTES = 2 * MiB;
constexpr size_t WS_TAB = 2 * MiB;
constexpr size_t WS_WIN = 3 * MiB, WS_WQUP = 7 * MiB, WS_WKVUP = 7 * MiB + 512 * KiB, WS_WOUT = 8 * MiB, WS_WFFI = 10 * MiB, WS_WFFO = 21 * MiB;
constexpr size_t WS_A2 = 27 * MiB, WS_CAT = 91 * MiB;
constexpr size_t WS_H = 155 * MiB, WS_QB = 155 * MiB, WS_QA = 227 * MiB, WS_KA = 263 * MiB, WS_VA = 299 * MiB, WS_CQ = 335 * MiB, WS_CKV = 353 * MiB;
constexpr size_t WS_KB = 362 * MiB, WS_VB = 416 * MiB, WS_SCR = 452 * MiB, WS_G = 155 * MiB, WS_END = 484 * MiB;
static_assert(WS_G + (size_t)MLAT * FFH * 2 <= WS_CQ, "G overlay");
static_assert(WS_WFFO + (size_t)DM * FFH * 2 <= WS_A2, "wffo");

struct Params {
    const float *x, *c, *ctx, *c_ctx, *w_ada, *b_ada, *w_in, *q_a_norm, *kv_a_norm, *w_q_up, *w_kv_up, *diff_lambda, *diff_subln, *w_out, *w_ffn_in, *w_ffn_out, *final_norm;
    float* out; unsigned char* ws;
};

__device__ __forceinline__ unsigned cvtpk(float lo, float hi) { f32x2 v = {lo, hi}; bf16x2_t b = __builtin_convertvector(v, bf16x2_t); return __builtin_bit_cast(unsigned, b); }
__device__ __forceinline__ float wave_sum(float v) {
#pragma unroll
    for (int o = 1; o < 64; o <<= 1) v += __shfl_xor(v, o);
    return v;
}
__device__ __forceinline__ float silu_f(float v) { return v / (1.f + __expf(-v)); }
__device__ __forceinline__ u32x4 pack8(f32x4 a, f32x4 b) { u32x4 w; w.x = cvtpk(a[0], a[1]); w.y = cvtpk(a[2], a[3]); w.z = cvtpk(b[0], b[1]); w.w = cvtpk(b[2], b[3]); return w; }
__device__ __forceinline__ int ropeA_L(int q) { return 4 * ((q >> 3) & 3) + (q & 3) + 16 * ((q >> 2) & 1); }
__device__ __forceinline__ int ropeB_L(int q) { const int a = q >> 3, n = (q >> 2) & 1, j = q & 3; return (a >> 1) * 16 + (a & 1) * 4 + j + 8 * n; }

struct Frame { int tid, lane, wave, G, bid, gwi, ngw; bool dry; LAS unsigned char* lds; };

__device__ __forceinline__ void p0_ada_task(const Params& P, float* MOD, int t, int lane, bool dry) {
    const int cgp = t % 24, kc = t / 24, k0 = kc * 32, n = cgp * 256 + lane * 4, k = k0 + (lane & 31);
    float sv[17];
#pragma unroll
    for (int b = 0; b < 16; ++b) sv[b] = silu_f(P.c[b * DM + k]);
    sv[16] = silu_f(P.c_ctx[k]);
    f32x4 acc[17];
    const f32x4 binit = (kc == 0) ? *(const f32x4*)(P.b_ada + n) : (f32x4){0.f, 0.f, 0.f, 0.f};
#pragma unroll
    for (int b = 0; b < 17; ++b) acc[b] = binit;
#pragma unroll 2
    for (int kk = 0; kk < 32; ++kk) {
        const f32x4 w = *(const f32x4*)(P.w_ada + (size_t)(k0 + kk) * NADA + n);
#pragma unroll
        for (int b = 0; b < 17; ++b) { const float s = __shfl(sv[b], kk); acc[b] += w * s; }
    }
#pragma unroll
    for (int b = 0; b < 17; ++b)
#pragma unroll
        for (int j = 0; j < 4; ++j) { if (!dry) atomicAdd(&MOD[b * NADA + n + j], acc[b][j]); else asm volatile("" :: "v"(acc[b][j])); }
}
__device__ __forceinline__ int src_col(int mat, int p) {
    switch (mat) {
    case 0: if (p < 1024) return (p & ~31) + ropeA_L(p & 31); if (p < 1920) return p; if (p < 1952) return 1920 + ropeB_L(p - 1920); return -1;
    case 1: if (p < 512) return (p >> 6) * 96 + (p & 63); { const int q = p - 512; return (q >> 5) * 96 + 64 + ropeB_L(q & 31); }
    case 2: if (p < 512) return (p >> 6) * 128 + (p & 63); { const int q = p - 512; return (q >> 6) * 128 + 64 + (q & 63); }
    case 4: { const int t = p >> 8, q = p & 255; return q < 128 ? 128 * t + q : FFH + 128 * t + (q - 128); }
    default: return p;
    }
}
__device__ __forceinline__ void p0_transpose_item(const float* W, int K, int N, const float* gain, bf16_t* WT, int mat, int npb, LAS float* scr, int item, int lane) {
    const int kb = item / npb, pb = item % npb, k0 = 64 * kb, p0 = 32 * pb;
    const int sc = src_col(mat, p0 + (lane & 31));
#pragma unroll 8
    for (int i = 0; i < 32; ++i) { const int kk = 2 * i + (lane >> 5);
        float v = 0.f; if (sc >= 0) { v = W[(size_t)(k0 + kk) * N + sc]; if (gain) v *= gain[k0 + kk]; }
        scr[kk * 33 + (lane & 31)] = v; }
    asm volatile("s_waitcnt lgkmcnt(0)" ::: "memory");
    const int c = lane & 7;
#pragma unroll
    for (int j = 0; j < 4; ++j) { const int n = (lane >> 3) + 8 * j; const LAS float* s = scr + (8 * c) * 33 + n;
        u32x4 o; o.x = cvtpk(s[0 * 33], s[1 * 33]); o.y = cvtpk(s[2 * 33], s[3 * 33]); o.z = cvtpk(s[4 * 33], s[5 * 33]); o.w = cvtpk(s[6 * 33], s[7 * 33]);
        *(u32x4*)(WT + (size_t)(p0 + n) * K + k0 + 8 * c) = o; }
    asm volatile("s_waitcnt lgkmcnt(0)" ::: "memory");
}
__device__ __forceinline__ void sincos_d(double a, float& s, float& c) {
    const double k = __builtin_rint(a * 0.15915494309189535);
    double r = __builtin_fma(-k, 6.283185307179586, a); r = __builtin_fma(-k, 2.4492935982947064e-16, r);
    const double r2 = r * r; double ts = r, tc = 1.0, ss = r, cc = 1.0;
    for (int n = 0; n < 14; ++n) { tc = -tc * r2 / (double)((2 * n + 1) * (2 * n + 2)); cc += tc; ts = -ts * r2 / (double)((2 * n + 2) * (2 * n + 3)); ss += ts; }
    s = (float)ss; c = (float)cc;
}
__device__ __forceinline__ void p0_phase(const Params& P, const Frame& F) {
    float* MOD = (float*)(P.ws + WS_MOD);
    LAS float* scr = (LAS float*)(F.lds + F.wave * 8448);
    constexpr int NADA_T = 24 * 32;
    constexpr int I0 = 16 * 64, I1 = 4 * 24, I2 = 2 * 32, I3 = 16 * 32, I4 = 16 * 176, I5 = 44 * 32;
    constexpr int NT = NADA_T + I0 + I1 + I2 + I3 + I4 + I5;
    for (int t = F.gwi; t < NT; t += F.ngw) {
        int r = t;
        if (r < NADA_T) { p0_ada_task(P, MOD, r, F.lane, F.dry); continue; } r -= NADA_T;
        if (r < I0) { p0_transpose_item(P.w_in, 1024, 1952, nullptr, (bf16_t*)(P.ws + WS_WIN), 0, 64, scr, r, F.lane); continue; } r -= I0;
        if (r < I1) { p0_transpose_item(P.w_q_up, 256, 768, P.q_a_norm, (bf16_t*)(P.ws + WS_WQUP), 1, 24, scr, r, F.lane); continue; } r -= I1;
        if (r < I2) { p0_transpose_item(P.w_kv_up, 128, 1024, P.kv_a_norm, (bf16_t*)(P.ws + WS_WKVUP), 2, 32, scr, r, F.lane); continue; } r -= I2;
        if (r < I3) { p0_transpose_item(P.w_out, 1024, 1024, nullptr, (bf16_t*)(P.ws + WS_WOUT), 3, 32, scr, r, F.lane); continue; } r -= I3;
        if (r < I4) { p0_transpose_item(P.w_ffn_in, 1024, 2 * FFH, nullptr, (bf16_t*)(P.ws + WS_WFFI), 4, 176, scr, r, F.lane); continue; } r -= I4;
        p0_transpose_item(P.w_ffn_out, FFH, 1024, nullptr, (bf16_t*)(P.ws + WS_WFFO), 5, 32, scr, r, F.lane);
    }
    if (F.bid == F.G - 1) {
        float* TAB = (float*)(P.ws + WS_TAB);
        for (int i = F.tid; i < 1536; i += NTHREADS) {
            float s, c;
            if (i < 1024) { const int pos = i >> 4, f = i & 15; double inv = 1.0; for (int q = 0; q < f; ++q) inv *= 0.5623413251903491; sincos_d((double)pos * inv, s, c); TAB[i] = c; TAB[1024 + i] = s; }
            else { const int e = i - 1024, pos = e >> 3, f = e & 7; double inv = 1.0; for (int q = 0; q < f; ++q) inv *= 0.31622776601683794; sincos_d((double)pos * inv, s, c); TAB[2048 + e] = c; TAB[2560 + e] = s; }
        }
        if (F.wave == 0) {
            const float* lp = P.diff_lambda; const float a = wave_sum(lp[F.lane] * lp[64 + F.lane]), b = wave_sum(lp[128 + F.lane] * lp[192 + F.lane]);
            if (F.lane == 0) *(float*)(P.ws + WS_LAM) = __expf(a) - __expf(b) + 0.2f;
        }
    }
}

__device__ __forceinline__ void p1_row_load(const Params& P, int r, int lane, f32x4 (&v)[4], const float*& mp) {
    const int b = r / TPB, t = r - b * TPB;
    const float* src = (t < CTXL) ? P.ctx + ((size_t)b * CTXL + t) * DM : P.x + ((size_t)b * SEQ + (t - CTXL)) * DM;
    mp = (const float*)(P.ws + WS_MOD) + (size_t)((t < CTXL) ? 16 : b) * NADA;
#pragma unroll
    for (int j = 0; j < 4; ++j) v[j] = *(const f32x4*)(src + 4 * lane + 256 * j);
}
__device__ __forceinline__ void p1_row_finish(bf16_t* H, int r, int lane, const f32x4 (&v)[4], const float* mp) {
    float s = 0.f;
#pragma unroll
    for (int j = 0; j < 4; ++j) s += (v[j].x * v[j].x + v[j].y * v[j].y) + (v[j].z * v[j].z + v[j].w * v[j].w);
    const float rstd = rsqrtf(wave_sum(s) * (1.f / DM) + EPS);
#pragma unroll
    for (int j = 0; j < 4; ++j) { const int col = 4 * lane + 256 * j; const f32x4 sh = *(const f32x4*)(mp + col), sc = *(const f32x4*)(mp + DM + col);
        const f32x4 h = v[j] * rstd * (sc + 1.f) + sh; u32x2 w; w.x = cvtpk(h[0], h[1]); w.y = cvtpk(h[2], h[3]);
        *(u32x2*)(H + (size_t)r * DM + col) = w; }
}
__device__ __forceinline__ void p1_phase(const Params& P, const Frame& F) {
    bf16_t* H = (bf16_t*)(P.ws + WS_H);
    for (int r = F.gwi; r < MROWS; r += 3 * F.ngw) {
        f32x4 va[4], vb[4], vc[4]; const float *ma, *mb, *mc; const int r1 = r + F.ngw, r2 = r + 2 * F.ngw;
        p1_row_load(P, r, F.lane, va, ma);
        if (r1 < MROWS) p1_row_load(P, r1, F.lane, vb, mb);
        if (r2 < MROWS) p1_row_load(P, r2, F.lane, vc, mc);
        p1_row_finish(H, r, F.lane, va, ma);
        if (r1 < MROWS) p1_row_finish(H, r1, F.lane, vb, mb);
        if (r2 < MROWS) p1_row_finish(H, r2, F.lane, vc, mc);
    }
}
__device__ __forceinline__ void biasf_task(const Params& P, const Frame& F) {
    if (F.gwi < 22 * 16) {
        const float* MOD = (const float*)(P.ws + WS_MOD);
        float* BIASF = (float*)(P.ws + WS_BIASF);
        const int cgp = F.gwi % 22, kc = F.gwi / 22, k0 = kc * 64, n = cgp * 256 + F.lane * 4;
        float sv[16];
#pragma unroll
        for (int b = 0; b < 16; ++b) sv[b] = MOD[(size_t)b * NADA + 3 * DM + k0 + F.lane];
        f32x4 acc[16];
#pragma unroll
        for (int b = 0; b < 16; ++b) acc[b] = (f32x4){0.f, 0.f, 0.f, 0.f};
#pragma unroll 1
        for (int k1 = 0; k1 < 64; k1 += 8) {
            f32x4 w[8];
#pragma unroll
            for (int kk = 0; kk < 8; ++kk) w[kk] = *(const f32x4*)(P.w_ffn_in + (size_t)(k0 + k1 + kk) * (2 * FFH) + n);
#pragma unroll
            for (int kk = 0; kk < 8; ++kk)
#pragma unroll
                for (int b = 0; b < 16; ++b) { const float s = __shfl(sv[b], k1 + kk); acc[b] += w[kk] * s; }
        }
#pragma unroll
        for (int b = 0; b < 16; ++b)
#pragma unroll
            for (int j = 0; j < 4; ++j) { if (!F.dry) atomicAdd(&BIASF[b * (2 * FFH) + n + j], acc[b][j]); else asm volatile("" :: "v"(acc[b][j])); }
    }
}

struct Unit { int pm, pn; };
__device__ __forceinline__ int perm32(int rho) { const int n = rho >> 4, i = rho & 15; return 8 * (i >> 2) + 4 * n + (i & 3); }
struct TileOrder {
    int nM, nN, nwg, G, c; bool skipctx;
    __device__ __forceinline__ void init(int nM_, int nN_, int G_, int c_, bool skip_ = false) { nM = nM_; nN = nN_; nwg = nM * nN; G = G_; c = c_; skipctx = skip_; }
    __device__ __forceinline__ bool next(int i, Unit& u) const {
        const long L = (long)i * G + c; if (L >= nwg) return false;
        int wgid = (int)L; { const int q = nwg / 8, r = nwg % 8, xcd = wgid % 8, off = wgid / 8; wgid = (xcd < r ? xcd * (q + 1) : r * (q + 1) + (xcd - r) * q) + off; }
        const int nig = 8 * nN, gid = wgid / nig, fm = gid * 8, gsz = (nM - fm) < 8 ? (nM - fm) : 8;
        u.pm = fm + ((wgid % nig) % gsz); u.pn = (wgid % nig) / gsz; if (skipctx) u.pm += (u.pm >> 3) + 1; return true;
    }
};
typedef f32x4 Acc[2][2][4][2];
constexpr int SG_STRIDE = 144;
template <class Epi>
__device__ __forceinline__ void gemm_unit_simple(const Frame& F, const bf16_t* A, const bf16_t* Bt, int K, const Unit u, const Epi& E) {
    const int wr = F.wave >> 2, wc = F.wave & 3, fr = F.lane & 15, fq = F.lane >> 4;
    LAS unsigned char* As = F.lds; LAS unsigned char* Bs = F.lds + 256 * SG_STRIDE;
    Acc acc;
#pragma unroll
    for (int a = 0; a < 2; ++a)
#pragma unroll
        for (int b = 0; b < 2; ++b)
#pragma unroll
            for (int m = 0; m < 4; ++m)
#pragma unroll
                for (int n = 0; n < 2; ++n) acc[a][b][m][n] = (f32x4){0.f, 0.f, 0.f, 0.f};
    const bf16_t* Ag = A + (size_t)u.pm * 256 * K; const bf16_t* Bg = Bt + (size_t)u.pn * 256 * K;
#pragma unroll 1
    for (int kt = 0; kt < K; kt += 64) {
        __syncthreads();
#pragma unroll
        for (int i = 0; i < 4; ++i) { const int p = F.tid + 512 * i, row = p >> 3, ch = p & 7;
            const u32x4 va = *(const u32x4*)(Ag + (size_t)row * K + kt + ch * 8), vb = *(const u32x4*)(Bg + (size_t)row * K + kt + ch * 8);
            *(LAS u32x4*)(As + row * SG_STRIDE + ch * 16) = va; *(LAS u32x4*)(Bs + row * SG_STRIDE + ch * 16) = vb; if (i & 1) asm volatile("" ::: "memory"); }
        __syncthreads();
#pragma unroll
        for (int k2 = 0; k2 < 2; ++k2) {
#pragma unroll
            for (int ai = 0; ai < 2; ++ai) {
                bf16x8 At[4];
#pragma unroll
                for (int m = 0; m < 4; ++m) At[m] = *(const LAS bf16x8*)(As + (128 * ai + 64 * wr + 16 * m + fr) * SG_STRIDE + (32 * k2 + 8 * fq) * 2);
#pragma unroll
                for (int bj = 0; bj < 2; ++bj) {
                    bf16x8 Bf[2];
#pragma unroll
                    for (int n = 0; n < 2; ++n) Bf[n] = *(const LAS bf16x8*)(Bs + (128 * bj + 32 * wc + perm32(16 * n + fr)) * SG_STRIDE + (32 * k2 + 8 * fq) * 2);
#pragma unroll
                    for (int m = 0; m < 4; ++m)
#pragma unroll
                        for (int n = 0; n < 2; ++n) acc[ai][bj][m][n] = __builtin_amdgcn_mfma_f32_16x16x32_bf16(Bf[n], At[m], acc[ai][bj][m][n], 0, 0, 0);
                }
            }
        }
    }
    E(acc, u, wr, wc, fr, fq);
}

struct RopeTab { const float *Ac, *As, *Bc, *Bs; };
__device__ __forceinline__ RopeTab rope_tab(const Params& P) { const float* T = (const float*)(P.ws + WS_TAB); return RopeTab{T, T + 1024, T + 2048, T + 2560}; }
__device__ __forceinline__ void rope_pair(f32x4& v0, f32x4& v1, const f32x4 cs, const f32x4 sn) { const f32x4 a = v0 * cs - v1 * sn, b = v1 * cs + v0 * sn; v0 = a; v1 = b; }

struct EpiQKV {
    bf16_t *QA, *KA, *VA, *CQ, *CKV, *KB; float *SSQQ, *SSQKV; RopeTab T; bool dry;
    __device__ __forceinline__ void operator()(const Acc& acc, const Unit& u, int wr, int wc, int fr, int fq) const {
        const int jb = u.pm % 9; const bool lat = jb != 0; const int pn = u.pn;
        if (!lat && (pn < 2 || pn == 6)) return;
#pragma unroll
        for (int ai = 0; ai < 2; ++ai) {
            const int prow = (jb - 1) * 4 + 2 * ai + wr;
#pragma unroll
            for (int m = 0; m < 4; ++m) {
                const int pcol = 16 * m + fr; const size_t grow = (size_t)u.pm * 256 + 128 * ai + 64 * wr + 16 * m + fr;
                if (pn < 4) {
                    bf16_t* dst = (pn < 2 ? QA : KA) + grow * 512 + (pn & 1) * 256 + 32 * wc + 8 * fq;
                    const int pos = (wc & 1) ? pcol : prow;
                    f32x4 cs = {1.f, 1.f, 1.f, 1.f}, sn = {0.f, 0.f, 0.f, 0.f};
                    if (lat) { cs = *(const f32x4*)(T.Ac + pos * 16 + 4 * fq); sn = *(const f32x4*)(T.As + pos * 16 + 4 * fq); }
                    const float qs = (pn < 2) ? QSCALE_A : 1.f;
#pragma unroll
                    for (int bj = 0; bj < 2; ++bj) { f32x4 v0 = acc[ai][bj][m][0] * qs, v1 = acc[ai][bj][m][1] * qs; rope_pair(v0, v1, cs, sn); *(u32x4*)(dst + 128 * bj) = pack8(v0, v1); }
                } else if (pn < 6) {
#pragma unroll
                    for (int bj = 0; bj < 2; ++bj) *(u32x4*)(VA + grow * 512 + (pn - 4) * 256 + 128 * bj + 32 * wc + 8 * fq) = pack8(acc[ai][bj][m][0], acc[ai][bj][m][1]);
                } else if (pn == 6) {
                    float s = 0.f;
#pragma unroll
                    for (int bj = 0; bj < 2; ++bj) { const f32x4 v0 = acc[ai][bj][m][0], v1 = acc[ai][bj][m][1];
                        s += (v0[0] * v0[0] + v0[1] * v0[1]) + (v0[2] * v0[2] + v0[3] * v0[3]) + (v1[0] * v1[0] + v1[1] * v1[1]) + (v1[2] * v1[2] + v1[3] * v1[3]);
                        *(u32x4*)(CQ + grow * 256 + 128 * bj + 32 * wc + 8 * fq) = pack8(v0, v1); }
                    s += __shfl_xor(s, 16); s += __shfl_xor(s, 32);
                    if (fq == 0 && !dry) atomicAdd(SSQQ + grow, s);
                } else {
                    { const f32x4 v0 = acc[ai][0][m][0], v1 = acc[ai][0][m][1];
                      float s = (v0[0] * v0[0] + v0[1] * v0[1]) + (v0[2] * v0[2] + v0[3] * v0[3]) + (v1[0] * v1[0] + v1[1] * v1[1]) + (v1[2] * v1[2] + v1[3] * v1[3]);
                      *(u32x4*)(CKV + grow * 128 + 32 * wc + 8 * fq) = pack8(v0, v1);
                      s += __shfl_xor(s, 16); s += __shfl_xor(s, 32);
                      if (fq == 0 && !dry) atomicAdd(SSQKV + grow, s); }
                    if (wc == 0) {
                        f32x4 v0 = acc[ai][1][m][0], v1 = acc[ai][1][m][1];
                        if (lat) { const int pos = (fq < 2) ? prow : pcol; const f32x4 cs = *(const f32x4*)(T.Bc + pos * 8 + 4 * (fq & 1)), sn = *(const f32x4*)(T.Bs + pos * 8 + 4 * (fq & 1)); rope_pair(v0, v1, cs, sn); }
                        const u32x4 w = pack8(v0, v1);
#pragma unroll
                        for (int h = 0; h < 8; ++h) *(u32x4*)(KB + grow * 768 + h * 96 + 64 + 8 * fq) = w;
                    }
                }
            }
        }
    }
};
struct EpiQup {
    bf16_t* QB; const float* SSQQ; RopeTab T;
    __device__ __forceinline__ void operator()(const Acc& acc, const Unit& u, int wr, int wc, int fr, int fq) const {
        const int jb = u.pm % 9, pn = u.pn;
        float rs[2][4];
#pragma unroll
        for (int ai = 0; ai < 2; ++ai)
#pragma unroll
            for (int m = 0; m < 4; ++m) rs[ai][m] = SSQQ[(size_t)u.pm * 256 + 128 * ai + 64 * wr + 16 * m + fr];
#pragma unroll
        for (int ai = 0; ai < 2; ++ai) {
            const int prow = (jb - 1) * 4 + 2 * ai + wr;
#pragma unroll
            for (int m = 0; m < 4; ++m) {
                const int pcol = 16 * m + fr; const size_t grow = (size_t)u.pm * 256 + 128 * ai + 64 * wr + 16 * m + fr;
                const float rstd = rsqrtf(rs[ai][m] * (1.f / 256.f) + EPS) * QSCALE_B;
#pragma unroll
                for (int bj = 0; bj < 2; ++bj) {
                    f32x4 v0 = acc[ai][bj][m][0] * rstd, v1 = acc[ai][bj][m][1] * rstd;
                    if (pn < 2) { const int c = pn * 256 + 128 * bj + 32 * wc + 8 * fq; *(u32x4*)(QB + grow * 768 + (c >> 6) * 96 + (c & 63)) = pack8(v0, v1); }
                    else { const int h = 4 * bj + wc, pos = (fq < 2) ? prow : pcol;
                        const f32x4 cs = *(const f32x4*)(T.Bc + pos * 8 + 4 * (fq & 1)), sn = *(const f32x4*)(T.Bs + pos * 8 + 4 * (fq & 1)); rope_pair(v0, v1, cs, sn);
                        *(u32x4*)(QB + grow * 768 + h * 96 + 64 + 8 * fq) = pack8(v0, v1); }
                }
                asm volatile("" ::: "memory");
            }
        }
    }
};
struct EpiKVup {
    bf16_t *KB, *VB; const float* SSQKV;
    __device__ __forceinline__ void operator()(const Acc& acc, const Unit& u, int wr, int wc, int fr, int fq) const {
        const int pn = u.pn;
        float rs[2][4];
#pragma unroll
        for (int ai = 0; ai < 2; ++ai)
#pragma unroll
            for (int m = 0; m < 4; ++m) rs[ai][m] = SSQKV[(size_t)u.pm * 256 + 128 * ai + 64 * wr + 16 * m + fr];
#pragma unroll
        for (int ai = 0; ai < 2; ++ai)
#pragma unroll
            for (int m = 0; m < 4; ++m) {
                const size_t grow = (size_t)u.pm * 256 + 128 * ai + 64 * wr + 16 * m + fr;
                const float rstd = rsqrtf(rs[ai][m] * (1.f / 128.f) + EPS);
#pragma unroll
                for (int bj = 0; bj < 2; ++bj) {
                    const f32x4 v0 = acc[ai][bj][m][0] * rstd, v1 = acc[ai][bj][m][1] * rstd;
                    if (pn < 2) { const int c = pn * 256 + 128 * bj + 32 * wc + 8 * fq; *(u32x4*)(KB + grow * 768 + (c >> 6) * 96 + (c & 63)) = pack8(v0, v1); }
                    else *(u32x4*)(VB + grow * 512 + (pn - 2) * 256 + 128 * bj + 32 * wc + 8 * fq) = pack8(v0, v1);
                }
                asm volatile("" ::: "memory");
            }
    }
};
struct EpiOut {
    const float* x; float* out; bf16_t* A2; const float* MOD; float* SSQ2; bool dry;
    __device__ __forceinline__ void operator()(const Acc& acc, const Unit& u, int wr, int wc, int fr, int fq) const {
        const float* mp = MOD + (size_t)(u.pm >> 3) * NADA;
#pragma unroll
        for (int ai = 0; ai < 2; ++ai)
#pragma unroll
            for (int m = 0; m < 4; ++m) {
                const size_t row = (size_t)u.pm * 256 + 128 * ai + 64 * wr + 16 * m + fr; float s = 0.f;
#pragma unroll
                for (int bj = 0; bj < 2; ++bj) {
                    const int col = u.pn * 256 + 128 * bj + 32 * wc + 8 * fq; const size_t off = row * DM + col;
                    f32x4 nv[2];
#pragma unroll
                    for (int n = 0; n < 2; ++n) { const f32x4 ga = *(const f32x4*)(mp + 2 * DM + col + 4 * n), xv = *(const f32x4*)(x + off + 4 * n);
                        nv[n] = xv + ga * acc[ai][bj][m][n]; if (!dry) *(f32x4*)(out + off + 4 * n) = nv[n];
                        s += (nv[n][0] * nv[n][0] + nv[n][1] * nv[n][1]) + (nv[n][2] * nv[n][2] + nv[n][3] * nv[n][3]); }
                    const f32x4 s0 = *(const f32x4*)(mp + 4 * DM + col), s1 = *(const f32x4*)(mp + 4 * DM + col + 4);
                    { const u32x4 pk = pack8(nv[0] * (s0 + 1.f), nv[1] * (s1 + 1.f)); if (!dry) *(u32x4*)(A2 + off) = pk; else asm volatile("" :: "v"(pk)); }
                }
                s += __shfl_xor(s, 16); s += __shfl_xor(s, 32);
                if (fq == 0 && !dry) atomicAdd(SSQ2 + row, s);
            }
    }
};
struct EpiFfnIn {
    bf16_t* G; const float* SSQ2; const float* BIASF;
    __device__ __forceinline__ void operator()(const Acc& acc, const Unit& u, int wr, int wc, int fr, int fq) const {
        const float* bp = BIASF + (size_t)(u.pm >> 3) * (2 * FFH); const int hc = u.pn * 128 + 32 * wc + 8 * fq;
        f32x4 bg[2], bu[2];
#pragma unroll
        for (int n = 0; n < 2; ++n) { bg[n] = *(const f32x4*)(bp + hc + 4 * n); bu[n] = *(const f32x4*)(bp + FFH + hc + 4 * n); }
        float rs[2][4];
#pragma unroll
        for (int ai = 0; ai < 2; ++ai)
#pragma unroll
            for (int m = 0; m < 4; ++m) rs[ai][m] = SSQ2[(size_t)u.pm * 256 + 128 * ai + 64 * wr + 16 * m + fr];
#pragma unroll
        for (int ai = 0; ai < 2; ++ai)
#pragma unroll
            for (int m = 0; m < 4; ++m) {
                const size_t row = (size_t)u.pm * 256 + 128 * ai + 64 * wr + 16 * m + fr;
                const float rstd = rsqrtf(rs[ai][m] * (1.f / DM) + EPS);
                f32x4 o[2];
#pragma unroll
                for (int n = 0; n < 2; ++n) { const f32x4 g = acc[ai][0][m][n] * rstd + bg[n], up = acc[ai][1][m][n] * rstd + bu[n];
#pragma unroll
                    for (int j = 0; j < 4; ++j) o[n][j] = silu_f(g[j]) * up[j]; }
                *(u32x4*)(G + row * FFH + hc) = pack8(o[0], o[1]);
            }
    }
};
struct EpiFfnOut {
    float* out; const float* MOD; bool dry;
    __device__ __forceinline__ void operator()(const Acc& acc, const Unit& u, int wr, int wc, int fr, int fq) const {
        const float* mp = MOD + (size_t)(u.pm >> 3) * NADA + 5 * DM;
#pragma unroll
        for (int ai = 0; ai < 2; ++ai)
#pragma unroll
            for (int m = 0; m < 4; ++m) {
                const size_t row = (size_t)u.pm * 256 + 128 * ai + 64 * wr + 16 * m + fr;
#pragma unroll
                for (int bj = 0; bj < 2; ++bj)
#pragma unroll
                    for (int n = 0; n < 2; ++n) { const int col = u.pn * 256 + 128 * bj + 32 * wc + 8 * fq + 4 * n; const size_t off = row * DM + col;
                        const f32x4 gf = *(const f32x4*)(mp + col), nl = *(const f32x4*)(out + off); const f32x4 yv = nl + gf * acc[ai][bj][m][n]; if (!dry) *(f32x4*)(out + off) = yv; else asm volatile("" :: "v"(yv)); }
            }
    }
};


namespace pg8 {
constexpr int BK = 64, HALF = 128, HTB = HALF * BK * 2, STAGE_BYTES = 8 * HTB;
__device__ __forceinline__ int lds_byte(int r, int c) { const int st = (r >> 4) * 2 + (c >> 5), rr = r & 15, cc = c & 31, ob = rr * 64 + cc * 2; return st * 1024 + (ob ^ (((ob >> 9) & 1) << 5)); }
__device__ __forceinline__ void stage_rc(int b, int& R, int& C) { const int st = b / 1024, sb = b % 1024, swz = sb ^ (((sb >> 9) & 1) << 5); R = (st >> 1) * 16 + swz / 64; C = (st & 1) * 32 + (swz % 64) / 2; }
struct Gemm { const bf16_t* A; const bf16_t* Bt; int K; };
template <class Epi, class Sched>
__device__ __forceinline__ void gemm_phase(LAS unsigned char* lds, const Gemm g, const Sched& S, const Epi& E) {
    const int tid = threadIdx.x, wid = __builtin_amdgcn_readfirstlane(tid >> 6), lane = tid & 63, wr = wid >> 2, wc = wid & 3, fr = lane & 15, fq = lane >> 4;
    const int K = g.K, nt = K / BK;
    unsigned voffA[2], voffB[2];
#pragma unroll
    for (int i = 0; i < 2; ++i) { int R, C; stage_rc(tid * 16 + i * 8192, R, C); const int Rb = (R & ~31) + perm32(R & 31);
        voffA[i] = (unsigned)(R * K + C) * 2u; voffB[i] = (unsigned)(Rb * K + C) * 2u; }
    const size_t kstep = (size_t)(BK * 2);
    const size_t hstep = (size_t)HALF * K * 2;
    const size_t tstep = 2 * hstep;
    const unsigned ldsw = (unsigned)wid * 1024u;
    const int aoff = lds_byte(wr * 64 + fr, fq * 8), boff = lds_byte(wc * 32 + fr, fq * 8);
#define PG8_SA(b, h) (((b) * 2 + (h)) * HTB)
#define PG8_SB(b, h) ((4 + (b) * 2 + (h)) * HTB)
#define PG8_STAGE(bufoff, gbase, voff) do { _Pragma("unroll") for (int _i = 0; _i < 2; ++_i) \
        __builtin_amdgcn_global_load_lds((const unsigned*)((const char*)(gbase) + (voff)[_i]), (LAS unsigned*)(lds + (bufoff) + ldsw + _i * 8192), 16, 0, 0); } while (0)
#define PG8_LDA(dst, b, h) do { _Pragma("unroll") for (int m = 0; m < 4; ++m) _Pragma("unroll") for (int k = 0; k < 2; ++k) dst[m][k] = *(const LAS bf16x8*)(lds + PG8_SA(b, h) + aoff + m * 2048 + k * 1024); } while (0)
#define PG8_LDB(dst, b, h) do { _Pragma("unroll") for (int n = 0; n < 2; ++n) _Pragma("unroll") for (int k = 0; k < 2; ++k) dst[n][k] = *(const LAS bf16x8*)(lds + PG8_SB(b, h) + boff + n * 2048 + k * 1024); } while (0)
#define PG8_MMA(ai, bj, At, Bt) do { __builtin_amdgcn_s_setprio(1); _Pragma("unroll") for (int m = 0; m < 4; ++m) _Pragma("unroll") for (int n = 0; n < 2; ++n) _Pragma("unroll") for (int k = 0; k < 2; ++k) \
        acc[ai][bj][m][n] = __builtin_amdgcn_mfma_f32_16x16x32_bf16(Bt[n][k], At[m][k], acc[ai][bj][m][n], 0, 0, 0); __builtin_amdgcn_s_setprio(0); } while (0)
#define PG8_WAIT_V(n) asm volatile("s_waitcnt vmcnt(" #n ")" ::: "memory")
#define PG8_WAIT_L(n) asm volatile("s_waitcnt lgkmcnt(" #n ")" ::: "memory")
#define PG8_BAR __builtin_amdgcn_s_barrier()
#define PG8_SCHED __builtin_amdgcn_sched_barrier(0)
    Unit cur, nxt; int ui = 0;
    if (!S.next(0, cur)) return;
    f32x4 acc[2][2][4][2];
#pragma unroll
    for (int a = 0; a < 2; ++a)
#pragma unroll
        for (int b = 0; b < 2; ++b)
#pragma unroll
            for (int m = 0; m < 4; ++m)
#pragma unroll
                for (int n = 0; n < 2; ++n) acc[a][b][m][n] = (f32x4){0.f, 0.f, 0.f, 0.f};
    bf16x8 At[4][2], B0[2][2], B1[2][2];
    const char* cA = (const char*)g.A + (size_t)cur.pm * tstep; const char* cB = (const char*)g.Bt + (size_t)cur.pn * tstep;
    PG8_STAGE(PG8_SB(0, 0), cB, voffB); PG8_STAGE(PG8_SB(0, 1), cB + hstep, voffB); PG8_STAGE(PG8_SA(0, 0), cA, voffA); PG8_STAGE(PG8_SA(0, 1), cA + hstep, voffA);
    if (wr == 1) PG8_BAR;
    PG8_WAIT_V(2); PG8_BAR;
    PG8_STAGE(PG8_SB(1, 0), cB + kstep, voffB); PG8_STAGE(PG8_SA(1, 0), cA + kstep, voffA); PG8_STAGE(PG8_SB(1, 1), cB + hstep + kstep, voffB);
    PG8_WAIT_V(6); PG8_BAR;
    for (;;) {
        const bool has_next = S.next(ui + 1, nxt);
        const char* nA = has_next ? (const char*)g.A + (size_t)nxt.pm * tstep : cA; const char* nB = has_next ? (const char*)g.Bt + (size_t)nxt.pn * tstep : cB;
        for (int t = 0; t < nt; t += 2) {
            const bool last = (t == nt - 2);
            const char* a1 = cA + (size_t)(t + 1) * kstep;
            const char* a2 = last ? nA : cA + (size_t)(t + 2) * kstep; const char* b2 = last ? nB : cB + (size_t)(t + 2) * kstep;
            const char* a3 = a2 + kstep; const char* b3 = b2 + kstep;
            PG8_LDB(B0, 0, 0); PG8_LDB(B1, 0, 1); PG8_SCHED; PG8_LDA(At, 0, 0); PG8_STAGE(PG8_SA(1, 1), a1 + hstep, voffA);
            PG8_WAIT_V(8); PG8_WAIT_L(0); PG8_BAR; PG8_MMA(0, 0, At, B0); PG8_MMA(0, 1, At, B1); PG8_BAR; PG8_SCHED;
            PG8_LDA(At, 0, 1); PG8_STAGE(PG8_SB(0, 0), b2, voffB); PG8_STAGE(PG8_SB(0, 1), b2 + hstep, voffB); PG8_STAGE(PG8_SA(0, 0), a2, voffA);
            PG8_WAIT_V(8); PG8_WAIT_L(0); PG8_BAR; PG8_MMA(1, 0, At, B0); PG8_MMA(1, 1, At, B1); PG8_BAR; PG8_SCHED;
            PG8_LDB(B0, 1, 0); PG8_LDB(B1, 1, 1); PG8_SCHED; PG8_LDA(At, 1, 0); PG8_STAGE(PG8_SA(0, 1), a2 + hstep, voffA);
            PG8_WAIT_V(8); PG8_WAIT_L(0); PG8_BAR; PG8_MMA(0, 0, At, B0); PG8_MMA(0, 1, At, B1); PG8_BAR; PG8_SCHED;
            PG8_LDA(At, 1, 1); PG8_STAGE(PG8_SB(1, 0), b3, voffB); PG8_STAGE(PG8_SB(1, 1), b3 + hstep, voffB); PG8_STAGE(PG8_SA(1, 0), a3, voffA);
            PG8_WAIT_V(8); PG8_WAIT_L(0); PG8_BAR; PG8_MMA(1, 0, At, B0); PG8_MMA(1, 1, At, B1); PG8_BAR; PG8_SCHED;
        }
        if (wr == 0) PG8_BAR;
        E(acc, cur, wr, wc, fr, fq);
        if (!has_next) break;
#pragma unroll
        for (int a = 0; a < 2; ++a)
#pragma unroll
            for (int b = 0; b < 2; ++b)
#pragma unroll
                for (int m = 0; m < 4; ++m)
#pragma unroll
                    for (int n = 0; n < 2; ++n) acc[a][b][m][n] = (f32x4){0.f, 0.f, 0.f, 0.f};
        cur = nxt; cA = nA; cB = nB; ++ui;
        if (wr == 1) PG8_BAR;
    }
    PG8_WAIT_V(0);
    PG8_BAR;
#undef PG8_SA
#undef PG8_SB
#undef PG8_STAGE
#undef PG8_LDA
#undef PG8_LDB
#undef PG8_MMA
#undef PG8_WAIT_V
#undef PG8_WAIT_L
#undef PG8_BAR
#undef PG8_SCHED
}
}

#define SBAR() __builtin_amdgcn_sched_barrier(0)
__device__ __forceinline__ int crow(int r, int hi) { return (r & 3) + 8 * (r >> 2) + 4 * hi; }
constexpr float ATT_THR = 8.f;
constexpr float ATT_THRL = 11.5f;
template <bool FIRST>
__device__ __forceinline__ void partialSM(f32x16& p0, f32x16& p1, float& mhat, f32x16& negm, float& alpha) {
    float a = fmaxf(fmaxf(p0[0], p0[1]), p1[0]), b = fmaxf(fmaxf(p0[2], p0[3]), p1[1]); a = fmaxf(fmaxf(a, p1[2]), p1[3]);
#pragma unroll
    for (int r = 4; r < 16; r += 4) { a = fmaxf(fmaxf(a, p0[r]), p0[r + 1]); b = fmaxf(fmaxf(b, p0[r + 2]), p0[r + 3]); a = fmaxf(fmaxf(a, p1[r]), p1[r + 1]); b = fmaxf(fmaxf(b, p1[r + 2]), p1[r + 3]); }
    float rm = fmaxf(a, b);
    { auto rr = __builtin_amdgcn_permlane32_swap(__float_as_uint(rm), __float_as_uint(rm), false, false);
      rm = fmaxf(__uint_as_float(rr[0]), __uint_as_float(rr[1])); }
    alpha = 1.f;
    if (FIRST || __builtin_expect(__any(rm > ATT_THRL), 0)) {
        const float dl = FIRST ? rm : fmaxf(rm, 0.f); mhat += dl;
#pragma unroll
        for (int r = 0; r < 16; ++r) { p0[r] -= dl; p1[r] -= dl; }
#pragma unroll
        for (int r = 0; r < 16; ++r) negm[r] = -mhat;
        alpha = __builtin_amdgcn_exp2f(-dl);
    }
#pragma unroll
    for (int r = 0; r < 16; ++r) p0[r] = __builtin_amdgcn_exp2f(p0[r]);
}
__device__ __forceinline__ void finishSM(f32x16& p0, f32x16& p1, float alpha, float& l_reg, bf16x8& pa0, bf16x8& pa1, bf16x8& pa2, bf16x8& pa3) {
#pragma unroll
    for (int r = 0; r < 16; ++r) p1[r] = __builtin_amdgcn_exp2f(p1[r]);
    float ps = 0;
#pragma unroll
    for (int r = 0; r < 16; ++r) ps += p0[r];
#pragma unroll
    for (int r = 0; r < 16; ++r) ps += p1[r];
    { auto rr = __builtin_amdgcn_permlane32_swap(__float_as_uint(ps), __float_as_uint(ps), false, false);
      ps = __uint_as_float(rr[0]) + __uint_as_float(rr[1]); }
    l_reg = l_reg * alpha + ps;
#define PK4(P, BASE, OUT) do { unsigned a0 = cvtpk(P[BASE + 0], P[BASE + 1]), a1 = cvtpk(P[BASE + 2], P[BASE + 3]);   \
    unsigned b0 = cvtpk(P[BASE + 4], P[BASE + 5]), b1 = cvtpk(P[BASE + 6], P[BASE + 7]);                              \
    auto r0 = __builtin_amdgcn_permlane32_swap(a0, b0, false, false); auto r1 = __builtin_amdgcn_permlane32_swap(a1, b1, false, false); \
    u32x4 w = {r0[0], r1[0], r0[1], r1[1]}; OUT = __builtin_bit_cast(bf16x8, w); } while (0)
    PK4(p0, 0, pa0); PK4(p0, 8, pa1); PK4(p1, 0, pa2); PK4(p1, 8, pa3);
#undef PK4
}
template <int DQK>
__device__ __forceinline__ void qkt(f32x16& p0, f32x16& p1, const char* Ks, const bf16x8* qr, const f32x16& negm, int r32, int hi) {
    const char* kb = Ks + hi * 1024 + r32 * 16;
#pragma unroll
    for (int d0 = 0; d0 < DQK / 16; ++d0) {
        const bf16x8 b0 = *reinterpret_cast<const bf16x8*>(kb + d0 * 2048);
        const bf16x8 b1 = *reinterpret_cast<const bf16x8*>(kb + d0 * 2048 + 512);
        if (d0 == 0) { p0 = __builtin_amdgcn_mfma_f32_32x32x16_bf16(b0, qr[0], negm, 0, 0, 0); p1 = __builtin_amdgcn_mfma_f32_32x32x16_bf16(b1, qr[0], negm, 0, 0, 0); }
        else { p0 = __builtin_amdgcn_mfma_f32_32x32x16_bf16(b0, qr[d0], p0, 0, 0, 0); p1 = __builtin_amdgcn_mfma_f32_32x32x16_bf16(b1, qr[d0], p1, 0, 0, 0); } }
}
template <int DV> __device__ __forceinline__ int v_st(int k, int c) { const int kk = (k & ~0xC) | ((k & 4) << 1) | ((k & 8) >> 1); return ((kk >> 3) * (DV / 32) + (c >> 5)) * 512 + ((kk & 7) * 32 + (c & 31)) * 2; }
__device__ __forceinline__ int v_rd_base(int lane) { return ((lane & 3) << 3) | (((lane >> 2) & 3) << 6) | (((lane >> 4) & 1) << 5) | (((lane >> 5) & 1) << 8); }
template <int OFF> __device__ __forceinline__ s16x4 tr_read(int vb) {
    s16x4 r; asm volatile("ds_read_b64_tr_b16 %0, %1 offset:%2" : "=&v"(r) : "v"(vb), "i"(OFF) : "memory"); return r;
}
template <int DV, int D0> __device__ __forceinline__ void pv_one(f32x16& od, int vb, bf16x8 pa0, bf16x8 pa1, bf16x8 pa2, bf16x8 pa3) {
    constexpr int KS = 2 * (DV / 32) * 512, HF = (DV / 32) * 512, B0 = D0 * 512;
    const s16x4 l0 = tr_read<B0>(vb), h0 = tr_read<B0 + HF>(vb), l1 = tr_read<B0 + KS>(vb), h1 = tr_read<B0 + KS + HF>(vb);
    const s16x4 l2 = tr_read<B0 + 2 * KS>(vb), h2 = tr_read<B0 + 2 * KS + HF>(vb), l3 = tr_read<B0 + 3 * KS>(vb), h3 = tr_read<B0 + 3 * KS + HF>(vb);
    asm volatile("s_waitcnt lgkmcnt(0)" ::: "memory"); SBAR();
#define PK(L, H) (bf16x8){L[0], L[1], L[2], L[3], H[0], H[1], H[2], H[3]}
    od = __builtin_amdgcn_mfma_f32_32x32x16_bf16(pa0, PK(l0, h0), od, 0, 0, 0);
    od = __builtin_amdgcn_mfma_f32_32x32x16_bf16(pa1, PK(l1, h1), od, 0, 0, 0);
    od = __builtin_amdgcn_mfma_f32_32x32x16_bf16(pa2, PK(l2, h2), od, 0, 0, 0);
    od = __builtin_amdgcn_mfma_f32_32x32x16_bf16(pa3, PK(l3, h3), od, 0, 0, 0);
#undef PK
}
template <int DV> __device__ __forceinline__ void pv_all(f32x16* o, int vb, bf16x8 pa0, bf16x8 pa1, bf16x8 pa2, bf16x8 pa3) {
    pv_one<DV, 0>(o[0], vb, pa0, pa1, pa2, pa3); pv_one<DV, 1>(o[1], vb, pa0, pa1, pa2, pa3);
    if constexpr (DV == 128) { pv_one<DV, 2>(o[2], vb, pa0, pa1, pa2, pa3); pv_one<DV, 3>(o[3], vb, pa0, pa1, pa2, pa3); }
}
template <int DQK, int DV>
__device__ __forceinline__ void attn_pass(const bf16_t* __restrict__ Qb, int ldq, const bf16_t* __restrict__ Kh, int ldk, const bf16_t* __restrict__ Vh, int ldv, int seq, LAS unsigned char* ldsl, f32x16* o) {
    constexpr int KPC = DQK / 8, KBYTES = KPC * 1024, VBYTES = 64 * DV * 2, VPC = VBYTES / 1024, SLOTB = KBYTES + VBYTES, NSLOT = 4, ND = DV / 32, NC = DV / 32;
    static_assert(KPC >= 8 && KPC <= 16 && (VPC == 8 || VPC == 16), "piece assignment");
    char* lds = (char*)ldsl;
    const int tid = threadIdx.x, wid = __builtin_amdgcn_readfirstlane(tid >> 6), lane = tid & 63, r32 = lane & 31, hi = lane >> 5;
    float* wsf = (float*)(lds + NSLOT * SLOTB) + wid * 64; float* li_l = wsf; float* al_l = wsf + 32;
    float mhat = 0.f, l_reg = 0; f32x16 negm = f32x16{}; bf16x8 qr[DQK / 16];
#pragma unroll
    for (int d = 0; d < ND; ++d) o[d] = f32x16{};
    const bool k1v = (8 + wid) < KPC;
    const unsigned koff0 = (unsigned)(lane * ldk + wid * 8) * 2u, koff1 = (unsigned)(lane * ldk + (8 + wid) * 8) * 2u;
    unsigned voff[2];
#pragma unroll
    for (int i = 0; i < 2; ++i) { const int p = wid + 8 * i, st = 2 * p + (lane >> 5), kgrp = st / NC, cblk = st % NC, kk = kgrp * 8 + ((lane >> 2) & 7);
        const int k = (kk & ~0xC) | ((kk & 4) << 1) | ((kk & 8) >> 1); voff[i] = (unsigned)(k * ldv + cblk * 32 + (lane & 3) * 8) * 2u; }
#define GLDS(src, dstoff) __builtin_amdgcn_global_load_lds((const unsigned*)(src), (LAS unsigned*)(ldsl + (dstoff)), 16, 0, 0)
#define DMA(t, slot) do { const char* kb_ = (const char*)Kh + (size_t)(t) * 64 * ldk * 2; const char* vb_ = (const char*)Vh + (size_t)(t) * 64 * ldv * 2; const int so_ = (slot) * SLOTB; \
    GLDS(kb_ + koff0, so_ + wid * 1024); if (KPC > 8) { if (k1v) GLDS(kb_ + koff1, so_ + (8 + wid) * 1024); } \
    GLDS(vb_ + voff[0], so_ + KBYTES + wid * 1024); if (VPC == 16) GLDS(vb_ + voff[1], so_ + KBYTES + (8 + wid) * 1024); } while (0)
#define WAIT_V(n) asm volatile("s_waitcnt vmcnt(" #n ")" ::: "memory")
#define WAIT_1T() do { if (KPC > 8 && !k1v) WAIT_V(2); else WAIT_V(3); } while (0)
#define WAIT_2T() do { if (KPC > 8 && !k1v) WAIT_V(4); else WAIT_V(6); } while (0)
#define BAR() __builtin_amdgcn_s_barrier()
    DMA(0, 0); DMA(1, 1); DMA(2, 2);
    const bf16_t* Qw = Qb + (size_t)(wid * 32 + r32) * ldq + hi * 8;
#pragma unroll
    for (int d0 = 0; d0 < DQK / 16; ++d0) qr[d0] = *reinterpret_cast<const bf16x8*>(Qw + d0 * 16);
    const int vb0 = (int)(uintptr_t)(lds + KBYTES) + v_rd_base(lane);
#define RESC(a) do { if (__any((a) < 1.f)) { if (hi == 0) al_l[r32] = (a); asm volatile("s_waitcnt lgkmcnt(0)" ::: "memory"); \
    _Pragma("unroll") for (int d = 0; d < ND; ++d) _Pragma("unroll") for (int r = 0; r < 16; ++r) o[d][r] *= al_l[crow(r, hi)]; } } while (0)
    f32x16 pA0, pA1, pB0, pB1; float alA, alB; bf16x8 pa0, pa1, pa2, pa3; const int NT = seq / 64;
    WAIT_2T(); BAR();
    qkt<DQK>(pA0, pA1, lds, qr, negm, r32, hi); partialSM<true>(pA0, pA1, mhat, negm, alA);
    WAIT_1T(); BAR();
    int sl = 1;
    for (int j = 1; j + 1 < NT; j += 2) {
        if (j + 2 < NT) DMA(j + 2, (sl + 2) & 3);
        SBAR(); qkt<DQK>(pB0, pB1, lds + sl * SLOTB, qr, negm, r32, hi);
        finishSM(pA0, pA1, alA, l_reg, pa0, pa1, pa2, pa3); SBAR();
        pv_all<DV>(o, vb0 + ((sl + 3) & 3) * SLOTB, pa0, pa1, pa2, pa3); partialSM<false>(pB0, pB1, mhat, negm, alB);
        RESC(alB);
        if (j + 2 < NT) WAIT_1T(); else WAIT_V(0);
        BAR();
        if (j + 3 < NT) DMA(j + 3, (sl + 3) & 3);
        SBAR(); qkt<DQK>(pA0, pA1, lds + ((sl + 1) & 3) * SLOTB, qr, negm, r32, hi);
        finishSM(pB0, pB1, alB, l_reg, pa0, pa1, pa2, pa3); SBAR();
        pv_all<DV>(o, vb0 + sl * SLOTB, pa0, pa1, pa2, pa3); partialSM<false>(pA0, pA1, mhat, negm, alA);
        RESC(alA);
        if (j + 3 < NT) WAIT_1T(); else WAIT_V(0);
        BAR();
        sl = (sl + 2) & 3;
    }
    SBAR(); qkt<DQK>(pB0, pB1, lds + sl * SLOTB, qr, negm, r32, hi);
    finishSM(pA0, pA1, alA, l_reg, pa0, pa1, pa2, pa3); SBAR();
    pv_all<DV>(o, vb0 + ((sl + 3) & 3) * SLOTB, pa0, pa1, pa2, pa3); partialSM<false>(pB0, pB1, mhat, negm, alB);
    RESC(alB);
    finishSM(pB0, pB1, alB, l_reg, pa0, pa1, pa2, pa3); SBAR();
    pv_all<DV>(o, vb0 + sl * SLOTB, pa0, pa1, pa2, pa3);
    if (hi == 0) li_l[r32] = l_reg; asm volatile("s_waitcnt lgkmcnt(0)" ::: "memory");
#pragma unroll
    for (int r = 0; r < 16; ++r) { const float rl = __builtin_amdgcn_rcpf(li_l[crow(r, hi)]);
#pragma unroll
        for (int d = 0; d < ND; ++d) o[d][r] *= rl; }
    __syncthreads();
#undef GLDS
#undef DMA
#undef WAIT_V
#undef WAIT_1T
#undef WAIT_2T
#undef BAR
#undef RESC
}

constexpr int OT_STRIDE = 132;
template <int ND> __device__ __forceinline__ void o_to_lds(const f32x16* o, LAS float* T, int r32, int hi) {
#pragma unroll
    for (int d = 0; d < ND; ++d)
#pragma unroll
        for (int r = 0; r < 16; ++r) T[crow(r, hi) * OT_STRIDE + d * 32 + r32] = o[d][r];
    asm volatile("s_waitcnt lgkmcnt(0)" ::: "memory");
}
__device__ __forceinline__ void attn_phase(const Params& P, const Frame& F) {
    const bf16_t* QA = (const bf16_t*)(P.ws + WS_QA); const bf16_t* KA = (const bf16_t*)(P.ws + WS_KA); const bf16_t* VA = (const bf16_t*)(P.ws + WS_VA);
    const bf16_t* QB = (const bf16_t*)(P.ws + WS_QB); const bf16_t* KB = (const bf16_t*)(P.ws + WS_KB); const bf16_t* VB = (const bf16_t*)(P.ws + WS_VB);
    bf16_t* CAT = (bf16_t*)(P.ws + WS_CAT);
    float* SCR = (float*)(P.ws + WS_SCR) + ((size_t)F.bid * NWAVES + F.wave) * 4096;
    const float lam = *(const float*)(P.ws + WS_LAM);
    const int vcu = (F.G % 8 == 0) ? (F.bid % 8) * (F.G / 8) + F.bid / 8 : F.bid;
    const int r32 = F.lane & 31, hi = F.lane >> 5, erow = F.lane >> 1, ehalf = F.lane & 1;
    LAS float* T = (LAS float*)(F.lds + F.wave * (32 * OT_STRIDE * 4));
    int u = vcu;
    for (; u < 512; u += F.G) {
        {
            const int b = u >> 5, h = (u >> 3) & 3, qb = u & 7;
            const size_t krow0 = (size_t)b * TPB, qrow0 = krow0 + CTXL + qb * 256;
            { f32x16 o[4];
              attn_pass<64, 128>(QA + qrow0 * 512 + h * 128, 512, KA + krow0 * 512 + h * 128, 512, VA + krow0 * 512 + h * 128, 512, TPB, F.lds, o);
              o_to_lds<4>(o, T, r32, hi); }
#pragma unroll 4
            for (int q = 0; q < 16; ++q) *(f32x4*)(SCR + erow * 128 + ehalf * 64 + 4 * q) = *(const LAS f32x4*)(T + erow * OT_STRIDE + ehalf * 64 + 4 * q);
            __syncthreads();
            { f32x16 o[4];
              attn_pass<64, 128>(QA + qrow0 * 512 + h * 128 + 64, 512, KA + krow0 * 512 + h * 128 + 64, 512, VA + krow0 * 512 + h * 128, 512, TPB, F.lds, o);
              o_to_lds<4>(o, T, r32, hi); }
            float ss = 0.f;
#pragma unroll 4
            for (int q = 0; q < 16; ++q) { LAS f32x4* tp = (LAS f32x4*)(T + erow * OT_STRIDE + ehalf * 64 + 4 * q);
                const f32x4 cv = *(const f32x4*)(SCR + erow * 128 + ehalf * 64 + 4 * q) - *tp * lam; *tp = cv;
                ss += (cv[0] * cv[0] + cv[1] * cv[1]) + (cv[2] * cv[2] + cv[3] * cv[3]); }
            ss += __shfl_xor(ss, 1);
            const float rstd = rsqrtf(ss * (1.f / 128.f) + EPS) * 0.8f;
            asm volatile("s_waitcnt lgkmcnt(0)" ::: "memory");
            bf16_t* dst = CAT + ((size_t)b * SEQ + qb * 256 + F.wave * 32 + erow) * DM + h * 128 + ehalf * 64;
#pragma unroll 2
            for (int q = 0; q < 8; ++q) { const LAS f32x4* tp = (const LAS f32x4*)(T + erow * OT_STRIDE + ehalf * 64 + 8 * q);
                const f32x4 g0 = *(const f32x4*)(P.diff_subln + ehalf * 64 + 8 * q), g1 = *(const f32x4*)(P.diff_subln + ehalf * 64 + 8 * q + 4);
                *(u32x4*)(dst + 8 * q) = pack8(tp[0] * g0 * rstd, tp[1] * g1 * rstd); }
            __syncthreads();
        }
    }
    for (; u < 1536; u += F.G) {
        {
            const int v = u - 512, b = v >> 6, h = (v >> 3) & 7, qb = v & 7;
            const size_t krow0 = (size_t)b * TPB, qrow0 = krow0 + CTXL + qb * 256;
            { f32x16 o[2];
              attn_pass<96, 64>(QB + qrow0 * 768 + h * 96, 768, KB + krow0 * 768 + h * 96, 768, VB + krow0 * 512 + h * 64, 512, TPB, F.lds, o);
              o_to_lds<2>(o, T, r32, hi); }
            bf16_t* dst = CAT + ((size_t)b * SEQ + qb * 256 + F.wave * 32 + erow) * DM + 512 + h * 64 + ehalf * 32;
#pragma unroll
            for (int q = 0; q < 4; ++q) { const LAS f32x4* tp = (const LAS f32x4*)(T + erow * OT_STRIDE + ehalf * 32 + 8 * q); *(u32x4*)(dst + 8 * q) = pack8(tp[0], tp[1]); }
            __syncthreads();
        }
    }
}

__device__ __forceinline__ void p8_phase(const Params& P, const Frame& F) {
    float chk = 1.f;
#if MK_CHECK
    { const unsigned* BAD = (const unsigned*)(P.ws + WS_LAM) + 16; chk = 1.f + 0.1f * (float)((BAD[0] ? 1 : 0) + (BAD[1] ? 2 : 0)); }
#endif
    for (int r = F.gwi; r < MLAT; r += F.ngw) {
        float* row = P.out + (size_t)r * DM; f32x4 v[4]; float s = 0.f;
#pragma unroll
        for (int j = 0; j < 4; ++j) { v[j] = *(const f32x4*)(row + 4 * F.lane + 256 * j); s += (v[j].x * v[j].x + v[j].y * v[j].y) + (v[j].z * v[j].z + v[j].w * v[j].w); }
        const float rstd = rsqrtf(wave_sum(s) * (1.f / DM) + EPS);
#pragma unroll
        for (int j = 0; j < 4; ++j) { const f32x4 g = *(const f32x4*)(P.final_norm + 4 * F.lane + 256 * j); const f32x4 ov = v[j] * (rstd * chk) * g; if (!F.dry) *(f32x4*)(row + 4 * F.lane + 256 * j) = ov; else asm volatile("" :: "v"(ov)); }
    }
}


#define XB_TMO      128
#define XB_XCNT(j)  (256  + 64 * (j))
#define XB_XSUB(j)  (1280 + 64 * (j))
#define XB_XGEN(j)  (2304 + 64 * (j))
#define XB_TOP      3328
#define XB_TOPGEN   3392
#define XCD_BAR_WORDS 3456
#define XB_SPIN_CAP (1u << 20)
__device__ __forceinline__ unsigned xb_ld(unsigned* p)              { return __hip_atomic_load(p, __ATOMIC_RELAXED, __HIP_MEMORY_SCOPE_AGENT); }
__device__ __forceinline__ unsigned xb_add(unsigned* p, unsigned v) { return __hip_atomic_fetch_add(p, v, __ATOMIC_RELAXED, __HIP_MEMORY_SCOPE_AGENT); }
__device__ __forceinline__ unsigned xb_xcc_id() { return (unsigned)__builtin_amdgcn_s_getreg((3 << 11) | 20) & 0xFu; }
#define XB_SPIN(cond, bar) do { unsigned _sp = 0; while (cond) { __builtin_amdgcn_s_sleep(1); \
    if ((++_sp & 255u) == 0u) { if (xb_ld(&(bar)[XB_TMO])) break; if (_sp > XB_SPIN_CAP) { atomicAdd(&(bar)[XB_TMO], 1u); break; } } } } while (0)
struct XcdBarrier { unsigned* bar; unsigned x; volatile LAS unsigned* st; };
__device__ __forceinline__ XcdBarrier xcd_barrier_post(unsigned* bar, volatile LAS unsigned* st) {
    XcdBarrier b; b.bar = bar; b.x = xb_xcc_id(); b.st = st;
    if (threadIdx.x == 0) (void)xb_add(&bar[XB_XCNT(b.x)], 1u);
    return b;
}
__device__ __forceinline__ void xcd_barrier_complete(unsigned* bar, unsigned x, unsigned& nloc, unsigned& nx) {
    const unsigned G = gridDim.x * gridDim.y * gridDim.z;
    unsigned sum, cnt, mine, sp = 0u;
    for (;;) {
        sum = 0u; cnt = 0u; mine = 0u;
#pragma unroll
        for (unsigned j = 0; j < 16; ++j) { const unsigned c = xb_ld(&bar[XB_XCNT(j)]); sum += c; cnt += (c > 0u) ? 1u : 0u; mine = (j == x) ? c : mine; }
        if (sum == G) break;
        __builtin_amdgcn_s_sleep(1);
        if ((++sp & 255u) == 0u) { if (xb_ld(&bar[XB_TMO])) break; if (sp > XB_SPIN_CAP) { atomicAdd(&bar[XB_TMO], 1u); break; } }
    }
    nloc = mine > 0u ? mine : 1u; nx = cnt > 0u ? cnt : 1u;
}
__device__ __forceinline__ void xcd_barrier(const XcdBarrier& b) {
    asm volatile("s_waitcnt vmcnt(0)" ::: "memory");
    __syncthreads();
    if (threadIdx.x == 0) {
        unsigned* bar = b.bar;
        __builtin_amdgcn_s_waitcnt(0);
        unsigned nloc = b.st[0], nx = b.st[1];
        if (nloc == 0u) { xcd_barrier_complete(bar, b.x, nloc, nx); b.st[0] = nloc; b.st[1] = nx; }
        const unsigned old = xb_add(&bar[XB_XSUB(b.x)], 1u);
        const unsigned gen = old / nloc;
        if (old + 1u == (gen + 1u) * nloc) {
            __builtin_amdgcn_fence(__ATOMIC_RELEASE, "agent");
            asm volatile("s_waitcnt vmcnt(0)" ::: "memory");
            const unsigned og = xb_add(&bar[XB_TOP], 1u);
            const unsigned tg = og / nx;
            if (og + 1u == (tg + 1u) * nx) xb_add(&bar[XB_TOPGEN], 1u);
            else XB_SPIN(xb_ld(&bar[XB_TOPGEN]) == tg, bar);
            __builtin_amdgcn_fence(__ATOMIC_ACQUIRE, "agent");
            xb_add(&bar[XB_XGEN(b.x)], 1u);
            asm volatile("s_waitcnt vmcnt(0)" ::: "memory");
        } else {
            XB_SPIN(xb_ld(&bar[XB_XGEN(b.x)]) == gen, bar);
            __builtin_amdgcn_fence(__ATOMIC_ACQUIRE, "agent");
            asm volatile("s_waitcnt vmcnt(0)" ::: "memory");
        }
    }
    __syncthreads();
}

#ifndef MK_FUSED
#define MK_FUSED 1
#endif
#ifndef MK_REP_MASK
#define MK_REP_MASK 0
#endif
#ifndef MK_CHECK
#define MK_CHECK 0
#endif
#ifndef MK_P3_SIMPLE
#define MK_P3_SIMPLE 0
#endif
#ifndef MK_SYNC
#define MK_SYNC 1
#endif
constexpr int LDS_BYTES = 147456;
constexpr int NPHASE = 9;
__global__ void __launch_bounds__(NTHREADS, 2) mk_kernel(Params P, int lo, int hi, int dry) {
    extern __shared__ __attribute__((aligned(16))) unsigned char lds_raw[];
    Frame F; F.tid = threadIdx.x; F.lane = F.tid & 63; F.wave = __builtin_amdgcn_readfirstlane(F.tid >> 6); F.G = gridDim.x; F.bid = blockIdx.x;
    F.gwi = F.wave * F.G + F.bid; F.ngw = F.G * NWAVES; F.lds = (LAS unsigned char*)lds_raw; F.dry = (MK_REP_MASK != 0) && (dry != 0);
#if MK_SYNC == 0
    cg::grid_group grid = cg::this_grid();
#define GRID_BAR() grid.sync()
#else
    volatile LAS unsigned* MISC = (volatile LAS unsigned*)(F.lds + LDS_BYTES - 256);
    if (F.tid < 64) MISC[F.tid] = 0u;
    __syncthreads();
    XcdBarrier xbar; xbar.bar = (unsigned*)(P.ws + WS_BAR); xbar.x = 0; xbar.st = nullptr;
    if (hi - lo > 1) xbar = xcd_barrier_post((unsigned*)(P.ws + WS_BAR), MISC);
#define GRID_BAR() xcd_barrier(xbar)
#endif
#define IN(k) (lo <= (k) && (k) < hi)
#define SEAM(k) do { if (IN(k) && IN((k) + 1)) GRID_BAR(); } while (0)
#define RUN(k, ...) do { if (IN(k)) { __VA_ARGS__ } } while (0)
    RUN(0, p0_phase(P, F););
    SEAM(0);
    RUN(1, p1_phase(P, F););
    SEAM(1);
    RUN(2, {
        TileOrder S; S.init(MROWS / 256, NIN / 256, F.G, F.bid);
        EpiQKV E{(bf16_t*)(P.ws + WS_QA), (bf16_t*)(P.ws + WS_KA), (bf16_t*)(P.ws + WS_VA), (bf16_t*)(P.ws + WS_CQ), (bf16_t*)(P.ws + WS_CKV), (bf16_t*)(P.ws + WS_KB),
                 (float*)(P.ws + WS_SSQQ), (float*)(P.ws + WS_SSQKV), rope_tab(P), F.dry};
        pg8::gemm_phase(F.lds, pg8::Gemm{(const bf16_t*)(P.ws + WS_H), (const bf16_t*)(P.ws + WS_WIN), 1024}, S, E);
    });
    SEAM(2);
    RUN(3, {
#if MK_P3_SIMPLE
        { TileOrder S; S.init(MLAT / 256, 3, F.G, F.bid, true); EpiQup E{(bf16_t*)(P.ws + WS_QB), (const float*)(P.ws + WS_SSQQ), rope_tab(P)};
          Unit u; for (int i = 0; S.next(i, u); ++i) gemm_unit_simple(F, (const bf16_t*)(P.ws + WS_CQ), (const bf16_t*)(P.ws + WS_WQUP), 256, u, E); }
        { TileOrder S; S.init(MROWS / 256, 4, F.G, F.bid); EpiKVup E{(bf16_t*)(P.ws + WS_KB), (bf16_t*)(P.ws + WS_VB), (const float*)(P.ws + WS_SSQKV)};
          Unit u; for (int i = 0; S.next(i, u); ++i) gemm_unit_simple(F, (const bf16_t*)(P.ws + WS_CKV), (const bf16_t*)(P.ws + WS_WKVUP), 128, u, E); }
#else
        { TileOrder S; S.init(MLAT / 256, 3, F.G, F.bid, true); EpiQup E{(bf16_t*)(P.ws + WS_QB), (const float*)(P.ws + WS_SSQQ), rope_tab(P)};
          int kq = 256; asm volatile("" : "+s"(kq)); pg8::gemm_phase(F.lds, pg8::Gemm{(const bf16_t*)(P.ws + WS_CQ), (const bf16_t*)(P.ws + WS_WQUP), kq}, S, E); }
        { TileOrder S; S.init(MROWS / 256, 4, F.G, F.bid); EpiKVup E{(bf16_t*)(P.ws + WS_KB), (bf16_t*)(P.ws + WS_VB), (const float*)(P.ws + WS_SSQKV)};
          int kk = 128; asm volatile("" : "+s"(kk)); pg8::gemm_phase(F.lds, pg8::Gemm{(const bf16_t*)(P.ws + WS_CKV), (const bf16_t*)(P.ws + WS_WKVUP), kk}, S, E); }
#endif
#if MK_CHECK == 3
        GRID_BAR();
        { TileOrder S; S.init(MLAT / 256, 3, F.G, F.bid, true); EpiQup E{(bf16_t*)(P.ws + WS_A2), (const float*)(P.ws + WS_SSQQ), rope_tab(P)};
          Unit u; for (int i = 0; S.next(i, u); ++i) gemm_unit_simple(F, (const bf16_t*)(P.ws + WS_CQ), (const bf16_t*)(P.ws + WS_WQUP), 256, u, E); }
        { TileOrder S; S.init(MROWS / 256, 4, F.G, F.bid); EpiKVup E{(bf16_t*)(P.ws + WS_CAT), (bf16_t*)(P.ws + WS_SCR), (const float*)(P.ws + WS_SSQKV)};
          Unit u; for (int i = 0; S.next(i, u); ++i) if (u.pn < 2) gemm_unit_simple(F, (const bf16_t*)(P.ws + WS_CKV), (const bf16_t*)(P.ws + WS_WKVUP), 128, u, E); }
        GRID_BAR();
        { unsigned* BAD = (unsigned*)(P.ws + WS_LAM) + 16; const bf16_t* q0 = (const bf16_t*)(P.ws + WS_QB); const bf16_t* q1 = (const bf16_t*)(P.ws + WS_A2);
          const bf16_t* k0 = (const bf16_t*)(P.ws + WS_KB); const bf16_t* k1 = (const bf16_t*)(P.ws + WS_CAT); unsigned badq = 0, badk = 0;
          for (size_t i = (size_t)F.bid * NTHREADS + F.tid; i < (size_t)MROWS * 768; i += (size_t)F.G * NTHREADS) {
              const int row = (int)(i / 768), col = (int)(i % 768); const bool latrow = (row % TPB) >= CTXL;
              const float a = __uint_as_float((unsigned)q0[i] << 16), b = __uint_as_float((unsigned)q1[i] << 16);
              if (latrow && !(fabsf(a - b) <= 1e-3f + 1e-2f * fabsf(b))) ++badq;
              const float c = __uint_as_float((unsigned)k0[i] << 16), d = __uint_as_float((unsigned)k1[i] << 16);
              if ((col % 96) < 64 && !(fabsf(c - d) <= 1e-3f + 1e-2f * fabsf(d))) ++badk; }
          if (badq) atomicAdd(BAD, 1u); if (badk) atomicAdd(BAD + 1, 1u); }
#endif
    });
    SEAM(3);
    RUN(4, biasf_task(P, F); attn_phase(P, F););
    SEAM(4);
    RUN(5, {
        TileOrder S; S.init(MLAT / 256, 4, F.G, F.bid); EpiOut E{P.x, P.out, (bf16_t*)(P.ws + WS_A2), (const float*)(P.ws + WS_MOD), (float*)(P.ws + WS_SSQ2), F.dry};
        pg8::gemm_phase(F.lds, pg8::Gemm{(const bf16_t*)(P.ws + WS_CAT), (const bf16_t*)(P.ws + WS_WOUT), 1024}, S, E);
    });
    SEAM(5);
    RUN(6, {
        TileOrder S; S.init(MLAT / 256, 22, F.G, F.bid); EpiFfnIn E{(bf16_t*)(P.ws + WS_G), (const float*)(P.ws + WS_SSQ2), (const float*)(P.ws + WS_BIASF)};
        pg8::gemm_phase(F.lds, pg8::Gemm{(const bf16_t*)(P.ws + WS_A2), (const bf16_t*)(P.ws + WS_WFFI), 1024}, S, E);
    });
    SEAM(6);
    RUN(7, {
        TileOrder S; S.init(MLAT / 256, 4, F.G, F.bid); EpiFfnOut E{P.out, (const float*)(P.ws + WS_MOD), F.dry};
        pg8::gemm_phase(F.lds, pg8::Gemm{(const bf16_t*)(P.ws + WS_G), (const bf16_t*)(P.ws + WS_WFFO), FFH}, S, E);
    });
    SEAM(7);
    RUN(8, p8_phase(P, F););
#undef RUN
#undef IN
#undef SEAM
#undef GRID_BAR
}

extern "C" void kernel_launch(void* const* d_in, const int* in_sizes, int n_in, void* d_out, int out_size, void* d_ws, size_t ws_size, hipStream_t stream) {
    static int grid = 0;
    if (grid == 0) {
        if (n_in != 17 || in_sizes[0] != MLAT * DM || out_size != MLAT * DM || ws_size < WS_END) {
            fprintf(stderr, "kernel_launch: unexpected shapes: n_in %d in0 %d out %d ws %zu (need %zu)\n", n_in, n_in > 0 ? in_sizes[0] : -1, out_size, ws_size, (size_t)WS_END); grid = -1; return; }
        if (hipFuncSetAttribute((const void*)mk_kernel, hipFuncAttributeMaxDynamicSharedMemorySize, LDS_BYTES) != hipSuccess) { fprintf(stderr, "kernel_launch: hipFuncSetAttribute failed\n"); grid = -1; return; }
        int dev = 0, cus = 0, per_cu = 0;
        (void)hipGetDevice(&dev); (void)hipDeviceGetAttribute(&cus, hipDeviceAttributeMultiprocessorCount, dev);
        if (hipOccupancyMaxActiveBlocksPerMultiprocessor(&per_cu, (const void*)mk_kernel, NTHREADS, LDS_BYTES) != hipSuccess || per_cu < 1) { fprintf(stderr, "kernel_launch: occupancy query says %d blocks/CU\n", per_cu); per_cu = 1; }
        (void)hipGetLastError();
        grid = cus;
        if (grid <= 0) grid = 256;
    }
    if (grid < 0) return;
    (void)hipMemsetAsync(d_ws, 0, CTL_BYTES, stream);
    Params p{};
    p.x = (const float*)d_in[0]; p.c = (const float*)d_in[1]; p.ctx = (const float*)d_in[2]; p.c_ctx = (const float*)d_in[3]; p.w_ada = (const float*)d_in[4]; p.b_ada = (const float*)d_in[5];
    p.w_in = (const float*)d_in[6]; p.q_a_norm = (const float*)d_in[7]; p.kv_a_norm = (const float*)d_in[8]; p.w_q_up = (const float*)d_in[9]; p.w_kv_up = (const float*)d_in[10];
    p.diff_lambda = (const float*)d_in[11]; p.diff_subln = (const float*)d_in[12]; p.w_out = (const float*)d_in[13]; p.w_ffn_in = (const float*)d_in[14]; p.w_ffn_out = (const float*)d_in[15];
    p.final_norm = (const float*)d_in[16]; p.out = (float*)d_out; p.ws = (unsigned char*)d_ws;
#if MK_FUSED
#if MK_SYNC == 0
    int lo = 0, hi = NPHASE, dry = 0; void* args[] = {&p, &lo, &hi, &dry};
    hipError_t e = hipLaunchCooperativeKernel((const void*)mk_kernel, dim3(grid), dim3(NTHREADS), args, LDS_BYTES, stream);
    if (e != hipSuccess) fprintf(stderr, "kernel_launch: cooperative launch failed: %s (grid %d)\n", hipGetErrorString(e), grid);
#else
    hipLaunchKernelGGL(mk_kernel, dim3(grid), dim3(NTHREADS), LDS_BYTES, stream, p, 0, NPHASE, 0);
    for (int k = 0; k < NPHASE; ++k) if ((MK_REP_MASK >> k) & 1) hipLaunchKernelGGL(mk_kernel, dim3(grid), dim3(NTHREADS), LDS_BYTES, stream, p, k, k + 1, 1);
    { const hipError_t le = hipPeekAtLastError(); if (le != hipSuccess) fprintf(stderr, "kernel_launch: launch failed: %s\n", hipGetErrorName(le)); }
#endif
#else
    for (int ph = 0; ph < NPHASE; ++ph) {
        hipLaunchKernelGGL(mk_kernel, dim3(grid), dim3(NTHREADS), LDS_BYTES, stream, p, ph, ph + 1, 0);
        const hipError_t le = hipPeekAtLastError();
        if (le != hipSuccess) { fprintf(stderr, "kernel_launch: launch %d failed: %s\n", ph, hipGetErrorName(le)); break; }
    }
#endif
}
```

```cpp
#include <hip/hip_runtime.h>
#include <hip/hip_cooperative_groups.h>
#include <cstdint>
#include <cstdio>
namespace cg = cooperative_groups;

#define LAS __attribute__((address_space(3)))
typedef unsigned short bf16_t;
typedef short bf16x8 __attribute__((ext_vector_type(8)));
typedef short s16x4 __attribute__((ext_vector_type(4)));
typedef float f32x2 __attribute__((ext_vector_type(2)));
typedef float f32x4 __attribute__((ext_vector_type(4)));
typedef float f32x16 __attribute__((ext_vector_type(16)));
typedef unsigned u32x2 __attribute__((ext_vector_type(2)));
typedef unsigned u32x4 __attribute__((ext_vector_type(4)));
typedef __bf16 bf16x2_t __attribute__((ext_vector_type(2)));

constexpr int DM = 1024, NB = 16, SEQ = 2048, CTXL = 256, TPB = SEQ + CTXL;
constexpr int MROWS = NB * TPB, MLAT = NB * SEQ;
constexpr int FFH = 2816, NIN = 2048, NADA = 6 * DM;
constexpr float EPS = 1e-6f;
constexpr float QSCALE_A = 0.125f * 1.4426950408889634f, QSCALE_B = 0.10206207261596575f * 1.4426950408889634f;
constexpr int NWAVES = 8, NTHREADS = 512;

constexpr size_t KiB = 1024, MiB = 1024 * 1024;
constexpr size_t WS_MOD = 0, WS_BIASF = 512 * KiB, WS_SSQQ = 1024 * KiB, WS_SSQKV = 1184 * KiB, WS_SSQ2 = 1344 * KiB, WS_LAM = 1536 * KiB, WS_BAR = 1792 * KiB;
constexpr size_t CTL_BYTES = 2 * MiB;
constexpr size_t WS_TAB = 2 * MiB;
constexpr size_t WS_WIN = 3 * MiB, WS_WQUP = 7 * MiB, WS_WKVUP = 7 * MiB + 512 * KiB, WS_WOUT = 8 * MiB, WS_WFFI = 10 * MiB, WS_WFFO = 21 * MiB;
constexpr size_t WS_A2 = 27 * MiB, WS_CAT = 91 * MiB;
constexpr size_t WS_H = 155 * MiB, WS_QB = 155 * MiB, WS_QA = 227 * MiB, WS_KA = 263 * MiB, WS_VA = 299 * MiB, WS_CQ = 335 * MiB, WS_CKV = 353 * MiB;
constexpr size_t WS_KB = 362 * MiB, WS_VB = 416 * MiB, WS_SCR = 452 * MiB, WS_G = 155 * MiB, WS_END = 484 * MiB;
static_assert(WS_G + (size_t)MLAT * FFH * 2 <= WS_CQ, "G overlay");
static_assert(WS_WFFO + (size_t)DM * FFH * 2 <= WS_A2, "wffo");

struct Params {
    const float *x, *c, *ctx, *c_ctx, *w_ada, *b_ada, *w_in, *q_a_norm, *kv_a_norm, *w_q_up, *w_kv_up, *diff_lambda, *diff_subln, *w_out, *w_ffn_in, *w_ffn_out, *final_norm;
    float* out; unsigned char* ws;
};

__device__ __forceinline__ unsigned cvtpk(float lo, float hi) { f32x2 v = {lo, hi}; bf16x2_t b = __builtin_convertvector(v, bf16x2_t); return __builtin_bit_cast(unsigned, b); }
__device__ __forceinline__ float wave_sum(float v) {
#pragma unroll
    for (int o = 1; o < 64; o <<= 1) v += __shfl_xor(v, o);
    return v;
}
__device__ __forceinline__ float silu_f(float v) { return v / (1.f + __expf(-v)); }
__device__ __forceinline__ u32x4 pack8(f32x4 a, f32x4 b) { u32x4 w; w.x = cvtpk(a[0], a[1]); w.y = cvtpk(a[2], a[3]); w.z = cvtpk(b[0], b[1]); w.w = cvtpk(b[2], b[3]); return w; }
__device__ __forceinline__ int ropeA_L(int q) { return 4 * ((q >> 3) & 3) + (q & 3) + 16 * ((q >> 2) & 1); }
__device__ __forceinline__ int ropeB_L(int q) { const int a = q >> 3, n = (q >> 2) & 1, j = q & 3; return (a >> 1) * 16 + (a & 1) * 4 + j + 8 * n; }

struct Frame { int tid, lane, wave, G, bid, gwi, ngw; bool dry; LAS unsigned char* lds; };

__device__ __forceinline__ void p0_ada_task(const Params& P, float* MOD, int t, int lane, bool dry) {
    const int cgp = t % 24, kc = t / 24, k0 = kc * 32, n = cgp * 256 + lane * 4, k = k0 + (lane & 31);
    float sv[17];
#pragma unroll
    for (int b = 0; b < 16; ++b) sv[b] = silu_f(P.c[b * DM + k]);
    sv[16] = silu_f(P.c_ctx[k]);
    f32x4 acc[17];
    const f32x4 binit = (kc == 0) ? *(const f32x4*)(P.b_ada + n) : (f32x4){0.f, 0.f, 0.f, 0.f};
#pragma unroll
    for (int b = 0; b < 17; ++b) acc[b] = binit;
#pragma unroll 2
    for (int kk = 0; kk < 32; ++kk) {
        const f32x4 w = *(const f32x4*)(P.w_ada + (size_t)(k0 + kk) * NADA + n);
#pragma unroll
        for (int b = 0; b < 17; ++b) { const float s = __shfl(sv[b], kk); acc[b] += w * s; }
    }
#pragma unroll
    for (int b = 0; b < 17; ++b)
#pragma unroll
        for (int j = 0; j < 4; ++j) { if (!dry) atomicAdd(&MOD[b * NADA + n + j], acc[b][j]); else asm volatile("" :: "v"(acc[b][j])); }
}
__device__ __forceinline__ int src_col(int mat, int p) {
    switch (mat) {
    case 0: if (p < 1024) return (p & ~31) + ropeA_L(p & 31); if (p < 1920) return p; if (p < 1952) return 1920 + ropeB_L(p - 1920); return -1;
    case 1: if (p < 512) return (p >> 6) * 96 + (p & 63); { const int q = p - 512; return (q >> 5) * 96 + 64 + ropeB_L(q & 31); }
    case 2: if (p < 512) return (p >> 6) * 128 + (p & 63); { const int q = p - 512; return (q >> 6) * 128 + 64 + (q & 63); }
    case 4: { const int t = p >> 8, q = p & 255; return q < 128 ? 128 * t + q : FFH + 128 * t + (q - 128); }
    default: return p;
    }
}
__device__ __forceinline__ void p0_transpose_item(const float* W, int K, int N, const float* gain, bf16_t* WT, int mat, int npb, LAS float* scr, int item, int lane) {
    const int kb = item / npb, pb = item % npb, k0 = 64 * kb, p0 = 32 * pb;
    const int sc = src_col(mat, p0 + (lane & 31));
#pragma unroll 8
    for (int i = 0; i < 32; ++i) { const int kk = 2 * i + (lane >> 5);
        float v = 0.f; if (sc >= 0) { v = W[(size_t)(k0 + kk) * N + sc]; if (gain) v *= gain[k0 + kk]; }
        scr[kk * 33 + (lane & 31)] = v; }
    asm volatile("s_waitcnt lgkmcnt(0)" ::: "memory");
    const int c = lane & 7;
#pragma unroll
    for (int j = 0; j < 4; ++j) { const int n = (lane >> 3) + 8 * j; const LAS float* s = scr + (8 * c) * 33 + n;
        u32x4 o; o.x = cvtpk(s[0 * 33], s[1 * 33]); o.y = cvtpk(s[2 * 33], s[3 * 33]); o.z = cvtpk(s[4 * 33], s[5 * 33]); o.w = cvtpk(s[6 * 33], s[7 * 33]);
        *(u32x4*)(WT + (size_t)(p0 + n) * K + k0 + 8 * c) = o; }
    asm volatile("s_waitcnt lgkmcnt(0)" ::: "memory");
}
__device__ __forceinline__ void sincos_d(double a, float& s, float& c) {
    const double k = __builtin_rint(a * 0.15915494309189535);
    double r = __builtin_fma(-k, 6.283185307179586, a); r = __builtin_fma(-k, 2.4492935982947064e-16, r);
    const double r2 = r * r; double ts = r, tc = 1.0, ss = r, cc = 1.0;
    for (int n = 0; n < 14; ++n) { tc = -tc * r2 / (double)((2 * n + 1) * (2 * n + 2)); cc += tc; ts = -ts * r2 / (double)((2 * n + 2) * (2 * n + 3)); ss += ts; }
    s = (float)ss; c = (float)cc;
}
__device__ __forceinline__ void p0_phase(const Params& P, const Frame& F) {
    float* MOD = (float*)(P.ws + WS_MOD);
    LAS float* scr = (LAS float*)(F.lds + F.wave * 8448);
    constexpr int NADA_T = 24 * 32;
    constexpr int I0 = 16 * 64, I1 = 4 * 24, I2 = 2 * 32, I3 = 16 * 32, I4 = 16 * 176, I5 = 44 * 32;
    constexpr int NT = NADA_T + I0 + I1 + I2 + I3 + I4 + I5;
    for (int t = F.gwi; t < NT; t += F.ngw) {
        int r = t;
        if (r < NADA_T) { p0_ada_task(P, MOD, r, F.lane, F.dry); continue; } r -= NADA_T;
        if (r < I0) { p0_transpose_item(P.w_in, 1024, 1952, nullptr, (bf16_t*)(P.ws + WS_WIN), 0, 64, scr, r, F.lane); continue; } r -= I0;
        if (r < I1) { p0_transpose_item(P.w_q_up, 256, 768, P.q_a_norm, (bf16_t*)(P.ws + WS_WQUP), 1, 24, scr, r, F.lane); continue; } r -= I1;
        if (r < I2) { p0_transpose_item(P.w_kv_up, 128, 1024, P.kv_a_norm, (bf16_t*)(P.ws + WS_WKVUP), 2, 32, scr, r, F.lane); continue; } r -= I2;
        if (r < I3) { p0_transpose_item(P.w_out, 1024, 1024, nullptr, (bf16_t*)(P.ws + WS_WOUT), 3, 32, scr, r, F.lane); continue; } r -= I3;
        if (r < I4) { p0_transpose_item(P.w_ffn_in, 1024, 2 * FFH, nullptr, (bf16_t*)(P.ws + WS_WFFI), 4, 176, scr, r, F.lane); continue; } r -= I4;
        p0_transpose_item(P.w_ffn_out, FFH, 1024, nullptr, (bf16_t*)(P.ws + WS_WFFO), 5, 32, scr, r, F.lane);
    }
    if (F.bid == F.G - 1) {
        float* TAB = (float*)(P.ws + WS_TAB);
        for (int i = F.tid; i < 1536; i += NTHREADS) {
            float s, c;
            if (i < 1024) { const int pos = i >> 4, f = i & 15; double inv = 1.0; for (int q = 0; q < f; ++q) inv *= 0.5623413251903491; sincos_d((double)pos * inv, s, c); TAB[i] = c; TAB[1024 + i] = s; }
            else { const int e = i - 1024, pos = e >> 3, f = e & 7; double inv = 1.0; for (int q = 0; q < f; ++q) inv *= 0.31622776601683794; sincos_d((double)pos * inv, s, c); TAB[2048 + e] = c; TAB[2560 + e] = s; }
        }
        if (F.wave == 0) {
            const float* lp = P.diff_lambda; const float a = wave_sum(lp[F.lane] * lp[64 + F.lane]), b = wave_sum(lp[128 + F.lane] * lp[192 + F.lane]);
            if (F.lane == 0) *(float*)(P.ws + WS_LAM) = __expf(a) - __expf(b) + 0.2f;
        }
    }
}

__device__ __forceinline__ void p1_row_load(const Params& P, int r, int lane, f32x4 (&v)[4], const float*& mp) {
    const int b = r / TPB, t = r - b * TPB;
    const float* src = (t < CTXL) ? P.ctx + ((size_t)b * CTXL + t) * DM : P.x + ((size_t)b * SEQ + (t - CTXL)) * DM;
    mp = (const float*)(P.ws + WS_MOD) + (size_t)((t < CTXL) ? 16 : b) * NADA;
#pragma unroll
    for (int j = 0; j < 4; ++j) v[j] = *(const f32x4*)(src + 4 * lane + 256 * j);
}
__device__ __forceinline__ void p1_row_finish(bf16_t* H, int r, int lane, const f32x4 (&v)[4], const float* mp) {
    float s = 0.f;
#pragma unroll
    for (int j = 0; j < 4; ++j) s += (v[j].x * v[j].x + v[j].y * v[j].y) + (v[j].z * v[j].z + v[j].w * v[j].w);
    const float rstd = rsqrtf(wave_sum(s) * (1.f / DM) + EPS);
#pragma unroll
    for (int j = 0; j < 4; ++j) { const int col = 4 * lane + 256 * j; const f32x4 sh = *(const f32x4*)(mp + col), sc = *(const f32x4*)(mp + DM + col);
        const f32x4 h = v[j] * rstd * (sc + 1.f) + sh; u32x2 w; w.x = cvtpk(h[0], h[1]); w.y = cvtpk(h[2], h[3]);
        *(u32x2*)(H + (size_t)r * DM + col) = w; }
}
__device__ __forceinline__ void p1_phase(const Params& P, const Frame& F) {
    bf16_t* H = (bf16_t*)(P.ws + WS_H);
    for (int r = F.gwi; r < MROWS; r += 3 * F.ngw) {
        f32x4 va[4], vb[4], vc[4]; const float *ma, *mb, *mc; const int r1 = r + F.ngw, r2 = r + 2 * F.ngw;
        p1_row_load(P, r, F.lane, va, ma);
        if (r1 < MROWS) p1_row_load(P, r1, F.lane, vb, mb);
        if (r2 < MROWS) p1_row_load(P, r2, F.lane, vc, mc);
        p1_row_finish(H, r, F.lane, va, ma);
        if (r1 < MROWS) p1_row_finish(H, r1, F.lane, vb, mb);
        if (r2 < MROWS) p1_row_finish(H, r2, F.lane, vc, mc);
    }
}
__device__ __forceinline__ void biasf_task(const Params& P, const Frame& F) {
    if (F.gwi < 22 * 16) {
        const float* MOD = (const float*)(P.ws + WS_MOD);
        float* BIASF = (float*)(P.ws + WS_BIASF);
        const int cgp = F.gwi % 22, kc = F.gwi / 22, k0 = kc * 64, n = cgp * 256 + F.lane * 4;
        float sv[16];
#pragma unroll
        for (int b = 0; b < 16; ++b) sv[b] = MOD[(size_t)b * NADA + 3 * DM + k0 + F.lane];
        f32x4 acc[16];
#pragma unroll
        for (int b = 0; b < 16; ++b) acc[b] = (f32x4){0.f, 0.f, 0.f, 0.f};
#pragma unroll 1
        for (int k1 = 0; k1 < 64; k1 += 8) {
            f32x4 w[8];
#pragma unroll
            for (int kk = 0; kk < 8; ++kk) w[kk] = *(const f32x4*)(P.w_ffn_in + (size_t)(k0 + k1 + kk) * (2 * FFH) + n);
#pragma unroll
            for (int kk = 0; kk < 8; ++kk)
#pragma unroll
                for (int b = 0; b < 16; ++b) { const float s = __shfl(sv[b], k1 + kk); acc[b] += w[kk] * s; }
        }
#pragma unroll
        for (int b = 0; b < 16; ++b)
#pragma unroll
            for (int j = 0; j < 4; ++j) { if (!F.dry) atomicAdd(&BIASF[b * (2 * FFH) + n + j], acc[b][j]); else asm volatile("" :: "v"(acc[b][j])); }
    }
}

struct Unit { int pm, pn; };
__device__ __forceinline__ int perm32(int rho) { const int n = rho >> 4, i = rho & 15; return 8 * (i >> 2) + 4 * n + (i & 3); }
struct TileOrder {
    int nM, nN, nwg, G, c; bool skipctx;
    __device__ __forceinline__ void init(int nM_, int nN_, int G_, int c_, bool skip_ = false) { nM = nM_; nN = nN_; nwg = nM * nN; G = G_; c = c_; skipctx = skip_; }
    __device__ __forceinline__ bool next(int i, Unit& u) const {
        const long L = (long)i * G + c; if (L >= nwg) return false;
        int wgid = (int)L; { const int q = nwg / 8, r = nwg % 8, xcd = wgid % 8, off = wgid / 8; wgid = (xcd < r ? xcd * (q + 1) : r * (q + 1) + (xcd - r) * q) + off; }
        const int nig = 8 * nN, gid = wgid / nig, fm = gid * 8, gsz = (nM - fm) < 8 ? (nM - fm) : 8;
        u.pm = fm + ((wgid % nig) % gsz); u.pn = (wgid % nig) / gsz; if (skipctx) u.pm += (u.pm >> 3) + 1; return true;
    }
};
typedef f32x4 Acc[2][2][4][2];
constexpr int SG_STRIDE = 144;
template <class Epi>
__device__ __forceinline__ void gemm_unit_simple(const Frame& F, const bf16_t* A, const bf16_t* Bt, int K, const Unit u, const Epi& E) {
    const int wr = F.wave >> 2, wc = F.wave & 3, fr = F.lane & 15, fq = F.lane >> 4;
    LAS unsigned char* As = F.lds; LAS unsigned char* Bs = F.lds + 256 * SG_STRIDE;
    Acc acc;
#pragma unroll
    for (int a = 0; a < 2; ++a)
#pragma unroll
        for (int b = 0; b < 2; ++b)
#pragma unroll
            for (int m = 0; m < 4; ++m)
#pragma unroll
                for (int n = 0; n < 2; ++n) acc[a][b][m][n] = (f32x4){0.f, 0.f, 0.f, 0.f};
    const bf16_t* Ag = A + (size_t)u.pm * 256 * K; const bf16_t* Bg = Bt + (size_t)u.pn * 256 * K;
#pragma unroll 1
    for (int kt = 0; kt < K; kt += 64) {
        __syncthreads();
#pragma unroll
        for (int i = 0; i < 4; ++i) { const int p = F.tid + 512 * i, row = p >> 3, ch = p & 7;
            const u32x4 va = *(const u32x4*)(Ag + (size_t)row * K + kt + ch * 8), vb = *(const u32x4*)(Bg + (size_t)row * K + kt + ch * 8);
            *(LAS u32x4*)(As + row * SG_STRIDE + ch * 16) = va; *(LAS u32x4*)(Bs + row * SG_STRIDE + ch * 16) = vb; if (i & 1) asm volatile("" ::: "memory"); }
        __syncthreads();
#pragma unroll
        for (int k2 = 0; k2 < 2; ++k2) {
#pragma unroll
            for (int ai = 0; ai < 2; ++ai) {
                bf16x8 At[4];
#pragma unroll
                for (int m = 0; m < 4; ++m) At[m] = *(const LAS bf16x8*)(As + (128 * ai + 64 * wr + 16 * m + fr) * SG_STRIDE + (32 * k2 + 8 * fq) * 2);
#pragma unroll
                for (int bj = 0; bj < 2; ++bj) {
                    bf16x8 Bf[2];
#pragma unroll
                    for (int n = 0; n < 2; ++n) Bf[n] = *(const LAS bf16x8*)(Bs + (128 * bj + 32 * wc + perm32(16 * n + fr)) * SG_STRIDE + (32 * k2 + 8 * fq) * 2);
#pragma unroll
                    for (int m = 0; m < 4; ++m)
#pragma unroll
                        for (int n = 0; n < 2; ++n) acc[ai][bj][m][n] = __builtin_amdgcn_mfma_f32_16x16x32_bf16(Bf[n], At[m], acc[ai][bj][m][n], 0, 0, 0);
                }
            }
        }
    }
    E(acc, u, wr, wc, fr, fq);
}

struct RopeTab { const float *Ac, *As, *Bc, *Bs; };
__device__ __forceinline__ RopeTab rope_tab(const Params& P) { const float* T = (const float*)(P.ws + WS_TAB); return RopeTab{T, T + 1024, T + 2048, T + 2560}; }
__device__ __forceinline__ void rope_pair(f32x4& v0, f32x4& v1, const f32x4 cs, const f32x4 sn) { const f32x4 a = v0 * cs - v1 * sn, b = v1 * cs + v0 * sn; v0 = a; v1 = b; }

struct EpiQKV {
    bf16_t *QA, *KA, *VA, *CQ, *CKV, *KB; float *SSQQ, *SSQKV; RopeTab T; bool dry;
    __device__ __forceinline__ void operator()(const Acc& acc, const Unit& u, int wr, int wc, int fr, int fq) const {
        const int jb = u.pm % 9; const bool lat = jb != 0; const int pn = u.pn;
        if (!lat && (pn < 2 || pn == 6)) return;
#pragma unroll
        for (int ai = 0; ai < 2; ++ai) {
            const int prow = (jb - 1) * 4 + 2 * ai + wr;
#pragma unroll
            for (int m = 0; m < 4; ++m) {
                const int pcol = 16 * m + fr; const size_t grow = (size_t)u.pm * 256 + 128 * ai + 64 * wr + 16 * m + fr;
                if (pn < 4) {
                    bf16_t* dst = (pn < 2 ? QA : KA) + grow * 512 + (pn & 1) * 256 + 32 * wc + 8 * fq;
                    const int pos = (wc & 1) ? pcol : prow;
                    f32x4 cs = {1.f, 1.f, 1.f, 1.f}, sn = {0.f, 0.f, 0.f, 0.f};
                    if (lat) { cs = *(const f32x4*)(T.Ac + pos * 16 + 4 * fq); sn = *(const f32x4*)(T.As + pos * 16 + 4 * fq); }
                    const float qs = (pn < 2) ? QSCALE_A : 1.f;
#pragma unroll
                    for (int bj = 0; bj < 2; ++bj) { f32x4 v0 = acc[ai][bj][m][0] * qs, v1 = acc[ai][bj][m][1] * qs; rope_pair(v0, v1, cs, sn); *(u32x4*)(dst + 128 * bj) = pack8(v0, v1); }
                } else if (pn < 6) {
#pragma unroll
                    for (int bj = 0; bj < 2; ++bj) *(u32x4*)(VA + grow * 512 + (pn - 4) * 256 + 128 * bj + 32 * wc + 8 * fq) = pack8(acc[ai][bj][m][0], acc[ai][bj][m][1]);
                } else if (pn == 6) {
                    float s = 0.f;
#pragma unroll
                    for (int bj = 0; bj < 2; ++bj) { const f32x4 v0 = acc[ai][bj][m][0], v1 = acc[ai][bj][m][1];
                        s += (v0[0] * v0[0] + v0[1] * v0[1]) + (v0[2] * v0[2] + v0[3] * v0[3]) + (v1[0] * v1[0] + v1[1] * v1[1]) + (v1[2] * v1[2] + v1[3] * v1[3]);
                        *(u32x4*)(CQ + grow * 256 + 128 * bj + 32 * wc + 8 * fq) = pack8(v0, v1); }
                    s += __shfl_xor(s, 16); s += __shfl_xor(s, 32);
                    if (fq == 0 && !dry) atomicAdd(SSQQ + grow, s);
                } else {
                    { const f32x4 v0 = acc[ai][0][m][0], v1 = acc[ai][0][m][1];
                      float s = (v0[0] * v0[0] + v0[1] * v0[1]) + (v0[2] * v0[2] + v0[3] * v0[3]) + (v1[0] * v1[0] + v1[1] * v1[1]) + (v1[2] * v1[2] + v1[3] * v1[3]);
                      *(u32x4*)(CKV + grow * 128 + 32 * wc + 8 * fq) = pack8(v0, v1);
                      s += __shfl_xor(s, 16); s += __shfl_xor(s, 32);
                      if (fq == 0 && !dry) atomicAdd(SSQKV + grow, s); }
                    if (wc == 0) {
                        f32x4 v0 = acc[ai][1][m][0], v1 = acc[ai][1][m][1];
                        if (lat) { const int pos = (fq < 2) ? prow : pcol; const f32x4 cs = *(const f32x4*)(T.Bc + pos * 8 + 4 * (fq & 1)), sn = *(const f32x4*)(T.Bs + pos * 8 + 4 * (fq & 1)); rope_pair(v0, v1, cs, sn); }
                        const u32x4 w = pack8(v0, v1);
#pragma unroll
                        for (int h = 0; h < 8; ++h) *(u32x4*)(KB + grow * 768 + h * 96 + 64 + 8 * fq) = w;
                    }
                }
            }
        }
    }
};
struct EpiQup {
    bf16_t* QB; const float* SSQQ; RopeTab T;
    __device__ __forceinline__ void operator()(const Acc& acc, const Unit& u, int wr, int wc, int fr, int fq) const {
        const int jb = u.pm % 9, pn = u.pn;
        float rs[2][4];
#pragma unroll
        for (int ai = 0; ai < 2; ++ai)
#pragma unroll
            for (int m = 0; m < 4; ++m) rs[ai][m] = SSQQ[(size_t)u.pm * 256 + 128 * ai + 64 * wr + 16 * m + fr];
#pragma unroll
        for (int ai = 0; ai < 2; ++ai) {
            const int prow = (jb - 1) * 4 + 2 * ai + wr;
#pragma unroll
            for (int m = 0; m < 4; ++m) {
                const int pcol = 16 * m + fr; const size_t grow = (size_t)u.pm * 256 + 128 * ai + 64 * wr + 16 * m + fr;
                const float rstd = rsqrtf(rs[ai][m] * (1.f / 256.f) + EPS) * QSCALE_B;
#pragma unroll
                for (int bj = 0; bj < 2; ++bj) {
                    f32x4 v0 = acc[ai][bj][m][0] * rstd, v1 = acc[ai][bj][m][1] * rstd;
                    if (pn < 2) { const int c = pn * 256 + 128 * bj + 32 * wc + 8 * fq; *(u32x4*)(QB + grow * 768 + (c >> 6) * 96 + (c & 63)) = pack8(v0, v1); }
                    else { const int h = 4 * bj + wc, pos = (fq < 2) ? prow : pcol;
                        const f32x4 cs = *(const f32x4*)(T.Bc + pos * 8 + 4 * (fq & 1)), sn = *(const f32x4*)(T.Bs + pos * 8 + 4 * (fq & 1)); rope_pair(v0, v1, cs, sn);
                        *(u32x4*)(QB + grow * 768 + h * 96 + 64 + 8 * fq) = pack8(v0, v1); }
                }
                asm volatile("" ::: "memory");
            }
        }
    }
};
struct EpiKVup {
    bf16_t *KB, *VB; const float* SSQKV;
    __device__ __forceinline__ void operator()(const Acc& acc, const Unit& u, int wr, int wc, int fr, int fq) const {
        const int pn = u.pn;
        float rs[2][4];
#pragma unroll
        for (int ai = 0; ai < 2; ++ai)
#pragma unroll
            for (int m = 0; m < 4; ++m) rs[ai][m] = SSQKV[(size_t)u.pm * 256 + 128 * ai + 64 * wr + 16 * m + fr];
#pragma unroll
        for (int ai = 0; ai < 2; ++ai)
#pragma unroll
            for (int m = 0; m < 4; ++m) {
                const size_t grow = (size_t)u.pm * 256 + 128 * ai + 64 * wr + 16 * m + fr;
                const float rstd = rsqrtf(rs[ai][m] * (1.f / 128.f) + EPS);
#pragma unroll
                for (int bj = 0; bj < 2; ++bj) {
                    const f32x4 v0 = acc[ai][bj][m][0] * rstd, v1 = acc[ai][bj][m][1] * rstd;
                    if (pn < 2) { const int c = pn * 256 + 128 * bj + 32 * wc + 8 * fq; *(u32x4*)(KB + grow * 768 + (c >> 6) * 96 + (c & 63)) = pack8(v0, v1); }
                    else *(u32x4*)(VB + grow * 512 + (pn - 2) * 256 + 128 * bj + 32 * wc + 8 * fq) = pack8(v0, v1);
                }
                asm volatile("" ::: "memory");
            }
    }
};
struct EpiOut {
    const float* x; float* out; bf16_t* A2; const float* MOD; float* SSQ2; bool dry;
    __device__ __forceinline__ void operator()(const Acc& acc, const Unit& u, int wr, int wc, int fr, int fq) const {
        const float* mp = MOD + (size_t)(u.pm >> 3) * NADA; const int col0 = u.pn * 256 + 32 * wc + 8 * fq;
        f32x4 ga[2][2], sf[2][2];
#pragma unroll
        for (int bj = 0; bj < 2; ++bj)
#pragma unroll
            for (int n = 0; n < 2; ++n) { ga[bj][n] = *(const f32x4*)(mp + 2 * DM + col0 + 128 * bj + 4 * n); sf[bj][n] = *(const f32x4*)(mp + 4 * DM + col0 + 128 * bj + 4 * n) + 1.f; }
#pragma unroll
        for (int ai = 0; ai < 2; ++ai)
#pragma unroll
            for (int mp2 = 0; mp2 < 2; ++mp2) {
                f32x4 xv[2][2][2];
#pragma unroll
                for (int mm = 0; mm < 2; ++mm) { const size_t row = (size_t)u.pm * 256 + 128 * ai + 64 * wr + 16 * (2 * mp2 + mm) + fr;
#pragma unroll
                    for (int bj = 0; bj < 2; ++bj)
#pragma unroll
                        for (int n = 0; n < 2; ++n) xv[mm][bj][n] = *(const f32x4*)(x + row * DM + col0 + 128 * bj + 4 * n); }
#pragma unroll
                for (int mm = 0; mm < 2; ++mm) { const int m = 2 * mp2 + mm; const size_t row = (size_t)u.pm * 256 + 128 * ai + 64 * wr + 16 * m + fr; float s = 0.f;
#pragma unroll
                    for (int bj = 0; bj < 2; ++bj) { const size_t off = row * DM + col0 + 128 * bj; f32x4 nv[2];
#pragma unroll
                        for (int n = 0; n < 2; ++n) { nv[n] = xv[mm][bj][n] + ga[bj][n] * acc[ai][bj][m][n]; if (!dry) *(f32x4*)(out + off + 4 * n) = nv[n];
                            s += (nv[n][0] * nv[n][0] + nv[n][1] * nv[n][1]) + (nv[n][2] * nv[n][2] + nv[n][3] * nv[n][3]); }
                        { const u32x4 pk = pack8(nv[0] * sf[bj][0], nv[1] * sf[bj][1]); if (!dry) *(u32x4*)(A2 + off) = pk; else asm volatile("" :: "v"(pk)); } }
                    s += __shfl_xor(s, 16); s += __shfl_xor(s, 32);
                    if (fq == 0 && !dry) atomicAdd(SSQ2 + row, s); }
                asm volatile("" ::: "memory");
            }
    }
};
struct EpiFfnIn {
    bf16_t* G; const float* SSQ2; const float* BIASF;
    __device__ __forceinline__ void operator()(const Acc& acc, const Unit& u, int wr, int wc, int fr, int fq) const {
        const float* bp = BIASF + (size_t)(u.pm >> 3) * (2 * FFH); const int hc = u.pn * 128 + 32 * wc + 8 * fq;
        f32x4 bg[2], bu[2];
#pragma unroll
        for (int n = 0; n < 2; ++n) { bg[n] = *(const f32x4*)(bp + hc + 4 * n); bu[n] = *(const f32x4*)(bp + FFH + hc + 4 * n); }
        float rs[2][4];
#pragma unroll
        for (int ai = 0; ai < 2; ++ai)
#pragma unroll
            for (int m = 0; m < 4; ++m) rs[ai][m] = SSQ2[(size_t)u.pm * 256 + 128 * ai + 64 * wr + 16 * m + fr];
#pragma unroll
        for (int ai = 0; ai < 2; ++ai)
#pragma unroll
            for (int m = 0; m < 4; ++m) {
                const size_t row = (size_t)u.pm * 256 + 128 * ai + 64 * wr + 16 * m + fr;
                const float rstd = rsqrtf(rs[ai][m] * (1.f / DM) + EPS);
                f32x4 o[2];
#pragma unroll
                for (int n = 0; n < 2; ++n) { const f32x4 g = acc[ai][0][m][n] * rstd + bg[n], up = acc[ai][1][m][n] * rstd + bu[n];
#pragma unroll
                    for (int j = 0; j < 4; ++j) o[n][j] = silu_f(g[j]) * up[j]; }
                *(u32x4*)(G + row * FFH + hc) = pack8(o[0], o[1]);
            }
    }
};
struct EpiFfnOut {
    float* out; const float* MOD; bool dry;
    __device__ __forceinline__ void operator()(const Acc& acc, const Unit& u, int wr, int wc, int fr, int fq) const {
        const float* mp = MOD + (size_t)(u.pm >> 3) * NADA + 5 * DM; const int col0 = u.pn * 256 + 32 * wc + 8 * fq;
        f32x4 gf[2][2];
#pragma unroll
        for (int bj = 0; bj < 2; ++bj)
#pragma unroll
            for (int n = 0; n < 2; ++n) gf[bj][n] = *(const f32x4*)(mp + col0 + 128 * bj + 4 * n);
#pragma unroll
        for (int ai = 0; ai < 2; ++ai)
#pragma unroll
            for (int mp2 = 0; mp2 < 2; ++mp2) {
                f32x4 nl[2][2][2];
#pragma unroll
                for (int mm = 0; mm < 2; ++mm) { const size_t row = (size_t)u.pm * 256 + 128 * ai + 64 * wr + 16 * (2 * mp2 + mm) + fr;
#pragma unroll
                    for (int bj = 0; bj < 2; ++bj)
#pragma unroll
                        for (int n = 0; n < 2; ++n) nl[mm][bj][n] = *(const f32x4*)(out + row * DM + col0 + 128 * bj + 4 * n); }
#pragma unroll
                for (int mm = 0; mm < 2; ++mm) { const int m = 2 * mp2 + mm; const size_t row = (size_t)u.pm * 256 + 128 * ai + 64 * wr + 16 * m + fr;
#pragma unroll
                    for (int bj = 0; bj < 2; ++bj)
#pragma unroll
                        for (int n = 0; n < 2; ++n) { const f32x4 yv = nl[mm][bj][n] + gf[bj][n] * acc[ai][bj][m][n];
                            if (!dry) *(f32x4*)(out + row * DM + col0 + 128 * bj + 4 * n) = yv; else asm volatile("" :: "v"(yv)); } }
                asm volatile("" ::: "memory");
            }
    }
};

namespace pg8 {
constexpr int BK = 64, HALF = 128, HTB = HALF * BK * 2, STAGE_BYTES = 8 * HTB;
__device__ __forceinline__ int lds_byte(int r, int c) { const int st = (r >> 4) * 2 + (c >> 5), rr = r & 15, cc = c & 31, ob = rr * 64 + cc * 2; return st * 1024 + (ob ^ (((ob >> 9) & 1) << 5)); }
__device__ __forceinline__ void stage_rc(int b, int& R, int& C) { const int st = b / 1024, sb = b % 1024, swz = sb ^ (((sb >> 9) & 1) << 5); R = (st >> 1) * 16 + swz / 64; C = (st & 1) * 32 + (swz % 64) / 2; }
struct Gemm { const bf16_t* A; const bf16_t* Bt; int K; };
template <class Epi, class Sched>
__device__ __forceinline__ void gemm_phase(LAS unsigned char* lds, const Gemm g, const Sched& S, const Epi& E) {
    const int tid = threadIdx.x, wid = __builtin_amdgcn_readfirstlane(tid >> 6), lane = tid & 63, wr = wid >> 2, wc = wid & 3, fr = lane & 15, fq = lane >> 4;
    const int K = g.K, nt = K / BK;
    unsigned voffA[2], voffB[2];
#pragma unroll
    for (int i = 0; i < 2; ++i) { int R, C; stage_rc(tid * 16 + i * 8192, R, C); const int Rb = (R & ~31) + perm32(R & 31);
        voffA[i] = (unsigned)(R * K + C) * 2u; voffB[i] = (unsigned)(Rb * K + C) * 2u; }
    const size_t kstep = (size_t)(BK * 2);
    const size_t hstep = (size_t)HALF * K * 2;
    const size_t tstep = 2 * hstep;
    const unsigned ldsw = (unsigned)wid * 1024u;
    const int aoff = lds_byte(wr * 64 + fr, fq * 8), boff = lds_byte(wc * 32 + fr, fq * 8);
#define PG8_SA(b, h) (((b) * 2 + (h)) * HTB)
#define PG8_SB(b, h) ((4 + (b) * 2 + (h)) * HTB)
#define PG8_STAGE(bufoff, gbase, voff) do { _Pragma("unroll") for (int _i = 0; _i < 2; ++_i) \
        __builtin_amdgcn_global_load_lds((const unsigned*)((const char*)(gbase) + (voff)[_i]), (LAS unsigned*)(lds + (bufoff) + ldsw + _i * 8192), 16, 0, 0); } while (0)
#define PG8_LDA(dst, b, h) do { _Pragma("unroll") for (int m = 0; m < 4; ++m) _Pragma("unroll") for (int k = 0; k < 2; ++k) dst[m][k] = *(const LAS bf16x8*)(lds + PG8_SA(b, h) + aoff + m * 2048 + k * 1024); } while (0)
#define PG8_LDB(dst, b, h) do { _Pragma("unroll") for (int n = 0; n < 2; ++n) _Pragma("unroll") for (int k = 0; k < 2; ++k) dst[n][k] = *(const LAS bf16x8*)(lds + PG8_SB(b, h) + boff + n * 2048 + k * 1024); } while (0)
#define PG8_MMA(ai, bj, At, Bt) do { __builtin_amdgcn_s_setprio(1); _Pragma("unroll") for (int m = 0; m < 4; ++m) _Pragma("unroll") for (int n = 0; n < 2; ++n) _Pragma("unroll") for (int k = 0; k < 2; ++k) \
        acc[ai][bj][m][n] = __builtin_amdgcn_mfma_f32_16x16x32_bf16(Bt[n][k], At[m][k], acc[ai][bj][m][n], 0, 0, 0); __builtin_amdgcn_s_setprio(0); } while (0)
#define PG8_WAIT_V(n) asm volatile("s_waitcnt vmcnt(" #n ")" ::: "memory")
#define PG8_WAIT_L(n) asm volatile("s_waitcnt lgkmcnt(" #n ")" ::: "memory")
#define PG8_BAR __builtin_amdgcn_s_barrier()
#define PG8_SCHED __builtin_amdgcn_sched_barrier(0)
    Unit cur, nxt; int ui = 0;
    if (!S.next(0, cur)) return;
    f32x4 acc[2][2][4][2];
#pragma unroll
    for (int a = 0; a < 2; ++a)
#pragma unroll
        for (int b = 0; b < 2; ++b)
#pragma unroll
            for (int m = 0; m < 4; ++m)
#pragma unroll
                for (int n = 0; n < 2; ++n) acc[a][b][m][n] = (f32x4){0.f, 0.f, 0.f, 0.f};
    bf16x8 At[4][2], B0[2][2], B1[2][2];
    const char* cA = (const char*)g.A + (size_t)cur.pm * tstep; const char* cB = (const char*)g.Bt + (size_t)cur.pn * tstep;
    PG8_STAGE(PG8_SB(0, 0), cB, voffB); PG8_STAGE(PG8_SB(0, 1), cB + hstep, voffB); PG8_STAGE(PG8_SA(0, 0), cA, voffA); PG8_STAGE(PG8_SA(0, 1), cA + hstep, voffA);
    if (wr == 1) PG8_BAR;
    PG8_WAIT_V(2); PG8_BAR;
    PG8_STAGE(PG8_SB(1, 0), cB + kstep, voffB); PG8_STAGE(PG8_SA(1, 0), cA + kstep, voffA); PG8_STAGE(PG8_SB(1, 1), cB + hstep + kstep, voffB);
    PG8_WAIT_V(6); PG8_BAR;
    for (;;) {
        const bool has_next = S.next(ui + 1, nxt);
        const char* nA = has_next ? (const char*)g.A + (size_t)nxt.pm * tstep : cA; const char* nB = has_next ? (const char*)g.Bt + (size_t)nxt.pn * tstep : cB;
        for (int t = 0; t < nt; t += 2) {
            const bool last = (t == nt - 2);
            const char* a1 = cA + (size_t)(t + 1) * kstep;
            const char* a2 = last ? nA : cA + (size_t)(t + 2) * kstep; const char* b2 = last ? nB : cB + (size_t)(t + 2) * kstep;
            const char* a3 = a2 + kstep; const char* b3 = b2 + kstep;
            PG8_LDB(B0, 0, 0); PG8_LDB(B1, 0, 1); PG8_SCHED; PG8_LDA(At, 0, 0); PG8_STAGE(PG8_SA(1, 1), a1 + hstep, voffA);
            PG8_WAIT_V(8); PG8_WAIT_L(0); PG8_BAR; PG8_MMA(0, 0, At, B0); PG8_MMA(0, 1, At, B1); PG8_BAR; PG8_SCHED;
            PG8_LDA(At, 0, 1); PG8_STAGE(PG8_SB(0, 0), b2, voffB); PG8_STAGE(PG8_SB(0, 1), b2 + hstep, voffB); PG8_STAGE(PG8_SA(0, 0), a2, voffA);
            PG8_WAIT_V(8); PG8_WAIT_L(0); PG8_BAR; PG8_MMA(1, 0, At, B0); PG8_MMA(1, 1, At, B1); PG8_BAR; PG8_SCHED;
            PG8_LDB(B0, 1, 0); PG8_LDB(B1, 1, 1); PG8_SCHED; PG8_LDA(At, 1, 0); PG8_STAGE(PG8_SA(0, 1), a2 + hstep, voffA);
            PG8_WAIT_V(8); PG8_WAIT_L(0); PG8_BAR; PG8_MMA(0, 0, At, B0); PG8_MMA(0, 1, At, B1); PG8_BAR; PG8_SCHED;
            PG8_LDA(At, 1, 1); PG8_STAGE(PG8_SB(1, 0), b3, voffB); PG8_STAGE(PG8_SB(1, 1), b3 + hstep, voffB); PG8_STAGE(PG8_SA(1, 0), a3, voffA);
            PG8_WAIT_V(8); PG8_WAIT_L(0); PG8_BAR; PG8_MMA(1, 0, At, B0); PG8_MMA(1, 1, At, B1); PG8_BAR; PG8_SCHED;
        }
        if (wr == 0) PG8_BAR;
        E(acc, cur, wr, wc, fr, fq);
        if (!has_next) break;
#pragma unroll
        for (int a = 0; a < 2; ++a)
#pragma unroll
            for (int b = 0; b < 2; ++b)
#pragma unroll
                for (int m = 0; m < 4; ++m)
#pragma unroll
                    for (int n = 0; n < 2; ++n) acc[a][b][m][n] = (f32x4){0.f, 0.f, 0.f, 0.f};
        cur = nxt; cA = nA; cB = nB; ++ui;
        if (wr == 1) PG8_BAR;
    }
    PG8_WAIT_V(0);
    PG8_BAR;
#undef PG8_SA
#undef PG8_SB
#undef PG8_STAGE
#undef PG8_LDA
#undef PG8_LDB
#undef PG8_MMA
#undef PG8_WAIT_V
#undef PG8_WAIT_L
#undef PG8_BAR
#undef PG8_SCHED
}
}

#define SBAR() __builtin_amdgcn_sched_barrier(0)
__device__ __forceinline__ int crow(int r, int hi) { return (r & 3) + 8 * (r >> 2) + 4 * hi; }
constexpr float ATT_THR = 8.f;
constexpr float ATT_THRL = 11.5f;
template <bool FIRST>
__device__ __forceinline__ void partialSM(f32x16& p0, f32x16& p1, float& mhat, f32x16& negm, float& alpha) {
    float a = fmaxf(fmaxf(p0[0], p0[1]), p1[0]), b = fmaxf(fmaxf(p0[2], p0[3]), p1[1]); a = fmaxf(fmaxf(a, p1[2]), p1[3]);
#pragma unroll
    for (int r = 4; r < 16; r += 4) { a = fmaxf(fmaxf(a, p0[r]), p0[r + 1]); b = fmaxf(fmaxf(b, p0[r + 2]), p0[r + 3]); a = fmaxf(fmaxf(a, p1[r]), p1[r + 1]); b = fmaxf(fmaxf(b, p1[r + 2]), p1[r + 3]); }
    float rm = fmaxf(a, b);
    { auto rr = __builtin_amdgcn_permlane32_swap(__float_as_uint(rm), __float_as_uint(rm), false, false);
      rm = fmaxf(__uint_as_float(rr[0]), __uint_as_float(rr[1])); }
    alpha = 1.f;
    if (FIRST || __builtin_expect(__any(rm > ATT_THRL), 0)) {
        const float dl = FIRST ? rm : fmaxf(rm, 0.f); mhat += dl;
#pragma unroll
        for (int r = 0; r < 16; ++r) { p0[r] -= dl; p1[r] -= dl; }
#pragma unroll
        for (int r = 0; r < 16; ++r) negm[r] = -mhat;
        alpha = __builtin_amdgcn_exp2f(-dl);
    }
#pragma unroll
    for (int r = 0; r < 16; ++r) p0[r] = __builtin_amdgcn_exp2f(p0[r]);
}
__device__ __forceinline__ void finishSM(f32x16& p0, f32x16& p1, float alpha, float& l_reg, bf16x8& pa0, bf16x8& pa1, bf16x8& pa2, bf16x8& pa3) {
#pragma unroll
    for (int r = 0; r < 16; ++r) p1[r] = __builtin_amdgcn_exp2f(p1[r]);
    float ps = 0;
#pragma unroll
    for (int r = 0; r < 16; ++r) ps += p0[r];
#pragma unroll
    for (int r = 0; r < 16; ++r) ps += p1[r];
    { auto rr = __builtin_amdgcn_permlane32_swap(__float_as_uint(ps), __float_as_uint(ps), false, false);
      ps = __uint_as_float(rr[0]) + __uint_as_float(rr[1]); }
    l_reg = l_reg * alpha + ps;
#define PK4(P, BASE, OUT) do { unsigned a0 = cvtpk(P[BASE + 0], P[BASE + 1]), a1 = cvtpk(P[BASE + 2], P[BASE + 3]);   \
    unsigned b0 = cvtpk(P[BASE + 4], P[BASE + 5]), b1 = cvtpk(P[BASE + 6], P[BASE + 7]);                              \
    auto r0 = __builtin_amdgcn_permlane32_swap(a0, b0, false, false); auto r1 = __builtin_amdgcn_permlane32_swap(a1, b1, false, false); \
    u32x4 w = {r0[0], r1[0], r0[1], r1[1]}; OUT = __builtin_bit_cast(bf16x8, w); } while (0)
    PK4(p0, 0, pa0); PK4(p0, 8, pa1); PK4(p1, 0, pa2); PK4(p1, 8, pa3);
#undef PK4
}
template <int DQK>
__device__ __forceinline__ void qkt(f32x16& p0, f32x16& p1, const char* Ks, const bf16x8* qr, const f32x16& negm, int r32, int hi) {
    const char* kb = Ks + hi * 1024 + r32 * 16;
#pragma unroll
    for (int d0 = 0; d0 < DQK / 16; ++d0) {
        const bf16x8 b0 = *reinterpret_cast<const bf16x8*>(kb + d0 * 2048);
        const bf16x8 b1 = *reinterpret_cast<const bf16x8*>(kb + d0 * 2048 + 512);
        if (d0 == 0) { p0 = __builtin_amdgcn_mfma_f32_32x32x16_bf16(b0, qr[0], negm, 0, 0, 0); p1 = __builtin_amdgcn_mfma_f32_32x32x16_bf16(b1, qr[0], negm, 0, 0, 0); }
        else { p0 = __builtin_amdgcn_mfma_f32_32x32x16_bf16(b0, qr[d0], p0, 0, 0, 0); p1 = __builtin_amdgcn_mfma_f32_32x32x16_bf16(b1, qr[d0], p1, 0, 0, 0); } }
}
template <int DV> __device__ __forceinline__ int v_st(int k, int c) { const int kk = (k & ~0xC) | ((k & 4) << 1) | ((k & 8) >> 1); return ((kk >> 3) * (DV / 32) + (c >> 5)) * 512 + ((kk & 7) * 32 + (c & 31)) * 2; }
__device__ __forceinline__ int v_rd_base(int lane) { return ((lane & 3) << 3) | (((lane >> 2) & 3) << 6) | (((lane >> 4) & 1) << 5) | (((lane >> 5) & 1) << 8); }
template <int OFF> __device__ __forceinline__ s16x4 tr_read(int vb) {
    s16x4 r; asm volatile("ds_read_b64_tr_b16 %0, %1 offset:%2" : "=&v"(r) : "v"(vb), "i"(OFF) : "memory"); return r;
}
template <int DV, int D0> __device__ __forceinline__ void pv_one(f32x16& od, int vb, bf16x8 pa0, bf16x8 pa1, bf16x8 pa2, bf16x8 pa3) {
    constexpr int KS = 2 * (DV / 32) * 512, HF = (DV / 32) * 512, B0 = D0 * 512;
    const s16x4 l0 = tr_read<B0>(vb), h0 = tr_read<B0 + HF>(vb), l1 = tr_read<B0 + KS>(vb), h1 = tr_read<B0 + KS + HF>(vb);
    const s16x4 l2 = tr_read<B0 + 2 * KS>(vb), h2 = tr_read<B0 + 2 * KS + HF>(vb), l3 = tr_read<B0 + 3 * KS>(vb), h3 = tr_read<B0 + 3 * KS + HF>(vb);
    asm volatile("s_waitcnt lgkmcnt(0)" ::: "memory"); SBAR();
#define PK(L, H) (bf16x8){L[0], L[1], L[2], L[3], H[0], H[1], H[2], H[3]}
    od = __builtin_amdgcn_mfma_f32_32x32x16_bf16(pa0, PK(l0, h0), od, 0, 0, 0);
    od = __builtin_amdgcn_mfma_f32_32x32x16_bf16(pa1, PK(l1, h1), od, 0, 0, 0);
    od = __builtin_amdgcn_mfma_f32_32x32x16_bf16(pa2, PK(l2, h2), od, 0, 0, 0);
    od = __builtin_amdgcn_mfma_f32_32x32x16_bf16(pa3, PK(l3, h3), od, 0, 0, 0);
#undef PK
}
template <int DV> __device__ __forceinline__ void pv_all(f32x16* o, int vb, bf16x8 pa0, bf16x8 pa1, bf16x8 pa2, bf16x8 pa3) {
    pv_one<DV, 0>(o[0], vb, pa0, pa1, pa2, pa3); pv_one<DV, 1>(o[1], vb, pa0, pa1, pa2, pa3);
    if constexpr (DV == 128) { pv_one<DV, 2>(o[2], vb, pa0, pa1, pa2, pa3); pv_one<DV, 3>(o[3], vb, pa0, pa1, pa2, pa3); }
}
template <int DQK, int DV>
__device__ __forceinline__ void attn_pass(const bf16_t* __restrict__ Qb, int ldq, const bf16_t* __restrict__ Kh, int ldk, const bf16_t* __restrict__ Vh, int ldv, int seq, LAS unsigned char* ldsl, f32x16* o) {
    constexpr int KPC = DQK / 8, KBYTES = KPC * 1024, VBYTES = 64 * DV * 2, VPC = VBYTES / 1024, SLOTB = KBYTES + VBYTES, NSLOT = 4, ND = DV / 32, NC = DV / 32;
    static_assert(KPC >= 8 && KPC <= 16 && (VPC == 8 || VPC == 16), "piece assignment");
    char* lds = (char*)ldsl;
    const int tid = threadIdx.x, wid = __builtin_amdgcn_readfirstlane(tid >> 6), lane = tid & 63, r32 = lane & 31, hi = lane >> 5;
    float* wsf = (float*)(lds + NSLOT * SLOTB) + wid * 64; float* li_l = wsf; float* al_l = wsf + 32;
    float mhat = 0.f, l_reg = 0; f32x16 negm = f32x16{}; bf16x8 qr[DQK / 16];
#pragma unroll
    for (int d = 0; d < ND; ++d) o[d] = f32x16{};
    const bool k1v = (8 + wid) < KPC;
    const unsigned koff0 = (unsigned)(lane * ldk + wid * 8) * 2u, koff1 = (unsigned)(lane * ldk + (8 + wid) * 8) * 2u;
    unsigned voff[2];
#pragma unroll
    for (int i = 0; i < 2; ++i) { const int p = wid + 8 * i, st = 2 * p + (lane >> 5), kgrp = st / NC, cblk = st % NC, kk = kgrp * 8 + ((lane >> 2) & 7);
        const int k = (kk & ~0xC) | ((kk & 4) << 1) | ((kk & 8) >> 1); voff[i] = (unsigned)(k * ldv + cblk * 32 + (lane & 3) * 8) * 2u; }
#define GLDS(src, dstoff) __builtin_amdgcn_global_load_lds((const unsigned*)(src), (LAS unsigned*)(ldsl + (dstoff)), 16, 0, 0)
#define DMA(t, slot) do { const char* kb_ = (const char*)Kh + (size_t)(t) * 64 * ldk * 2; const char* vb_ = (const char*)Vh + (size_t)(t) * 64 * ldv * 2; const int so_ = (slot) * SLOTB; \
    GLDS(kb_ + koff0, so_ + wid * 1024); if (KPC > 8) { if (k1v) GLDS(kb_ + koff1, so_ + (8 + wid) * 1024); } \
    GLDS(vb_ + voff[0], so_ + KBYTES + wid * 1024); if (VPC == 16) GLDS(vb_ + voff[1], so_ + KBYTES + (8 + wid) * 1024); } while (0)
#define WAIT_V(n) asm volatile("s_waitcnt vmcnt(" #n ")" ::: "memory")
#define WAIT_1T() do { if (KPC > 8 && !k1v) WAIT_V(2); else WAIT_V(3); } while (0)
#define WAIT_2T() do { if (KPC > 8 && !k1v) WAIT_V(4); else WAIT_V(6); } while (0)
#define BAR() __builtin_amdgcn_s_barrier()
    DMA(0, 0); DMA(1, 1); DMA(2, 2);
    const bf16_t* Qw = Qb + (size_t)(wid * 32 + r32) * ldq + hi * 8;
#pragma unroll
    for (int d0 = 0; d0 < DQK / 16; ++d0) qr[d0] = *reinterpret_cast<const bf16x8*>(Qw + d0 * 16);
    const int vb0 = (int)(uintptr_t)(lds + KBYTES) + v_rd_base(lane);
#define RESC(a) do { if (__any((a) < 1.f)) { if (hi == 0) al_l[r32] = (a); asm volatile("s_waitcnt lgkmcnt(0)" ::: "memory"); \
    _Pragma("unroll") for (int d = 0; d < ND; ++d) _Pragma("unroll") for (int r = 0; r < 16; ++r) o[d][r] *= al_l[crow(r, hi)]; } } while (0)
    f32x16 pA0, pA1, pB0, pB1; float alA, alB; bf16x8 pa0, pa1, pa2, pa3; const int NT = seq / 64;
    WAIT_2T(); BAR();
    qkt<DQK>(pA0, pA1, lds, qr, negm, r32, hi); partialSM<true>(pA0, pA1, mhat, negm, alA);
    WAIT_1T(); BAR();
    int sl = 1;
    for (int j = 1; j + 1 < NT; j += 2) {
        if (j + 2 < NT) DMA(j + 2, (sl + 2) & 3);
        SBAR(); qkt<DQK>(pB0, pB1, lds + sl * SLOTB, qr, negm, r32, hi);
        finishSM(pA0, pA1, alA, l_reg, pa0, pa1, pa2, pa3); SBAR();
        pv_all<DV>(o, vb0 + ((sl + 3) & 3) * SLOTB, pa0, pa1, pa2, pa3); partialSM<false>(pB0, pB1, mhat, negm, alB);
        RESC(alB);
        if (j + 2 < NT) WAIT_1T(); else WAIT_V(0);
        BAR();
        if (j + 3 < NT) DMA(j + 3, (sl + 3) & 3);
        SBAR(); qkt<DQK>(pA0, pA1, lds + ((sl + 1) & 3) * SLOTB, qr, negm, r32, hi);
        finishSM(pB0, pB1, alB, l_reg, pa0, pa1, pa2, pa3); SBAR();
        pv_all<DV>(o, vb0 + sl * SLOTB, pa0, pa1, pa2, pa3); partialSM<false>(pA0, pA1, mhat, negm, alA);
        RESC(alA);
        if (j + 3 < NT) WAIT_1T(); else WAIT_V(0);
        BAR();
        sl = (sl + 2) & 3;
    }
    SBAR(); qkt<DQK>(pB0, pB1, lds + sl * SLOTB, qr, negm, r32, hi);
    finishSM(pA0, pA1, alA, l_reg, pa0, pa1, pa2, pa3); SBAR();
    pv_all<DV>(o, vb0 + ((sl + 3) & 3) * SLOTB, pa0, pa1, pa2, pa3); partialSM<false>(pB0, pB1, mhat, negm, alB);
    RESC(alB);
    finishSM(pB0, pB1, alB, l_reg, pa0, pa1, pa2, pa3); SBAR();
    pv_all<DV>(o, vb0 + sl * SLOTB, pa0, pa1, pa2, pa3);
    if (hi == 0) li_l[r32] = l_reg; asm volatile("s_waitcnt lgkmcnt(0)" ::: "memory");
#pragma unroll
    for (int r = 0; r < 16; ++r) { const float rl = __builtin_amdgcn_rcpf(li_l[crow(r, hi)]);
#pragma unroll
        for (int d = 0; d < ND; ++d) o[d][r] *= rl; }
    __syncthreads();
#undef GLDS
#undef DMA
#undef WAIT_V
#undef WAIT_1T
#undef WAIT_2T
#undef BAR
#undef RESC
}

constexpr int OT_STRIDE = 132;
template <int ND> __device__ __forceinline__ void o_to_lds(const f32x16* o, LAS float* T, int r32, int hi) {
#pragma unroll
    for (int d = 0; d < ND; ++d)
#pragma unroll
        for (int r = 0; r < 16; ++r) T[crow(r, hi) * OT_STRIDE + d * 32 + r32] = o[d][r];
    asm volatile("s_waitcnt lgkmcnt(0)" ::: "memory");
}
__device__ __forceinline__ void attn_phase(const Params& P, const Frame& F) {
    const bf16_t* QA = (const bf16_t*)(P.ws + WS_QA); const bf16_t* KA = (const bf16_t*)(P.ws + WS_KA); const bf16_t* VA = (const bf16_t*)(P.ws + WS_VA);
    const bf16_t* QB = (const bf16_t*)(P.ws + WS_QB); const bf16_t* KB = (const bf16_t*)(P.ws + WS_KB); const bf16_t* VB = (const bf16_t*)(P.ws + WS_VB);
    bf16_t* CAT = (bf16_t*)(P.ws + WS_CAT);
    float* SCR = (float*)(P.ws + WS_SCR) + ((size_t)F.bid * NWAVES + F.wave) * 4096;
    const float lam = *(const float*)(P.ws + WS_LAM);
    const int vcu = (F.G % 8 == 0) ? (F.bid % 8) * (F.G / 8) + F.bid / 8 : F.bid;
    const int r32 = F.lane & 31, hi = F.lane >> 5, erow = F.lane >> 1, ehalf = F.lane & 1;
    LAS float* T = (LAS float*)(F.lds + F.wave * (32 * OT_STRIDE * 4));
    int u = vcu;
    for (; u < 512; u += F.G) {
        {
            const int b = u >> 5, h = (u >> 3) & 3, qb = u & 7;
            const size_t krow0 = (size_t)b * TPB, qrow0 = krow0 + CTXL + qb * 256;
            { f32x16 o[4];
              attn_pass<64, 128>(QA + qrow0 * 512 + h * 128, 512, KA + krow0 * 512 + h * 128, 512, VA + krow0 * 512 + h * 128, 512, TPB, F.lds, o);
              o_to_lds<4>(o, T, r32, hi); }
#pragma unroll 4
            for (int q = 0; q < 16; ++q) *(f32x4*)(SCR + erow * 128 + ehalf * 64 + 4 * q) = *(const LAS f32x4*)(T + erow * OT_STRIDE + ehalf * 64 + 4 * q);
            __syncthreads();
            { f32x16 o[4];
              attn_pass<64, 128>(QA + qrow0 * 512 + h * 128 + 64, 512, KA + krow0 * 512 + h * 128 + 64, 512, VA + krow0 * 512 + h * 128, 512, TPB, F.lds, o);
              o_to_lds<4>(o, T, r32, hi); }
            float ss = 0.f;
#pragma unroll 4
            for (int q = 0; q < 16; ++q) { LAS f32x4* tp = (LAS f32x4*)(T + erow * OT_STRIDE + ehalf * 64 + 4 * q);
                const f32x4 cv = *(const f32x4*)(SCR + erow * 128 + ehalf * 64 + 4 * q) - *tp * lam; *tp = cv;
                ss += (cv[0] * cv[0] + cv[1] * cv[1]) + (cv[2] * cv[2] + cv[3] * cv[3]); }
            ss += __shfl_xor(ss, 1);
            const float rstd = rsqrtf(ss * (1.f / 128.f) + EPS) * 0.8f;
            asm volatile("s_waitcnt lgkmcnt(0)" ::: "memory");
            bf16_t* dst = CAT + ((size_t)b * SEQ + qb * 256 + F.wave * 32 + erow) * DM + h * 128 + ehalf * 64;
#pragma unroll 2
            for (int q = 0; q < 8; ++q) { const LAS f32x4* tp = (const LAS f32x4*)(T + erow * OT_STRIDE + ehalf * 64 + 8 * q);
                const f32x4 g0 = *(const f32x4*)(P.diff_subln + ehalf * 64 + 8 * q), g1 = *(const f32x4*)(P.diff_subln + ehalf * 64 + 8 * q + 4);
                *(u32x4*)(dst + 8 * q) = pack8(tp[0] * g0 * rstd, tp[1] * g1 * rstd); }
            __syncthreads();
        }
    }
    for (; u < 1536; u += F.G) {
        {
            const int v = u - 512, b = v >> 6, h = (v >> 3) & 7, qb = v & 7;
            const size_t krow0 = (size_t)b * TPB, qrow0 = krow0 + CTXL + qb * 256;
            { f32x16 o[2];
              attn_pass<96, 64>(QB + qrow0 * 768 + h * 96, 768, KB + krow0 * 768 + h * 96, 768, VB + krow0 * 512 + h * 64, 512, TPB, F.lds, o);
              o_to_lds<2>(o, T, r32, hi); }
            bf16_t* dst = CAT + ((size_t)b * SEQ + qb * 256 + F.wave * 32 + erow) * DM + 512 + h * 64 + ehalf * 32;
#pragma unroll
            for (int q = 0; q < 4; ++q) { const LAS f32x4* tp = (const LAS f32x4*)(T + erow * OT_STRIDE + ehalf * 32 + 8 * q); *(u32x4*)(dst + 8 * q) = pack8(tp[0], tp[1]); }
            __syncthreads();
        }
    }
}

__device__ __forceinline__ void p8_phase(const Params& P, const Frame& F) {
    float chk = 1.f;
#if MK_CHECK
    { const unsigned* BAD = (const unsigned*)(P.ws + WS_LAM) + 16; chk = 1.f + 0.1f * (float)((BAD[0] ? 1 : 0) + (BAD[1] ? 2 : 0)); }
#endif
    for (int r = F.gwi; r < MLAT; r += F.ngw) {
        float* row = P.out + (size_t)r * DM; f32x4 v[4]; float s = 0.f;
#pragma unroll
        for (int j = 0; j < 4; ++j) { v[j] = *(const f32x4*)(row + 4 * F.lane + 256 * j); s += (v[j].x * v[j].x + v[j].y * v[j].y) + (v[j].z * v[j].z + v[j].w * v[j].w); }
        const float rstd = rsqrtf(wave_sum(s) * (1.f / DM) + EPS);
#pragma unroll
        for (int j = 0; j < 4; ++j) { const f32x4 g = *(const f32x4*)(P.final_norm + 4 * F.lane + 256 * j); const f32x4 ov = v[j] * (rstd * chk) * g; if (!F.dry) *(f32x4*)(row + 4 * F.lane + 256 * j) = ov; else asm volatile("" :: "v"(ov)); }
    }
}


#define XB_TMO      128
#define XB_XCNT(j)  (256  + 64 * (j))
#define XB_XSUB(j)  (1280 + 64 * (j))
#define XB_XGEN(j)  (2304 + 64 * (j))
#define XB_TOP      3328
#define XB_TOPGEN   3392
#define XCD_BAR_WORDS 3456
#define XB_SPIN_CAP (1u << 20)
__device__ __forceinline__ unsigned xb_ld(unsigned* p)              { return __hip_atomic_load(p, __ATOMIC_RELAXED, __HIP_MEMORY_SCOPE_AGENT); }
__device__ __forceinline__ unsigned xb_add(unsigned* p, unsigned v) { return __hip_atomic_fetch_add(p, v, __ATOMIC_RELAXED, __HIP_MEMORY_SCOPE_AGENT); }
__device__ __forceinline__ unsigned xb_xcc_id() { return (unsigned)__builtin_amdgcn_s_getreg((3 << 11) | 20) & 0xFu; }
#define XB_SPIN(cond, bar) do { unsigned _sp = 0; while (cond) { __builtin_amdgcn_s_sleep(1); \
    if ((++_sp & 255u) == 0u) { if (xb_ld(&(bar)[XB_TMO])) break; if (_sp > XB_SPIN_CAP) { atomicAdd(&(bar)[XB_TMO], 1u); break; } } } } while (0)
struct XcdBarrier { unsigned* bar; unsigned x; volatile LAS unsigned* st; };
__device__ __forceinline__ XcdBarrier xcd_barrier_post(unsigned* bar, volatile LAS unsigned* st) {
    XcdBarrier b; b.bar = bar; b.x = xb_xcc_id(); b.st = st;
    if (threadIdx.x == 0) (void)xb_add(&bar[XB_XCNT(b.x)], 1u);
    return b;
}
__device__ __forceinline__ void xcd_barrier_complete(unsigned* bar, unsigned x, unsigned& nloc, unsigned& nx) {
    const unsigned G = gridDim.x * gridDim.y * gridDim.z;
    unsigned sum, cnt, mine, sp = 0u;
    for (;;) {
        sum = 0u; cnt = 0u; mine = 0u;
#pragma unroll
        for (unsigned j = 0; j < 16; ++j) { const unsigned c = xb_ld(&bar[XB_XCNT(j)]); sum += c; cnt += (c > 0u) ? 1u : 0u; mine = (j == x) ? c : mine; }
        if (sum == G) break;
        __builtin_amdgcn_s_sleep(1);
        if ((++sp & 255u) == 0u) { if (xb_ld(&bar[XB_TMO])) break; if (sp > XB_SPIN_CAP) { atomicAdd(&bar[XB_TMO], 1u); break; } }
    }
    nloc = mine > 0u ? mine : 1u; nx = cnt > 0u ? cnt : 1u;
}
__device__ __forceinline__ void xcd_barrier(const XcdBarrier& b) {
    asm volatile("s_waitcnt vmcnt(0)" ::: "memory");
    __syncthreads();
    if (threadIdx.x == 0) {
        unsigned* bar = b.bar;
        __builtin_amdgcn_s_waitcnt(0);
        unsigned nloc = b.st[0], nx = b.st[1];
        if (nloc == 0u) { xcd_barrier_complete(bar, b.x, nloc, nx); b.st[0] = nloc; b.st[1] = nx; }
        const unsigned old = xb_add(&bar[XB_XSUB(b.x)], 1u);
        const unsigned gen = old / nloc;
        if (old + 1u == (gen + 1u) * nloc) {
            __builtin_amdgcn_fence(__ATOMIC_RELEASE, "agent");
            asm volatile("s_waitcnt vmcnt(0)" ::: "memory");
            const unsigned og = xb_add(&bar[XB_TOP], 1u);
            const unsigned tg = og / nx;
            if (og + 1u == (tg + 1u) * nx) xb_add(&bar[XB_TOPGEN], 1u);
            else XB_SPIN(xb_ld(&bar[XB_TOPGEN]) == tg, bar);
            __builtin_amdgcn_fence(__ATOMIC_ACQUIRE, "agent");
            xb_add(&bar[XB_XGEN(b.x)], 1u);
            asm volatile("s_waitcnt vmcnt(0)" ::: "memory");
        } else {
            XB_SPIN(xb_ld(&bar[XB_XGEN(b.x)]) == gen, bar);
            __builtin_amdgcn_fence(__ATOMIC_ACQUIRE, "agent");
            asm volatile("s_waitcnt vmcnt(0)" ::: "memory");
        }
    }
    __syncthreads();
}

#ifndef MK_FUSED
#define MK_FUSED 1
#endif
#ifndef MK_REP_MASK
#define MK_REP_MASK 0
#endif
#ifndef MK_CHECK
#define MK_CHECK 0
#endif
#ifndef MK_P3_SIMPLE
#define MK_P3_SIMPLE 0
#endif
#ifndef MK_SYNC
#define MK_SYNC 1
#endif
constexpr int LDS_BYTES = 147456;
constexpr int NPHASE = 9;
__global__ void __launch_bounds__(NTHREADS, 2) mk_kernel(Params P, int lo, int hi, int dry) {
    extern __shared__ __attribute__((aligned(16))) unsigned char lds_raw[];
    Frame F; F.tid = threadIdx.x; F.lane = F.tid & 63; F.wave = __builtin_amdgcn_readfirstlane(F.tid >> 6); F.G = gridDim.x; F.bid = blockIdx.x;
    F.gwi = F.wave * F.G + F.bid; F.ngw = F.G * NWAVES; F.lds = (LAS unsigned char*)lds_raw; F.dry = (MK_REP_MASK != 0) && (dry != 0);
#if MK_SYNC == 0
    cg::grid_group grid = cg::this_grid();
#define GRID_BAR() grid.sync()
#else
    volatile LAS unsigned* MISC = (volatile LAS unsigned*)(F.lds + LDS_BYTES - 256);
    if (F.tid < 64) MISC[F.tid] = 0u;
    __syncthreads();
    XcdBarrier xbar; xbar.bar = (unsigned*)(P.ws + WS_BAR); xbar.x = 0; xbar.st = nullptr;
    if (hi - lo > 1) xbar = xcd_barrier_post((unsigned*)(P.ws + WS_BAR), MISC);
#define GRID_BAR() xcd_barrier(xbar)
#endif
#define IN(k) (lo <= (k) && (k) < hi)
#define SEAM(k) do { if (IN(k) && IN((k) + 1)) GRID_BAR(); } while (0)
#define RUN(k, ...) do { if (IN(k)) { __VA_ARGS__ } } while (0)
    RUN(0, p0_phase(P, F););
    SEAM(0);
    RUN(1, p1_phase(P, F););
    SEAM(1);
    RUN(2, {
        TileOrder S; S.init(MROWS / 256, NIN / 256, F.G, F.bid);
        EpiQKV E{(bf16_t*)(P.ws + WS_QA), (bf16_t*)(P.ws + WS_KA), (bf16_t*)(P.ws + WS_VA), (bf16_t*)(P.ws + WS_CQ), (bf16_t*)(P.ws + WS_CKV), (bf16_t*)(P.ws + WS_KB),
                 (float*)(P.ws + WS_SSQQ), (float*)(P.ws + WS_SSQKV), rope_tab(P), F.dry};
        pg8::gemm_phase(F.lds, pg8::Gemm{(const bf16_t*)(P.ws + WS_H), (const bf16_t*)(P.ws + WS_WIN), 1024}, S, E);
    });
    SEAM(2);
    RUN(3, {
#if MK_P3_SIMPLE
        { TileOrder S; S.init(MLAT / 256, 3, F.G, F.bid, true); EpiQup E{(bf16_t*)(P.ws + WS_QB), (const float*)(P.ws + WS_SSQQ), rope_tab(P)};
          Unit u; for (int i = 0; S.next(i, u); ++i) gemm_unit_simple(F, (const bf16_t*)(P.ws + WS_CQ), (const bf16_t*)(P.ws + WS_WQUP), 256, u, E); }
        { TileOrder S; S.init(MROWS / 256, 4, F.G, F.bid); EpiKVup E{(bf16_t*)(P.ws + WS_KB), (bf16_t*)(P.ws + WS_VB), (const float*)(P.ws + WS_SSQKV)};
          Unit u; for (int i = 0; S.next(i, u); ++i) gemm_unit_simple(F, (const bf16_t*)(P.ws + WS_CKV), (const bf16_t*)(P.ws + WS_WKVUP), 128, u, E); }
#else
        { TileOrder S; S.init(MLAT / 256, 3, F.G, F.bid, true); EpiQup E{(bf16_t*)(P.ws + WS_QB), (const float*)(P.ws + WS_SSQQ), rope_tab(P)};
          int kq = 256; asm volatile("" : "+s"(kq)); pg8::gemm_phase(F.lds, pg8::Gemm{(const bf16_t*)(P.ws + WS_CQ), (const bf16_t*)(P.ws + WS_WQUP), kq}, S, E); }
        { TileOrder S; S.init(MROWS / 256, 4, F.G, F.bid); EpiKVup E{(bf16_t*)(P.ws + WS_KB), (bf16_t*)(P.ws + WS_VB), (const float*)(P.ws + WS_SSQKV)};
          int kk = 128; asm volatile("" : "+s"(kk)); pg8::gemm_phase(F.lds, pg8::Gemm{(const bf16_t*)(P.ws + WS_CKV), (const bf16_t*)(P.ws + WS_WKVUP), kk}, S, E); }
#endif
#if MK_CHECK == 3
        GRID_BAR();
        { TileOrder S; S.init(MLAT / 256, 3, F.G, F.bid, true); EpiQup E{(bf16_t*)(P.ws + WS_A2), (const float*)(P.ws + WS_SSQQ), rope_tab(P)};
          Unit u; for (int i = 0; S.next(i, u); ++i) gemm_unit_simple(F, (const bf16_t*)(P.ws + WS_CQ), (const bf16_t*)(P.ws + WS_WQUP), 256, u, E); }
        { TileOrder S; S.init(MROWS / 256, 4, F.G, F.bid); EpiKVup E{(bf16_t*)(P.ws + WS_CAT), (bf16_t*)(P.ws + WS_SCR), (const float*)(P.ws + WS_SSQKV)};
          Unit u; for (int i = 0; S.next(i, u); ++i) if (u.pn < 2) gemm_unit_simple(F, (const bf16_t*)(P.ws + WS_CKV), (const bf16_t*)(P.ws + WS_WKVUP), 128, u, E); }
        GRID_BAR();
        { unsigned* BAD = (unsigned*)(P.ws + WS_LAM) + 16; const bf16_t* q0 = (const bf16_t*)(P.ws + WS_QB); const bf16_t* q1 = (const bf16_t*)(P.ws + WS_A2);
          const bf16_t* k0 = (const bf16_t*)(P.ws + WS_KB); const bf16_t* k1 = (const bf16_t*)(P.ws + WS_CAT); unsigned badq = 0, badk = 0;
          for (size_t i = (size_t)F.bid * NTHREADS + F.tid; i < (size_t)MROWS * 768; i += (size_t)F.G * NTHREADS) {
              const int row = (int)(i / 768), col = (int)(i % 768); const bool latrow = (row % TPB) >= CTXL;
              const float a = __uint_as_float((unsigned)q0[i] << 16), b = __uint_as_float((unsigned)q1[i] << 16);
              if (latrow && !(fabsf(a - b) <= 1e-3f + 1e-2f * fabsf(b))) ++badq;
              const float c = __uint_as_float((unsigned)k0[i] << 16), d = __uint_as_float((unsigned)k1[i] << 16);
              if ((col % 96) < 64 && !(fabsf(c - d) <= 1e-3f + 1e-2f * fabsf(d))) ++badk; }
          if (badq) atomicAdd(BAD, 1u); if (badk) atomicAdd(BAD + 1, 1u); }
#endif
    });
    SEAM(3);
    RUN(4, biasf_task(P, F); attn_phase(P, F););
    SEAM(4);
    RUN(5, {
        TileOrder S; S.init(MLAT / 256, 4, F.G, F.bid); EpiOut E{P.x, P.out, (bf16_t*)(P.ws + WS_A2), (const float*)(P.ws + WS_MOD), (float*)(P.ws + WS_SSQ2), F.dry};
        pg8::gemm_phase(F.lds, pg8::Gemm{(const bf16_t*)(P.ws + WS_CAT), (const bf16_t*)(P.ws + WS_WOUT), 1024}, S, E);
    });
    SEAM(5);
    RUN(6, {
        TileOrder S; S.init(MLAT / 256, 22, F.G, F.bid); EpiFfnIn E{(bf16_t*)(P.ws + WS_G), (const float*)(P.ws + WS_SSQ2), (const float*)(P.ws + WS_BIASF)};
        pg8::gemm_phase(F.lds, pg8::Gemm{(const bf16_t*)(P.ws + WS_A2), (const bf16_t*)(P.ws + WS_WFFI), 1024}, S, E);
    });
    SEAM(6);
    RUN(7, {
        TileOrder S; S.init(MLAT / 256, 4, F.G, F.bid); EpiFfnOut E{P.out, (const float*)(P.ws + WS_MOD), F.dry};
        pg8::gemm_phase(F.lds, pg8::Gemm{(const bf16_t*)(P.ws + WS_G), (const bf16_t*)(P.ws + WS_WFFO), FFH}, S, E);
    });
    SEAM(7);
    RUN(8, p8_phase(P, F););
#undef RUN
#undef IN
#undef SEAM
#undef GRID_BAR
}

extern "C" void kernel_launch(void* const* d_in, const int* in_sizes, int n_in, void* d_out, int out_size, void* d_ws, size_t ws_size, hipStream_t stream) {
    static int grid = 0;
    if (grid == 0) {
        if (n_in != 17 || in_sizes[0] != MLAT * DM || out_size != MLAT * DM || ws_size < WS_END) {
            fprintf(stderr, "kernel_launch: unexpected shapes: n_in %d in0 %d out %d ws %zu (need %zu)\n", n_in, n_in > 0 ? in_sizes[0] : -1, out_size, ws_size, (size_t)WS_END); grid = -1; return; }
        if (hipFuncSetAttribute((const void*)mk_kernel, hipFuncAttributeMaxDynamicSharedMemorySize, LDS_BYTES) != hipSuccess) { fprintf(stderr, "kernel_launch: hipFuncSetAttribute failed\n"); grid = -1; return; }
        int dev = 0, cus = 0, per_cu = 0;
        (void)hipGetDevice(&dev); (void)hipDeviceGetAttribute(&cus, hipDeviceAttributeMultiprocessorCount, dev);
        if (hipOccupancyMaxActiveBlocksPerMultiprocessor(&per_cu, (const void*)mk_kernel, NTHREADS, LDS_BYTES) != hipSuccess || per_cu < 1) { fprintf(stderr, "kernel_launch: occupancy query says %d blocks/CU\n", per_cu); per_cu = 1; }
        (void)hipGetLastError();
        grid = cus;
        if (grid <= 0) grid = 256;
    }
    if (grid < 0) return;
    (void)hipMemsetAsync(d_ws, 0, CTL_BYTES, stream);
    Params p{};
    p.x = (const float*)d_in[0]; p.c = (const float*)d_in[1]; p.ctx = (const float*)d_in[2]; p.c_ctx = (const float*)d_in[3]; p.w_ada = (const float*)d_in[4]; p.b_ada = (const float*)d_in[5];
    p.w_in = (const float*)d_in[6]; p.q_a_norm = (const float*)d_in[7]; p.kv_a_norm = (const float*)d_in[8]; p.w_q_up = (const float*)d_in[9]; p.w_kv_up = (const float*)d_in[10];
    p.diff_lambda = (const float*)d_in[11]; p.diff_subln = (const float*)d_in[12]; p.w_out = (const float*)d_in[13]; p.w_ffn_in = (const float*)d_in[14]; p.w_ffn_out = (const float*)d_in[15];
    p.final_norm = (const float*)d_in[16]; p.out = (float*)d_out; p.ws = (unsigned char*)d_ws;
#if MK_FUSED
#if MK_SYNC == 0
    int lo = 0, hi = NPHASE, dry = 0; void* args[] = {&p, &lo, &hi, &dry};
    hipError_t e = hipLaunchCooperativeKernel((const void*)mk_kernel, dim3(grid), dim3(NTHREADS), args, LDS_BYTES, stream);
    if (e != hipSuccess) fprintf(stderr, "kernel_launch: cooperative launch failed: %s (grid %d)\n", hipGetErrorString(e), grid);
#else
    hipLaunchKernelGGL(mk_kernel, dim3(grid), dim3(NTHREADS), LDS_BYTES, stream, p, 0, NPHASE, 0);
    for (int k = 0; k < NPHASE; ++k) if ((MK_REP_MASK >> k) & 1) hipLaunchKernelGGL(mk_kernel, dim3(grid), dim3(NTHREADS), LDS_BYTES, stream, p, k, k + 1, 1);
    { const hipError_t le = hipPeekAtLastError(); if (le != hipSuccess) fprintf(stderr, "kernel_launch: launch failed: %s\n", hipGetErrorName(le)); }
#endif
#else
    for (int ph = 0; ph < NPHASE; ++ph) {
        hipLaunchKernelGGL(mk_kernel, dim3(grid), dim3(NTHREADS), LDS_BYTES, stream, p, ph, ph + 1, 0);
        const hipError_t le = hipPeekAtLastError();
        if (le != hipSuccess) { fprintf(stderr, "kernel_launch: launch %d failed: %s\n", ph, hipGetErrorName(le)); break; }
    }
#endif
}
```
